# Optimizing an MI355X kernel written in HIP

```python
import math
import jax
import jax.numpy as jnp
from jax import lax
import numpy as np

D_MODEL = 2048
BATCH = 2
SEQ = 4096
DEPTH = 2

N_MIXERS = 2
ATT_HEADS = 16
ATT_HEAD_DIM = D_MODEL // ATT_HEADS
DILATED_PATTERNS = ((128, 1), (512, 4), (2048, 16))
ATT_BLOCK = 128
LSTM_HEADS = 4
LSTM_V_DIM = D_MODEL // LSTM_HEADS
LSTM_QK_DIM = LSTM_V_DIM // 2
LSTM_QK_WIDTH = LSTM_HEADS * LSTM_QK_DIM
LSTM_IN_WIDTH = 2 * LSTM_QK_WIDTH + 2 * D_MODEL + 2 * LSTM_HEADS
LSTM_CHUNK = 64
LSTM_CONV = 4
FFN_DIM = ((8 * D_MODEL // 3 + 255) // 256) * 256
FFN_CONV = 3
NORM_EPS = 1e-6

kernel_name = 'hybrid_dilated_attn_mlstm_convffn'


def rms_norm(x, g):
    xf = x.astype(jnp.float32)
    y = xf * lax.rsqrt(jnp.mean(xf * xf, axis=-1, keepdims=True) + NORM_EPS)
    return y * g.astype(jnp.float32)


def causal_dwconv(x, w, b):
    K = w.shape[0]
    S = x.shape[1]
    xp = jnp.pad(x, ((0, 0), (K - 1, 0), (0, 0)))
    y = b
    for j in range(K):
        y = y + w[j] * xp[:, j:j + S]
    return y


def dilated_branch(q, k, v, window, dil):
    B, H, S, hd = q.shape
    n_sub = -(-S // dil)
    nb = -(-n_sub // ATT_BLOCK)
    lp = nb * ATT_BLOCK
    pad = lp * dil - S

    def to_blocks(t):
        t = jnp.pad(t, ((0, 0), (0, 0), (0, pad), (0, 0)))
        t = t.reshape(B, H, lp, dil, hd).transpose(0, 1, 3, 2, 4)
        return t.reshape(B, H, dil, nb, ATT_BLOCK, hd)

    def with_prev(t):
        prev = jnp.pad(t[:, :, :, :-1], ((0, 0), (0, 0), (0, 0), (1, 0), (0, 0), (0, 0)))
        return jnp.concatenate([prev, t], axis=4)

    qb = to_blocks(q)
    kb = with_prev(to_blocks(k))
    vb = with_prev(to_blocks(v))
    s = jnp.einsum('bhrnid,bhrnjd->bhrnij', qb, kb)
    i = jnp.arange(ATT_BLOCK)[:, None]
    j = jnp.arange(2 * ATT_BLOCK)[None, :]
    dist = ATT_BLOCK + i - j
    band = (dist >= 0) & (dist <= window // dil)
    has_prev = (jnp.arange(nb) > 0)[:, None, None] | (j >= ATT_BLOCK)[None]
    valid = band[None] & has_prev
    s = jnp.where(valid, s, -jnp.inf)
    mx = jnp.max(s, axis=-1, keepdims=True)
    p = jnp.exp(s - mx)
    den = jnp.sum(p, axis=-1)
    o = jnp.einsum('bhrnij,bhrnjd->bhrnid', p, vb) / den[..., None]
    lse = mx[..., 0] + jnp.log(den)
    o = o.reshape(B, H, dil, lp, hd).transpose(0, 1, 3, 2, 4).reshape(B, H, lp * dil, hd)[:, :, :S]
    lse = lse.reshape(B, H, dil, lp).transpose(0, 1, 3, 2).reshape(B, H, lp * dil)[:, :, :S]
    return o, lse


def dilated_attention(x, norm_g, w_qkv, q_gain, k_gain, w_o):
    B, S, _ = x.shape
    h = rms_norm(x, norm_g).astype(x.dtype)
    z = (h @ w_qkv).reshape(B, S, 3, ATT_HEADS, ATT_HEAD_DIM)
    z = z.astype(jnp.float32).transpose(2, 0, 3, 1, 4)
    q = rms_norm(z[0], q_gain) * (ATT_HEAD_DIM ** -0.5)
    k = rms_norm(z[1], k_gain)
    v = z[2]
    outs = []
    lses = []
    for window, dil in DILATED_PATTERNS:
        o, l = dilated_branch(q, k, v, window, dil)
        outs.append(o)
        lses.append(l)
    wts = jax.nn.softmax(jnp.stack(lses), axis=0)
    o = jnp.einsum('gbhs,gbhsd->bshd', wts, jnp.stack(outs)).reshape(B, S, D_MODEL)
    return o.astype(x.dtype) @ w_o


def mlstm_mixer(x, norm_g, w_in, gate_bias, conv_w, conv_b, head_gain, w_out):
    B, S, _ = x.shape
    H, dk, dv, L = LSTM_HEADS, LSTM_QK_DIM, LSTM_V_DIM, LSTM_CHUNK
    QKW = LSTM_QK_WIDTH
    h = rms_norm(x, norm_g).astype(x.dtype)
    z = h @ w_in
    qk = jax.nn.silu(causal_dwconv(z[..., :2 * QKW], conv_w, conv_b)).astype(jnp.float32)
    q = qk[..., :QKW].reshape(B, S, H, dk).transpose(0, 2, 1, 3)
    k = qk[..., QKW:].reshape(B, S, H, dk).transpose(0, 2, 1, 3) * (dk ** -0.5)
    v = z[..., 2 * QKW:2 * QKW + D_MODEL].astype(jnp.float32).reshape(B, S, H, dv).transpose(0, 2, 1, 3)
    o_gate = jax.nn.sigmoid(z[..., 2 * QKW + D_MODEL:2 * QKW + 2 * D_MODEL].astype(jnp.float32))
    gates = (z[..., 2 * QKW + 2 * D_MODEL:].astype(jnp.float32) + gate_bias.astype(jnp.float32)).transpose(0, 2, 1)
    log_i = gates[:, :H]
    log_f = jax.nn.log_sigmoid(gates[:, H:])
    nc = S // L

    def chunks(t):
        return jnp.moveaxis(t.reshape((B, H, nc, L) + t.shape[3:]), 2, 0)

    causal = jnp.tril(jnp.ones((L, L), dtype=bool))

    def step(carry, inp):
        C, n, m = carry
        qc, kc, vc, lic, lfc = inp
        b = jnp.cumsum(lfc, axis=-1)
        D = jnp.where(causal, b[..., :, None] - b[..., None, :] + lic[..., None, :], -jnp.inf)
        g = b + m[..., None]
        m_t = jnp.maximum(g, jnp.max(D, axis=-1))
        P = jnp.exp(D - m_t[..., None])
        inter = jnp.exp(g - m_t)
        W = P * jnp.einsum('bhld,bhsd->bhls', qc, kc)
        num = inter[..., None] * jnp.einsum('bhld,bhde->bhle', qc, C) + jnp.einsum('bhls,bhse->bhle', W, vc)
        den = inter * jnp.einsum('bhld,bhd->bhl', qc, n) + jnp.sum(W, axis=-1)
        h_c = num / jnp.maximum(jnp.abs(den), jnp.exp(-m_t))[..., None]
        bL = b[..., -1]
        a = bL[..., None] - b + lic
        m_new = jnp.maximum(bL + m, jnp.max(a, axis=-1))
        decay = jnp.exp(bL + m - m_new)
        wts = jnp.exp(a - m_new[..., None])
        C_new = decay[..., None, None] * C + jnp.einsum('bhs,bhsd,bhse->bhde', wts, kc, vc)
        n_new = decay[..., None] * n + jnp.einsum('bhs,bhsd->bhd', wts, kc)
        return (C_new, n_new, m_new), h_c

    init = (jnp.zeros((B, H, dk, dv), jnp.float32), jnp.zeros((B, H, dk), jnp.float32), jnp.zeros((B, H), jnp.float32))
    _, hs = lax.scan(step, init, (chunks(q), chunks(k), chunks(v), chunks(log_i), chunks(log_f)))
    hs = jnp.moveaxis(hs, 0, 2).reshape(B, H, S, dv).transpose(0, 2, 1, 3)
    hs = rms_norm(hs, head_gain.reshape(H, dv)).reshape(B, S, D_MODEL) * o_gate
    return hs.astype(x.dtype) @ w_out


def conv_ffn(x, norm_g, w_up, conv_w, conv_b, w_down):
    h = rms_norm(x, norm_g).astype(x.dtype)
    u = causal_dwconv(h @ w_up, conv_w, conv_b)
    gate = u[..., :FFN_DIM]
    up = u[..., FFN_DIM:]
    return (jax.nn.silu(gate) * up) @ w_down


def setup_inputs(seed: int = 0) -> dict:
    key = jax.random.key(seed)
    ks = jax.random.split(key, 24)
    n_a = (DEPTH + 1) // 2
    n_b = DEPTH // 2
    res = (2 * DEPTH) ** -0.5
    f32 = jnp.float32

    def nrm(k, shape, scale):
        return scale * jax.random.normal(k, shape, f32)

    def gain(k, shape):
        return 1.0 + nrm(k, shape, 0.05)

    def conv_init(k, n, width, ch):
        ident = jnp.zeros((width, ch), f32).at[width - 1].set(1.0)
        return ident[None] + nrm(k, (n, width, ch), 0.3)

    x = jax.random.normal(ks[0], (BATCH, SEQ, D_MODEL), f32)
    lstm_gate_bias = jnp.concatenate([
        nrm(ks[8], (n_b, LSTM_HEADS), 0.1),
        jnp.linspace(3.0, 6.0, LSTM_HEADS, dtype=f32)[None] + nrm(ks[9], (n_b, LSTM_HEADS), 0.1)], axis=1)
    return {
        'x': x,
        'attn_norm': gain(ks[1], (n_a, D_MODEL)),
        'attn_w_qkv': nrm(ks[2], (n_a, D_MODEL, 3 * D_MODEL), D_MODEL ** -0.5),
        'attn_q_gain': gain(ks[3], (n_a, ATT_HEAD_DIM)),
        'attn_k_gain': gain(ks[4], (n_a, ATT_HEAD_DIM)),
        'attn_w_o': nrm(ks[5], (n_a, D_MODEL, D_MODEL), res * D_MODEL ** -0.5),
        'lstm_norm': gain(ks[6], (n_b, D_MODEL)),
        'lstm_w_in': nrm(ks[7], (n_b, D_MODEL, LSTM_IN_WIDTH), D_MODEL ** -0.5),
        'lstm_gate_bias': lstm_gate_bias,
        'lstm_conv_w': conv_init(ks[10], n_b, LSTM_CONV, 2 * LSTM_QK_WIDTH),
        'lstm_conv_b': nrm(ks[11], (n_b, 2 * LSTM_QK_WIDTH), 0.01),
        'lstm_head_gain': gain(ks[12], (n_b, D_MODEL)),
        'lstm_w_out': nrm(ks[13], (n_b, D_MODEL, D_MODEL), res * D_MODEL ** -0.5),
        'ffn_norm': gain(ks[14], (DEPTH, D_MODEL)),
        'ffn_w_up': nrm(ks[15], (DEPTH, D_MODEL, 2 * FFN_DIM), D_MODEL ** -0.5),
        'ffn_conv_w': conv_init(ks[16], DEPTH, FFN_CONV, 2 * FFN_DIM),
        'ffn_conv_b': nrm(ks[17], (DEPTH, 2 * FFN_DIM), 0.01),
        'ffn_w_down': nrm(ks[18], (DEPTH, FFN_DIM, D_MODEL), res * FFN_DIM ** -0.5),
    }


def reference(x, attn_norm, attn_w_qkv, attn_q_gain, attn_k_gain, attn_w_o,
              lstm_norm, lstm_w_in, lstm_gate_bias, lstm_conv_w, lstm_conv_b, lstm_head_gain, lstm_w_out,
              ffn_norm, ffn_w_up, ffn_conv_w, ffn_conv_b, ffn_w_down):
    for i in range(DEPTH):
        j = i // N_MIXERS
        if i % N_MIXERS == 0:
            x = x + dilated_attention(x, attn_norm[j], attn_w_qkv[j], attn_q_gain[j], attn_k_gain[j], attn_w_o[j])
        else:
            x = x + mlstm_mixer(x, lstm_norm[j], lstm_w_in[j], lstm_gate_bias[j], lstm_conv_w[j],
                                lstm_conv_b[j], lstm_head_gain[j], lstm_w_out[j])
        x = x + conv_ffn(x, ffn_norm[i], ffn_w_up[i], ffn_conv_w[i], ffn_conv_b[i], ffn_w_down[i])
    return x
```

```cpp
#include <hip/hip_runtime.h>
#include <cstdio>
#include <cstdint>
#include <cstring>

namespace pg8 {
#define PG8_LAS __attribute__((address_space(3)))
typedef unsigned short bf16_t;
typedef short bf16x8 __attribute__((ext_vector_type(8)));
typedef float f32x4 __attribute__((ext_vector_type(4)));
typedef unsigned u32x4 __attribute__((ext_vector_type(4)));
constexpr int BM = 256, BK = 64, HALF = 128, HTB = HALF * BK * 2  , STAGE_BYTES = 8 * HTB, NXCD = 8, WGM = 8;

__host__ __device__ __forceinline__ int lds_byte(int r, int c) { const int st = (r >> 4) * 2 + (c >> 5), rr = r & 15, cc = c & 31, ob = rr * 64 + cc * 2; return st * 1024 + (ob ^ (((ob >> 9) & 1) << 5)); }
__host__ __device__ __forceinline__ void stage_rc(int b, int& R, int& C) { const int st = b / 1024, sb = b % 1024, swz = sb ^ (((sb >> 9) & 1) << 5); R = (st >> 1) * 16 + swz / 64; C = (st & 1) * 32 + (swz % 64) / 2; }
__host__ __device__ __forceinline__ int perm32(int rho) { const int n = rho >> 4, i = rho & 15; return 8 * (i >> 2) + 4 * n + (i & 3); }

struct Unit { int pm, pn; };
struct Gemm { const bf16_t* A; const bf16_t* Bt; int M, N, K; };

struct StaticOrder {
    int nM, nN, nwg, G, c;
    __host__ __device__ void init(int M, int N, int G_, int c_) { nM = M / BM; nN = N / BM; nwg = nM * nN; G = G_; c = c_; }
    __host__ __device__ bool next(int i, Unit& u) const {
        const long L = (long)i * G + c; if (L >= nwg) return false;
        int wgid = (int)L; { const int q = nwg / NXCD, r = nwg % NXCD, xcd = wgid % NXCD, off = wgid / NXCD; wgid = (xcd < r ? xcd * (q + 1) : r * (q + 1) + (xcd - r) * q) + off; }
        const int nig = WGM * nN, gid = wgid / nig, fm = gid * WGM, gsz = (nM - fm) < WGM ? (nM - fm) : WGM;
        u.pm = fm + ((wgid % nig) % gsz); u.pn = (wgid % nig) / gsz; return true;
    }
    __device__ __forceinline__ void a_ready(const Unit&) const {}
    __device__ __forceinline__ void done(const Unit&) const {}
};
__device__ __forceinline__ unsigned cvt_pk_bf16(float lo, float hi) { unsigned r; asm volatile("v_cvt_pk_bf16_f32 %0, %1, %2" : "=v"(r) : "v"(lo), "v"(hi)); return r; }
typedef float f32x2 __attribute__((ext_vector_type(2)));
__device__ __forceinline__ f32x2 gelu_pk(f32x2 v) {
    const f32x2 av = __builtin_elementwise_abs(v), d = av * 0.2316418882f + 1.0f;
    f32x2 t; t.x = __builtin_amdgcn_rcpf(d.x); t.y = __builtin_amdgcn_rcpf(d.y);
    f32x2 q = t * 0.5307027145f + (-0.7265760135f); q = q * t + 0.7107068705f; q = q * t + (-0.142248368f); q = q * t + 0.127414796f; q = q * t;
    const f32x2 s = (v * v) * (-0.72134752044f);
    f32x2 e; e.x = __builtin_amdgcn_exp2f(s.x); e.y = __builtin_amdgcn_exp2f(s.y);
    const f32x2 m = v * (q * e), r = v - m;
    f32x2 o; o.x = v.x < 0.f ? m.x : r.x; o.y = v.y < 0.f ? m.y : r.y; return o;
}

template <int ACT  > struct EpiBf16 {
    static constexpr bool PERM = true, AFTER_DRAIN = false; static_assert(ACT == 0 || ACT == 1, "EpiBf16: ACT is 0 (none) or 1 (gelu_pk)");
    bf16_t* O; int ldc; const float* bias; int split_cols; size_t split_stride; float scale0;
    __device__ __forceinline__ void operator()(const f32x4 (&acc)[2][2][4][2], const Unit& u, int wr, int wc, int fr, int fq) const {
        const int row0 = u.pm * BM + wr * 64 + fr; int colt = u.pn * BM; bf16_t* base = O;
        float sc = 1.f; if (split_cols) { const int t = colt / split_cols; base += (size_t)t * split_stride; colt -= t * split_cols; if (t == 0) sc = scale0; }
        const int col0 = colt + wc * 32 + 8 * fq, bcol0 = u.pn * BM + wc * 32 + 8 * fq;
        f32x4 bv[2][2];
#pragma unroll
        for (int bj = 0; bj < 2; ++bj)
#pragma unroll
            for (int n = 0; n < 2; ++n) bv[bj][n] = bias ? *(const f32x4*)(bias + bcol0 + bj * HALF + 4 * n) : (f32x4){0.f, 0.f, 0.f, 0.f};
#pragma unroll
        for (int ai = 0; ai < 2; ++ai)
#pragma unroll
            for (int m = 0; m < 4; ++m) { bf16_t* rowp = base + (size_t)(row0 + ai * HALF + m * 16) * ldc + col0;
#pragma unroll
                for (int bj = 0; bj < 2; ++bj) { f32x4 v0 = acc[ai][bj][m][0] + bv[bj][0], v1 = acc[ai][bj][m][1] + bv[bj][1];
                    if (ACT == 1) { f32x2 a = gelu_pk((f32x2){v0[0], v0[1]}), b = gelu_pk((f32x2){v0[2], v0[3]}), c = gelu_pk((f32x2){v1[0], v1[1]}), d = gelu_pk((f32x2){v1[2], v1[3]});
                        v0 = (f32x4){a.x, a.y, b.x, b.y}; v1 = (f32x4){c.x, c.y, d.x, d.y}; }
                    v0 = v0 * sc; v1 = v1 * sc; u32x4 w; w.x = cvt_pk_bf16(v0[0], v0[1]); w.y = cvt_pk_bf16(v0[2], v0[3]); w.z = cvt_pk_bf16(v1[0], v1[1]); w.w = cvt_pk_bf16(v1[2], v1[3]);
                    *(u32x4*)(rowp + bj * HALF) = w; } }
    }
};
struct EpiResF32 {
    static constexpr bool PERM = false, AFTER_DRAIN = false;
    const float* base; float* out; int ldc;
    __device__ __forceinline__ void operator()(const f32x4 (&acc)[2][2][4][2], const Unit& u, int wr, int wc, int fr, int fq) const {
        const int row0 = u.pm * BM + wr * 64 + fr, col0 = u.pn * BM + wc * 32 + 4 * fq;
#pragma unroll
        for (int ai = 0; ai < 2; ++ai)
#pragma unroll
            for (int m = 0; m < 4; ++m) { const size_t ro = (size_t)(row0 + ai * HALF + m * 16) * ldc + col0;
#pragma unroll
                for (int bj = 0; bj < 2; ++bj)
#pragma unroll
                    for (int n = 0; n < 2; ++n) { const size_t o = ro + bj * HALF + n * 16; *(f32x4*)(out + o) = *(const f32x4*)(base + o) + acc[ai][bj][m][n]; } }
    }
};
template <class Epi, class Sched, bool ALIGN_EPI = false, bool SP2 = false>
__device__ __forceinline__ void gemm_phase(PG8_LAS unsigned char* lds, const Gemm g, const Sched& S, const Epi& E) {
    const int tid = threadIdx.x, wid = __builtin_amdgcn_readfirstlane(tid >> 6), lane = tid & 63, wr = wid >> 2, wc = wid & 3, fr = lane & 15, fq = lane >> 4;
    const int K = g.K, nt = K / BK;
    unsigned voffA[2], voffB[2];
#pragma unroll
    for (int i = 0; i < 2; ++i) { int R, C; stage_rc(tid * 16 + i * 8192, R, C); const int Rb = Epi::PERM ? ((R & ~31) + perm32(R & 31)) : R;
        voffA[i] = (unsigned)(R * K + C) * 2u; voffB[i] = (unsigned)(Rb * K + C) * 2u; }
    const size_t kstep = (size_t)(BK * 2);
    const size_t hstep = (size_t)HALF * K * 2;
    const size_t tstep = 2 * hstep;
    const unsigned ldsw = (unsigned)wid * 1024u;
    const int aoff = lds_byte(wr * 64 + fr, fq * 8), boff = lds_byte(wc * 32 + fr, fq * 8);
#define PG8_SA(b, h) (((b) * 2 + (h)) * HTB)
#define PG8_SB(b, h) ((4 + (b) * 2 + (h)) * HTB)
#define PG8_STAGE(bufoff, gbase, voff) do { _Pragma("unroll") for (int _i = 0; _i < 2; ++_i) \
        __builtin_amdgcn_global_load_lds((const unsigned*)((const char*)(gbase) + (voff)[_i]), (PG8_LAS unsigned*)(lds + (bufoff) + ldsw + _i * 8192), 16, 0, 0); } while (0)
#define PG8_LDA(dst, b, h) do { _Pragma("unroll") for (int m = 0; m < 4; ++m) _Pragma("unroll") for (int k = 0; k < 2; ++k) dst[m][k] = *(const PG8_LAS bf16x8*)(lds + PG8_SA(b, h) + aoff + m * 2048 + k * 1024); } while (0)
#define PG8_LDB(dst, b, h) do { _Pragma("unroll") for (int n = 0; n < 2; ++n) _Pragma("unroll") for (int k = 0; k < 2; ++k) dst[n][k] = *(const PG8_LAS bf16x8*)(lds + PG8_SB(b, h) + boff + n * 2048 + k * 1024); } while (0)
#define PG8_MMA(ai, bj, At, Bt) do { __builtin_amdgcn_s_setprio(1); _Pragma("unroll") for (int m = 0; m < 4; ++m) _Pragma("unroll") for (int n = 0; n < 2; ++n) _Pragma("unroll") for (int k = 0; k < 2; ++k) \
        acc[ai][bj][m][n] = __builtin_amdgcn_mfma_f32_16x16x32_bf16(Bt[n][k], At[m][k], acc[ai][bj][m][n], 0, 0, 0); __builtin_amdgcn_s_setprio(0); } while (0)
#define PG8_WAIT_V(n) asm volatile("s_waitcnt vmcnt(" #n ")" ::: "memory")
#define PG8_WAIT_L(n) asm volatile("s_waitcnt lgkmcnt(" #n ")" ::: "memory")
#define PG8_BAR __builtin_amdgcn_s_barrier()
#define PG8_SCHED __builtin_amdgcn_sched_barrier(0)
    Unit cur, nxt; int ui = 0;
    if (!S.next(0, cur)) return;
    f32x4 acc[2][2][4][2];
#pragma unroll
    for (int a = 0; a < 2; ++a)
#pragma unroll
        for (int b = 0; b < 2; ++b)
#pragma unroll
            for (int m = 0; m < 4; ++m)
#pragma unroll
                for (int n = 0; n < 2; ++n) acc[a][b][m][n] = (f32x4){0.f, 0.f, 0.f, 0.f};
    bf16x8 At[4][2], B0[2][2], B1[2][2];
    const char* cA = (const char*)g.A + (size_t)cur.pm * tstep; const char* cB = (const char*)g.Bt + (size_t)cur.pn * tstep;
    S.a_ready(cur);
    if constexpr (SP2) {
        PG8_STAGE(PG8_SB(0, 0), cB, voffB); PG8_STAGE(PG8_SB(0, 1), cB + hstep, voffB); PG8_STAGE(PG8_SA(0, 0), cA, voffA); PG8_STAGE(PG8_SA(0, 1), cA + hstep, voffA);
        if (wr == 1) PG8_BAR;
        PG8_WAIT_V(2); PG8_BAR;
        PG8_STAGE(PG8_SB(1, 0), cB + kstep, voffB); PG8_STAGE(PG8_SA(1, 0), cA + kstep, voffA); PG8_STAGE(PG8_SB(1, 1), cB + hstep + kstep, voffB);
        PG8_WAIT_V(6); PG8_BAR;
    } else {
        PG8_STAGE(PG8_SB(0, 0), cB, voffB); PG8_STAGE(PG8_SA(0, 0), cA, voffA); PG8_STAGE(PG8_SB(0, 1), cB + hstep, voffB); PG8_STAGE(PG8_SA(0, 1), cA + hstep, voffA);
        if (wr == 1) PG8_BAR;
        PG8_WAIT_V(4); PG8_BAR;
        PG8_STAGE(PG8_SB(1, 0), cB + kstep, voffB); PG8_STAGE(PG8_SA(1, 0), cA + kstep, voffA); PG8_STAGE(PG8_SB(1, 1), cB + hstep + kstep, voffB);
        PG8_WAIT_V(6); PG8_BAR;
    }
    for (;;) {
        const bool has_next = S.next(ui + 1, nxt);
        const char* nA = has_next ? (const char*)g.A + (size_t)nxt.pm * tstep : cA; const char* nB = has_next ? (const char*)g.Bt + (size_t)nxt.pn * tstep : cB;
        for (int t = 0; t < nt; t += 2) {
            const bool last = (t == nt - 2);
            const char* a1 = cA + (size_t)(t + 1) * kstep;
            const char* a2 = last ? nA : cA + (size_t)(t + 2) * kstep; const char* b2 = last ? nB : cB + (size_t)(t + 2) * kstep;
            const char* a3 = a2 + kstep; const char* b3 = b2 + kstep;
            if (last && has_next) S.a_ready(nxt);
            if constexpr (SP2) {
            PG8_LDB(B0, 0, 0); PG8_LDB(B1, 0, 1); PG8_SCHED; PG8_LDA(At, 0, 0); PG8_STAGE(PG8_SA(1, 1), a1 + hstep, voffA);
            PG8_WAIT_V(8); PG8_WAIT_L(0); PG8_BAR; PG8_MMA(0, 0, At, B0); PG8_MMA(0, 1, At, B1); PG8_BAR; PG8_SCHED;
            PG8_LDA(At, 0, 1); PG8_STAGE(PG8_SB(0, 0), b2, voffB); PG8_STAGE(PG8_SB(0, 1), b2 + hstep, voffB); PG8_STAGE(PG8_SA(0, 0), a2, voffA);
            PG8_WAIT_V(8); PG8_WAIT_L(0); PG8_BAR; PG8_MMA(1, 0, At, B0); PG8_MMA(1, 1, At, B1); PG8_BAR; PG8_SCHED;
            PG8_LDB(B0, 1, 0); PG8_LDB(B1, 1, 1); PG8_SCHED; PG8_LDA(At, 1, 0); PG8_STAGE(PG8_SA(0, 1), a2 + hstep, voffA);
            PG8_WAIT_V(8); PG8_WAIT_L(0); PG8_BAR; PG8_MMA(0, 0, At, B0); PG8_MMA(0, 1, At, B1); PG8_BAR; PG8_SCHED;
            PG8_LDA(At, 1, 1); PG8_STAGE(PG8_SB(1, 0), b3, voffB); PG8_STAGE(PG8_SB(1, 1), b3 + hstep, voffB); PG8_STAGE(PG8_SA(1, 0), a3, voffA);
            PG8_WAIT_V(8); PG8_WAIT_L(0); PG8_BAR; PG8_MMA(1, 0, At, B0); PG8_MMA(1, 1, At, B1); PG8_BAR; PG8_SCHED;
            } else {
            PG8_LDB(B0, 0, 0); PG8_SCHED; PG8_LDA(At, 0, 0); PG8_STAGE(PG8_SA(1, 1), a1 + hstep, voffA);
            PG8_WAIT_L(8); PG8_BAR; PG8_WAIT_L(0); PG8_MMA(0, 0, At, B0); PG8_BAR; PG8_SCHED;
            PG8_LDB(B1, 0, 1); PG8_STAGE(PG8_SB(0, 0), b2, voffB);
            PG8_BAR; PG8_WAIT_L(0); PG8_MMA(0, 1, At, B1); PG8_BAR;
            PG8_LDA(At, 0, 1); PG8_STAGE(PG8_SA(0, 0), a2, voffA);
            PG8_BAR; PG8_WAIT_L(0); PG8_MMA(1, 0, At, B0); PG8_BAR; PG8_SCHED;
            PG8_STAGE(PG8_SB(0, 1), b2 + hstep, voffB);
            PG8_WAIT_V(6); PG8_BAR; PG8_MMA(1, 1, At, B1); PG8_BAR;
            PG8_LDB(B0, 1, 0); PG8_SCHED; PG8_LDA(At, 1, 0); PG8_STAGE(PG8_SA(0, 1), a2 + hstep, voffA);
            PG8_WAIT_L(8); PG8_BAR; PG8_WAIT_L(0); PG8_MMA(0, 0, At, B0); PG8_BAR; PG8_SCHED;
            PG8_LDB(B1, 1, 1); PG8_STAGE(PG8_SB(1, 0), b3, voffB);
            PG8_BAR; PG8_WAIT_L(0); PG8_MMA(0, 1, At, B1); PG8_BAR;
            PG8_LDA(At, 1, 1); PG8_STAGE(PG8_SA(1, 0), a3, voffA);
            PG8_BAR; PG8_WAIT_L(0); PG8_MMA(1, 0, At, B0); PG8_BAR; PG8_SCHED;
            PG8_STAGE(PG8_SB(1, 1), b3 + hstep, voffB);
            PG8_WAIT_V(6); PG8_BAR; PG8_MMA(1, 1, At, B1); PG8_BAR;
            }
        }
        if constexpr (ALIGN_EPI) { if (wr == 0) PG8_BAR; }
        if constexpr (!Epi::AFTER_DRAIN) { E(acc, cur, wr, wc, fr, fq); S.done(cur); }
        if (!has_next) break;
#pragma unroll
        for (int a = 0; a < 2; ++a)
#pragma unroll
            for (int b = 0; b < 2; ++b)
#pragma unroll
                for (int m = 0; m < 4; ++m)
#pragma unroll
                    for (int n = 0; n < 2; ++n) acc[a][b][m][n] = (f32x4){0.f, 0.f, 0.f, 0.f};
        cur = nxt; cA = nA; cB = nB; ++ui;
        if constexpr (ALIGN_EPI) { if (wr == 1) PG8_BAR; }
    }
    PG8_WAIT_V(0);
    if constexpr (!ALIGN_EPI) { if (wr == 0) PG8_BAR; }
    PG8_BAR;
    if constexpr (Epi::AFTER_DRAIN) { E.fused(acc, cur, wr, wc, fr, fq, lds, wid, lane); S.done(cur); }
#undef PG8_SA
#undef PG8_SB
#undef PG8_STAGE
#undef PG8_LDA
#undef PG8_LDB
#undef PG8_MMA
#undef PG8_WAIT_V
#undef PG8_WAIT_L
#undef PG8_BAR
#undef PG8_SCHED
}
}

constexpr int BATCH = 2, SEQ = 4096, DM = 2048, MROWS = BATCH * SEQ;
constexpr int AH = 16, AHD = 128, NQKV = 3 * DM;
constexpr int LH = 4, LDV = 512, LDK = 256, QKW = 1024, INW = 6152, INW_MAIN = 6144;
constexpr int FFN = 5632, FFN2 = 2 * FFN;
constexpr float NORM_EPS = 1e-6f;

typedef unsigned short bf16;
typedef unsigned v4u __attribute__((ext_vector_type(4)));
typedef unsigned v2u __attribute__((ext_vector_type(2)));
typedef float f32x4 __attribute__((ext_vector_type(4)));
#define LAS __attribute__((address_space(3)))

__device__ __forceinline__ unsigned f2bf(float f) { unsigned u = __builtin_bit_cast(unsigned, f); return (u + 0x7fffu + ((u >> 16) & 1u)) >> 16; }
__device__ __forceinline__ unsigned pk2(float lo, float hi) { return f2bf(lo) | (f2bf(hi) << 16); }
__device__ __forceinline__ float bf2f(unsigned short b) { return __builtin_bit_cast(float, (unsigned)b << 16); }
__device__ __forceinline__ float bflo(unsigned w) { return __builtin_bit_cast(float, w << 16); }
__device__ __forceinline__ float bfhi(unsigned w) { return __builtin_bit_cast(float, w & 0xffff0000u); }
__device__ __forceinline__ float wave_sum(float v) {
#pragma unroll
    for (int o = 1; o < 64; o <<= 1) v += __shfl_xor(v, o);
    return v;
}
__device__ __forceinline__ float sigmoidf_(float x) { return 1.f / (1.f + __expf(-x)); }
__device__ __forceinline__ float siluf_(float x) { return x / (1.f + __expf(-x)); }

constexpr size_t MiB = 1u << 20;
constexpr size_t WS_CTL = 0;
constexpr size_t WS_WQKV = 1 * MiB;
constexpr size_t WS_WO   = WS_WQKV + (size_t)NQKV * DM * 2;
constexpr size_t WS_WIN  = WS_WO + (size_t)DM * DM * 2;
constexpr size_t WS_WOUT = WS_WIN + (size_t)INW_MAIN * DM * 2;
constexpr size_t WS_WUP  = WS_WOUT + (size_t)DM * DM * 2;
constexpr size_t WS_WDN  = WS_WUP + 2 * (size_t)FFN2 * DM * 2;
constexpr size_t WS_HN   = WS_WDN + 2 * (size_t)DM * FFN * 2;
constexpr size_t WS_G    = WS_HN + (size_t)MROWS * DM * 2;
constexpr size_t WS_R    = WS_G + (size_t)MROWS * FFN * 2;
constexpr size_t WS_QKV  = WS_R;
constexpr size_t WS_O    = WS_QKV + (size_t)MROWS * NQKV * 2;
constexpr size_t WS_QKC  = WS_O + (size_t)MROWS * DM * 2;
constexpr size_t WS_HS   = WS_QKC + (size_t)MROWS * DM * 2;
constexpr size_t WS_U    = WS_R;
constexpr size_t WS_REND = WS_HS + (size_t)MROWS * DM * 4;
static_assert(WS_U + (size_t)MROWS * FFN2 * 2 <= WS_REND, "U overlay");
constexpr size_t WS_GATES = WS_REND;
constexpr size_t WS_SU   = WS_GATES + (size_t)MROWS * 8 * 4;
constexpr size_t WS_SM   = WS_SU + 8 * SEQ * 4;
constexpr size_t WS_SE   = WS_SM + 8 * SEQ * 4;
constexpr size_t WS_END  = WS_SE + 8 * SEQ * 4;

__device__ __forceinline__ void transpose_item(const float* W, int K, int ldn, int nblk, bf16* WT, LAS float* scr, int item, int lane) {
    const int kb = item / nblk, nb = item % nblk, k0 = 64 * kb, n0 = 32 * nb;
#pragma unroll 8
    for (int i = 0; i < 32; ++i) { const int kk = 2 * i + (lane >> 5); scr[kk * 33 + (lane & 31)] = W[(size_t)(k0 + kk) * ldn + n0 + (lane & 31)]; }
    asm volatile("s_waitcnt lgkmcnt(0)" ::: "memory");
    const int c = lane & 7;
#pragma unroll
    for (int j = 0; j < 4; ++j) { const int n = (lane >> 3) + 8 * j; const LAS float* s = scr + (8 * c) * 33 + n;
        v4u o; o.x = pk2(s[0 * 33], s[1 * 33]); o.y = pk2(s[2 * 33], s[3 * 33]); o.z = pk2(s[4 * 33], s[5 * 33]); o.w = pk2(s[6 * 33], s[7 * 33]);
        *(v4u*)(WT + (size_t)(n0 + n) * K + k0 + 8 * c) = o; }
    asm volatile("s_waitcnt lgkmcnt(0)" ::: "memory");
}
struct ConvJob { const float* W; bf16* WT; int K, ldn, N, pad; };
struct ConvArgs { ConvJob j[8]; };
__global__ void __launch_bounds__(256) k_convert(ConvArgs a) {
    __shared__ float scr_all[4][64 * 33];
    const int lane = threadIdx.x & 63, w = threadIdx.x >> 6;
    LAS float* scr = (LAS float*)&scr_all[w][0];
    const int gw = blockIdx.x * 4 + w, NGW = gridDim.x * 4;
    for (int q = 0; q < 8; ++q) {
        const ConvJob J = a.j[q]; const int nblk = J.N / 32, items = (J.K / 64) * nblk;
        for (int it = gw; it < items; it += NGW) transpose_item(J.W, J.K, J.ldn, nblk, J.WT, scr, it, lane);
    }
}

__global__ void __launch_bounds__(256) k_rmsnorm(const float* x, const float* g, bf16* hn, const float* w_in  , const float* gate_bias, float* gates) {
    const int lane = threadIdx.x & 63; const int row = blockIdx.x * 4 + (threadIdx.x >> 6);
    if (row >= MROWS) return;
    const f32x4* xr = (const f32x4*)(x + (size_t)row * DM) + lane;
    f32x4 v[8]; float s = 0.f;
#pragma unroll
    for (int j = 0; j < 8; ++j) { v[j] = xr[64 * j]; s += (v[j].x * v[j].x + v[j].y * v[j].y) + (v[j].z * v[j].z + v[j].w * v[j].w); }
    const float rstd = 1.f / sqrtf(wave_sum(s) * (1.f / DM) + NORM_EPS);
    v2u* o8 = (v2u*)(hn + (size_t)row * DM) + lane;
#pragma unroll
    for (int j = 0; j < 8; ++j) { const f32x4 gg = ((const f32x4*)g)[64 * j + lane]; v[j] = v[j] * rstd * gg; v2u w; w.x = pk2(v[j].x, v[j].y); w.y = pk2(v[j].z, v[j].w); o8[64 * j] = w; }
    if (w_in) {
        float acc[8];
#pragma unroll
        for (int q = 0; q < 8; ++q) acc[q] = 0.f;
#pragma unroll
        for (int j = 0; j < 8; ++j)
#pragma unroll
            for (int e = 0; e < 4; ++e) { const int k = 4 * (64 * j + lane) + e; const float* wp = w_in + (size_t)k * INW + INW_MAIN; const f32x4 a = *(const f32x4*)wp, b = *(const f32x4*)(wp + 4); const float hv = v[j][e];
                acc[0] += hv * a.x; acc[1] += hv * a.y; acc[2] += hv * a.z; acc[3] += hv * a.w; acc[4] += hv * b.x; acc[5] += hv * b.y; acc[6] += hv * b.z; acc[7] += hv * b.w; }
#pragma unroll
        for (int q = 0; q < 8; ++q) acc[q] = wave_sum(acc[q]);
        if (lane < 8) { float r = acc[0];
#pragma unroll
            for (int q = 1; q < 8; ++q) r = (lane == q) ? acc[q] : r;
            gates[(size_t)row * 8 + lane] = r + gate_bias[lane]; }
    }
}

constexpr int GEMM_LDS = pg8::STAGE_BYTES;
struct GemmArgs { const bf16* A; const bf16* Bt; void* out; const float* base; int M, N, K, pad; };
__global__ void __launch_bounds__(512, 2) k_gemm_bf16(GemmArgs a) {
    extern __shared__ __attribute__((aligned(16))) unsigned char lds[];
    pg8::Gemm g{a.A, a.Bt, a.M, a.N, a.K}; pg8::EpiBf16<0> E{(bf16*)a.out, a.N, nullptr, 0, 0, 1.f};
    pg8::StaticOrder S; S.init(g.M, g.N, gridDim.x, blockIdx.x);
    pg8::gemm_phase<pg8::EpiBf16<0>, pg8::StaticOrder, true, true>((PG8_LAS unsigned char*)lds, g, S, E);
}
__global__ void __launch_bounds__(512, 2) k_gemm_res(GemmArgs a) {
    extern __shared__ __attribute__((aligned(16))) unsigned char lds[];
    pg8::Gemm g{a.A, a.Bt, a.M, a.N, a.K}; pg8::EpiResF32 E{a.base, (float*)a.out, a.N};
    pg8::StaticOrder S; S.init(g.M, g.N, gridDim.x, blockIdx.x);
    pg8::gemm_phase<pg8::EpiResF32, pg8::StaticOrder, true, true>((PG8_LAS unsigned char*)lds, g, S, E);
}

__global__ void __launch_bounds__(256) k_attn_naive(const bf16* qkv, const float* qg, const float* kg, bf16* o) {
    const int lane = threadIdx.x & 63; const int wv = blockIdx.x * 4 + (threadIdx.x >> 6);
    const int h = wv & 15, row = wv >> 4, t = row & (SEQ - 1), d0 = 2 * lane;
    const unsigned qw = *(const unsigned*)(qkv + (size_t)row * NQKV + h * AHD + d0);
    float q0 = bflo(qw), q1 = bfhi(qw);
    const float rq = 1.f / sqrtf(wave_sum(q0 * q0 + q1 * q1) * (1.f / AHD) + NORM_EPS);
    const float scale = 0.08838834764831845f;
    q0 = q0 * rq * qg[d0] * scale * kg[d0]; q1 = q1 * rq * qg[d0 + 1] * scale * kg[d0 + 1];
    float m = -INFINITY, l = 0.f, a0 = 0.f, a1 = 0.f;
    for (int g = 0; g < 3; ++g) {
        const int dil = (g == 0) ? 1 : (g == 1) ? 4 : 16;
        for (int j = 0; j <= 128; ++j) {
            const int s = t - j * dil; if (s < 0) break;
            const bf16* kr = qkv + (size_t)(row - j * dil) * NQKV + DM + h * AHD + d0;
            const unsigned kw = *(const unsigned*)kr, vw = *(const unsigned*)(kr + DM);
            const float k0 = bflo(kw), k1 = bfhi(kw);
            float kss = k0 * k0 + k1 * k1, dot = q0 * k0 + q1 * k1;
#pragma unroll
            for (int of = 1; of < 64; of <<= 1) { kss += __shfl_xor(kss, of); dot += __shfl_xor(dot, of); }
            const float sc = dot / sqrtf(kss * (1.f / AHD) + NORM_EPS);
            const float mn = fmaxf(m, sc), corr = __expf(m - mn), p = __expf(sc - mn);
            l = l * corr + p; a0 = a0 * corr + p * bflo(vw); a1 = a1 * corr + p * bfhi(vw); m = mn;
        }
    }
    const float il = 1.f / l;
    *(unsigned*)(o + (size_t)row * DM + h * AHD + d0) = pk2(a0 * il, a1 * il);
}

__global__ void __launch_bounds__(256) k_ffn_gate(const bf16* u, const float* cw  , const float* cb  , bf16* g) {
    const size_t idx = (size_t)blockIdx.x * 256 + threadIdx.x;
    const int cp = (int)(idx % (FFN / 2)), row = (int)(idx / (FFN / 2)); if (row >= MROWS) return;
    const int c = 2 * cp, t = row & (SEQ - 1);
    float ga0 = cb[c], ga1 = cb[c + 1], up0 = cb[FFN + c], up1 = cb[FFN + c + 1];
#pragma unroll
    for (int j = 0; j < 3; ++j) { const int tt = t - 2 + j; if (tt < 0) continue;
        const bf16* ur = u + (size_t)(row - 2 + j) * FFN2; const unsigned a = *(const unsigned*)(ur + c), b = *(const unsigned*)(ur + FFN + c);
        ga0 += cw[j * FFN2 + c] * bflo(a); ga1 += cw[j * FFN2 + c + 1] * bfhi(a); up0 += cw[j * FFN2 + FFN + c] * bflo(b); up1 += cw[j * FFN2 + FFN + c + 1] * bfhi(b); }
    *(unsigned*)(g + (size_t)row * FFN + c) = pk2(siluf_(ga0) * up0, siluf_(ga1) * up1);
}

__global__ void __launch_bounds__(256) k_lstm_conv(const bf16* z  , const float* cw  , const float* cb, bf16* qk  ) {
    const size_t idx = (size_t)blockIdx.x * 256 + threadIdx.x; const int cp = (int)(idx % (DM / 2)), row = (int)(idx / (DM / 2)); if (row >= MROWS) return;
    const int c = 2 * cp, t = row & (SEQ - 1);
    float a0 = cb[c], a1 = cb[c + 1];
#pragma unroll
    for (int j = 0; j < 4; ++j) { const int tt = t - 3 + j; if (tt < 0) continue; const unsigned w = *(const unsigned*)(z + (size_t)(row - 3 + j) * INW_MAIN + c);
        a0 += cw[j * DM + c] * bflo(w); a1 += cw[j * DM + c + 1] * bfhi(w); }
    const float sc = (c >= QKW) ? 0.0625f : 1.f;
    *(unsigned*)(qk + (size_t)row * DM + c) = pk2(siluf_(a0) * sc, siluf_(a1) * sc);
}

__global__ void k_lstm_scan(const float* gates, float* U, float* Mx, float* E) {
    if (threadIdx.x != 0) return;
    const int bh = blockIdx.x, b = bh >> 2, h = bh & 3;
    float F = 0.f, mm = 0.f;
    for (int t = 0; t < SEQ; ++t) { const float* gr = gates + (size_t)(b * SEQ + t) * 8; const float li = gr[h], fg = gr[4 + h];
        const float lf = (fg >= 0.f) ? -log1pf(__expf(-fg)) : fg - log1pf(__expf(fg));
        F += lf; const float u = li - F; mm = fmaxf(mm, u);
        U[bh * SEQ + t] = u; Mx[bh * SEQ + t] = mm; E[bh * SEQ + t] = __expf(-(F + mm)); }
}

__global__ void __launch_bounds__(256) k_lstm_naive(const bf16* qk  , const bf16* z  , const float* U, const float* Mx, const float* E, float* hs) {
    __shared__ unsigned short qs[32][256]; __shared__ unsigned short ks[16][256]; __shared__ unsigned short vs[16][512]; __shared__ float ws_[32][16];
    const int tid = threadIdx.x, bh = blockIdx.x >> 7, tt = blockIdx.x & 127, b = bh >> 2, h = bh & 3, t0 = tt * 32;
    const size_t rbase = (size_t)b * SEQ;
    for (int i = tid; i < 32 * 32; i += 256) { const int r = i >> 5, c8 = i & 31; *(v4u*)&qs[r][c8 * 8] = *(const v4u*)(qk + (rbase + t0 + r) * DM + h * LDK + c8 * 8); }
    const int tq = tid >> 3, cq = tid & 7;
    float acc[64]; float den = 0.f;
#pragma unroll
    for (int i = 0; i < 64; ++i) acc[i] = 0.f;
    const float Mt = Mx[bh * SEQ + t0 + tq];
    const int nst = (t0 + 32) / 16;
    for (int st = 0; st < nst; ++st) {
        const int s0 = st * 16;
        __syncthreads();
        for (int i = tid; i < 16 * 32; i += 256) { const int r = i >> 5, c8 = i & 31; *(v4u*)&ks[r][c8 * 8] = *(const v4u*)(qk + (rbase + s0 + r) * DM + QKW + h * LDK + c8 * 8); }
        for (int i = tid; i < 16 * 64; i += 256) { const int r = i >> 6, c8 = i & 63; *(v4u*)&vs[r][c8 * 8] = *(const v4u*)(z + (rbase + s0 + r) * INW_MAIN + 2 * QKW + h * LDV + c8 * 8); }
        __syncthreads();
        for (int e = 0; e < 2; ++e) { const int id = tid * 2 + e, q_ = id >> 4, sk = id & 15; float d = 0.f;
            for (int c = 0; c < 256; c += 2) { const unsigned a = *(const unsigned*)&qs[q_][c], bb = *(const unsigned*)&ks[sk][c]; d += bflo(a) * bflo(bb) + bfhi(a) * bfhi(bb); }
            const int s = s0 + sk, t = t0 + q_;
            ws_[q_][sk] = (s <= t) ? d * __expf(U[bh * SEQ + s] - Mx[bh * SEQ + t]) : 0.f; }
        __syncthreads();
        for (int sk = 0; sk < 16; ++sk) { const float w = ws_[tq][sk]; den += w;
#pragma unroll
            for (int i = 0; i < 32; ++i) { const unsigned vv = *(const unsigned*)&vs[sk][16 * i + 2 * cq]; acc[2 * i] += w * bflo(vv); acc[2 * i + 1] += w * bfhi(vv); } }
    }
    (void)Mt;
    const float dn = 1.f / fmaxf(fabsf(den), E[bh * SEQ + t0 + tq]);
    float* orow = hs + (rbase + t0 + tq) * DM + h * LDV;
#pragma unroll
    for (int i = 0; i < 32; ++i) { orow[16 * i + 2 * cq] = acc[2 * i] * dn; orow[16 * i + 2 * cq + 1] = acc[2 * i + 1] * dn; }
}

__global__ void __launch_bounds__(256) k_lstm_post(const float* hs, const float* hg, const bf16* z, bf16* o) {
    const int lane = threadIdx.x & 63; const int wv = blockIdx.x * 4 + (threadIdx.x >> 6); const int h = wv & 3, row = wv >> 2; if (row >= MROWS) return;
    const float* hr = hs + (size_t)row * DM + h * LDV; float v[8]; float s = 0.f;
    const f32x4 a = *(const f32x4*)(hr + lane * 8), b = *(const f32x4*)(hr + lane * 8 + 4);
    v[0] = a.x; v[1] = a.y; v[2] = a.z; v[3] = a.w; v[4] = b.x; v[5] = b.y; v[6] = b.z; v[7] = b.w;
#pragma unroll
    for (int i = 0; i < 8; ++i) s += v[i] * v[i];
    const float rstd = 1.f / sqrtf(wave_sum(s) * (1.f / LDV) + NORM_EPS);
    const v4u og = *(const v4u*)(z + (size_t)row * INW_MAIN + 2 * QKW + DM + h * LDV + lane * 8);
    const float* gp = hg + h * LDV + lane * 8;
    float r[8];
#pragma unroll
    for (int i = 0; i < 8; ++i) { const unsigned w = og[i >> 1]; const float gt = (i & 1) ? bfhi(w) : bflo(w); r[i] = v[i] * rstd * gp[i] * sigmoidf_(gt); }
    v4u w; w.x = pk2(r[0], r[1]); w.y = pk2(r[2], r[3]); w.z = pk2(r[4], r[5]); w.w = pk2(r[6], r[7]);
    *(v4u*)(o + (size_t)row * DM + h * LDV + lane * 8) = w;
}

static void launch_gemm_bf16(const bf16* A, const bf16* Bt, int M, int N, int K, bf16* O, int grid, hipStream_t st) {
    GemmArgs a; memset(&a, 0, sizeof(a)); a.A = A; a.Bt = Bt; a.out = O; a.base = nullptr; a.M = M; a.N = N; a.K = K;
    hipLaunchKernelGGL(k_gemm_bf16, dim3(grid), dim3(512), GEMM_LDS, st, a);
}
static void launch_gemm_res(const bf16* A, const bf16* Bt, int M, int N, int K, const float* base, float* out, int grid, hipStream_t st) {
    GemmArgs a; memset(&a, 0, sizeof(a)); a.A = A; a.Bt = Bt; a.out = out; a.base = base; a.M = M; a.N = N; a.K = K;
    hipLaunchKernelGGL(k_gemm_res, dim3(grid), dim3(512), GEMM_LDS, st, a);
}
static void set_job(ConvJob& j, const float* W, bf16* WT, int K, int ldn, int N) { j.W = W; j.WT = WT; j.K = K; j.ldn = ldn; j.N = N; }

extern "C" void kernel_launch(void* const* d_in, const int* in_sizes, int n_in, void* d_out, int out_size, void* d_ws, size_t ws_size, hipStream_t stream) {
    static int grid = 0;
    if (grid == 0) {
        if (n_in != 18 || in_sizes[0] != MROWS * DM || out_size != MROWS * DM || ws_size < WS_END) { fprintf(stderr, "kernel_launch: unexpected problem (n_in %d, ws %zu < %zu)\n", n_in, ws_size, (size_t)WS_END); grid = -1; return; }
        int dev = 0, cus = 0; hipGetDevice(&dev); hipDeviceGetAttribute(&cus, hipDeviceAttributeMultiprocessorCount, dev);
        hipFuncSetAttribute((const void*)k_gemm_bf16, hipFuncAttributeMaxDynamicSharedMemorySize, GEMM_LDS);
        hipFuncSetAttribute((const void*)k_gemm_res, hipFuncAttributeMaxDynamicSharedMemorySize, GEMM_LDS);
        grid = cus > 0 ? cus : 256;
    }
    if (grid < 0) return;
    const float* x = (const float*)d_in[0];
    const float *attn_norm = (const float*)d_in[1], *w_qkv = (const float*)d_in[2], *q_gain = (const float*)d_in[3], *k_gain = (const float*)d_in[4], *w_o = (const float*)d_in[5];
    const float *lstm_norm = (const float*)d_in[6], *w_in = (const float*)d_in[7], *gate_bias = (const float*)d_in[8], *lconv_w = (const float*)d_in[9], *lconv_b = (const float*)d_in[10], *head_gain = (const float*)d_in[11], *w_out = (const float*)d_in[12];
    const float *ffn_norm = (const float*)d_in[13], *w_up = (const float*)d_in[14], *fconv_w = (const float*)d_in[15], *fconv_b = (const float*)d_in[16], *w_down = (const float*)d_in[17];
    unsigned char* ws = (unsigned char*)d_ws; float* out = (float*)d_out;
    bf16 *Wqkv = (bf16*)(ws + WS_WQKV), *Wo = (bf16*)(ws + WS_WO), *Win = (bf16*)(ws + WS_WIN), *Wout = (bf16*)(ws + WS_WOUT), *Wup = (bf16*)(ws + WS_WUP), *Wdn = (bf16*)(ws + WS_WDN);
    bf16 *HN = (bf16*)(ws + WS_HN), *G = (bf16*)(ws + WS_G), *QKV = (bf16*)(ws + WS_QKV), *O = (bf16*)(ws + WS_O), *QKC = (bf16*)(ws + WS_QKC), *U = (bf16*)(ws + WS_U);
    float *HS = (float*)(ws + WS_HS), *GATES = (float*)(ws + WS_GATES), *SU = (float*)(ws + WS_SU), *SM = (float*)(ws + WS_SM), *SE = (float*)(ws + WS_SE);

    ConvArgs ca; memset(&ca, 0, sizeof(ca));
    set_job(ca.j[0], w_qkv, Wqkv, DM, NQKV, NQKV);
    set_job(ca.j[1], w_o, Wo, DM, DM, DM);
    set_job(ca.j[2], w_in, Win, DM, INW, INW_MAIN);
    set_job(ca.j[3], w_out, Wout, DM, DM, DM);
    set_job(ca.j[4], w_up, Wup, DM, FFN2, FFN2);
    set_job(ca.j[5], w_up + (size_t)DM * FFN2, Wup + (size_t)FFN2 * DM, DM, FFN2, FFN2);
    set_job(ca.j[6], w_down, Wdn, FFN, DM, DM);
    set_job(ca.j[7], w_down + (size_t)FFN * DM, Wdn + (size_t)DM * FFN, FFN, DM, DM);
    hipLaunchKernelGGL(k_convert, dim3(grid * 4), dim3(256), 0, stream, ca);

    hipLaunchKernelGGL(k_rmsnorm, dim3(MROWS / 4), dim3(256), 0, stream, x, attn_norm, HN, (const float*)nullptr, (const float*)nullptr, (float*)nullptr);
    launch_gemm_bf16(HN, Wqkv, MROWS, NQKV, DM, QKV, grid, stream);
    hipLaunchKernelGGL(k_attn_naive, dim3(MROWS * AH / 4), dim3(256), 0, stream, QKV, q_gain, k_gain, O);
    launch_gemm_res(O, Wo, MROWS, DM, DM, x, out, grid, stream);
    hipLaunchKernelGGL(k_rmsnorm, dim3(MROWS / 4), dim3(256), 0, stream, (const float*)out, ffn_norm, HN, (const float*)nullptr, (const float*)nullptr, (float*)nullptr);
    launch_gemm_bf16(HN, Wup, MROWS, FFN2, DM, U, grid, stream);
    hipLaunchKernelGGL(k_ffn_gate, dim3((unsigned)((size_t)MROWS * (FFN / 2) / 256)), dim3(256), 0, stream, U, fconv_w, fconv_b, G);
    launch_gemm_res(G, Wdn, MROWS, DM, FFN, out, out, grid, stream);
    hipLaunchKernelGGL(k_rmsnorm, dim3(MROWS / 4), dim3(256), 0, stream, (const float*)out, lstm_norm, HN, w_in, gate_bias, GATES);
    launch_gemm_bf16(HN, Win, MROWS, INW_MAIN, DM, QKV, grid, stream);
    hipLaunchKernelGGL(k_lstm_conv, dim3((unsigned)((size_t)MROWS * (DM / 2) / 256)), dim3(256), 0, stream, QKV, lconv_w, lconv_b, QKC);
    hipLaunchKernelGGL(k_lstm_scan, dim3(8), dim3(64), 0, stream, GATES, SU, SM, SE);
    hipLaunchKernelGGL(k_lstm_naive, dim3(8 * 128), dim3(256), 0, stream, QKC, QKV, SU, SM, SE, HS);
    hipLaunchKernelGGL(k_lstm_post, dim3(MROWS * LH / 4), dim3(256), 0, stream, HS, head_gain, QKV, O);
    launch_gemm_res(O, Wout, MROWS, DM, DM, out, out, grid, stream);
    hipLaunchKernelGGL(k_rmsnorm, dim3(MROWS / 4), dim3(256), 0, stream, (const float*)out, ffn_norm + DM, HN, (const float*)nullptr, (const float*)nullptr, (float*)nullptr);
    launch_gemm_bf16(HN, Wup + (size_t)FFN2 * DM, MROWS, FFN2, DM, U, grid, stream);
    hipLaunchKernelGGL(k_ffn_gate, dim3((unsigned)((size_t)MROWS * (FFN / 2) / 256)), dim3(256), 0, stream, U, fconv_w + 3 * FFN2, fconv_b + FFN2, G);
    launch_gemm_res(G, Wdn + (size_t)DM * FFN, MROWS, DM, FFN, out, out, grid, stream);
}
```

```cpp
#include <hip/hip_runtime.h>
#include <cstdio>
#include <cstdint>
#include <cstring>

namespace pg8 {
#define PG8_LAS __attribute__((address_space(3)))
typedef unsigned short bf16_t;
typedef short bf16x8 __attribute__((ext_vector_type(8)));
typedef float f32x4 __attribute__((ext_vector_type(4)));
typedef unsigned u32x4 __attribute__((ext_vector_type(4)));
constexpr int BM = 256, BK = 64, HALF = 128, HTB = HALF * BK * 2  , STAGE_BYTES = 8 * HTB, NXCD = 8, WGM = 8;

__host__ __device__ __forceinline__ int lds_byte(int r, int c) { const int st = (r >> 4) * 2 + (c >> 5), rr = r & 15, cc = c & 31, ob = rr * 64 + cc * 2; return st * 1024 + (ob ^ (((ob >> 9) & 1) << 5)); }
__host__ __device__ __forceinline__ void stage_rc(int b, int& R, int& C) { const int st = b / 1024, sb = b % 1024, swz = sb ^ (((sb >> 9) & 1) << 5); R = (st >> 1) * 16 + swz / 64; C = (st & 1) * 32 + (swz % 64) / 2; }
__host__ __device__ __forceinline__ int perm32(int rho) { const int n = rho >> 4, i = rho & 15; return 8 * (i >> 2) + 4 * n + (i & 3); }

struct Unit { int pm, pn; };
struct Gemm { const bf16_t* A; const bf16_t* Bt; int M, N, K; };

struct StaticOrder {
    int nM, nN, nwg, G, c;
    __host__ __device__ void init(int M, int N, int G_, int c_) { nM = M / BM; nN = N / BM; nwg = nM * nN; G = G_; c = c_; }
    __host__ __device__ void init_tiles(int nM_, int nN_, int G_, int c_) { nM = nM_; nN = nN_; nwg = nM * nN; G = G_; c = c_; }
    __host__ __device__ bool next(int i, Unit& u) const {
        const long L = (long)i * G + c; if (L >= nwg) return false;
        int wgid = (int)L; { const int q = nwg / NXCD, r = nwg % NXCD, xcd = wgid % NXCD, off = wgid / NXCD; wgid = (xcd < r ? xcd * (q + 1) : r * (q + 1) + (xcd - r) * q) + off; }
        const int nig = WGM * nN, gid = wgid / nig, fm = gid * WGM, gsz = (nM - fm) < WGM ? (nM - fm) : WGM;
        u.pm = fm + ((wgid % nig) % gsz); u.pn = (wgid % nig) / gsz; return true;
    }
    __device__ __forceinline__ void a_ready(const Unit&) const {}
    __device__ __forceinline__ void done(const Unit&) const {}
};
__device__ __forceinline__ unsigned cvt_pk_bf16(float lo, float hi) { unsigned r; asm volatile("v_cvt_pk_bf16_f32 %0, %1, %2" : "=v"(r) : "v"(lo), "v"(hi)); return r; }
typedef float f32x2 __attribute__((ext_vector_type(2)));
__device__ __forceinline__ f32x2 gelu_pk(f32x2 v) {
    const f32x2 av = __builtin_elementwise_abs(v), d = av * 0.2316418882f + 1.0f;
    f32x2 t; t.x = __builtin_amdgcn_rcpf(d.x); t.y = __builtin_amdgcn_rcpf(d.y);
    f32x2 q = t * 0.5307027145f + (-0.7265760135f); q = q * t + 0.7107068705f; q = q * t + (-0.142248368f); q = q * t + 0.127414796f; q = q * t;
    const f32x2 s = (v * v) * (-0.72134752044f);
    f32x2 e; e.x = __builtin_amdgcn_exp2f(s.x); e.y = __builtin_amdgcn_exp2f(s.y);
    const f32x2 m = v * (q * e), r = v - m;
    f32x2 o; o.x = v.x < 0.f ? m.x : r.x; o.y = v.y < 0.f ? m.y : r.y; return o;
}

template <int ACT  > struct EpiBf16 {
    static constexpr bool PERM = true, AFTER_DRAIN = false, ACC_INIT = false; static_assert(ACT == 0 || ACT == 1, "EpiBf16: ACT is 0 (none) or 1 (gelu_pk)");
    static __host__ __device__ __forceinline__ int a_row0(int pm) { return pm * BM; }
    static __host__ __device__ __forceinline__ int b_row0(int pn) { return pn * BM; }
    bf16_t* O; int ldc; const float* bias; int split_cols; size_t split_stride; float scale0;
    __device__ __forceinline__ void operator()(const f32x4 (&acc)[2][2][4][2], const Unit& u, int wr, int wc, int fr, int fq, int ui) const {
        const int row0 = u.pm * BM + wr * 64 + fr; int colt = u.pn * BM; bf16_t* base = O;
        float sc = 1.f; if (split_cols) { const int t = colt / split_cols; base += (size_t)t * split_stride; colt -= t * split_cols; if (t == 0) sc = scale0; }
        const int col0 = colt + wc * 32 + 8 * fq, bcol0 = u.pn * BM + wc * 32 + 8 * fq;
        f32x4 bv[2][2];
#pragma unroll
        for (int bj = 0; bj < 2; ++bj)
#pragma unroll
            for (int n = 0; n < 2; ++n) bv[bj][n] = bias ? *(const f32x4*)(bias + bcol0 + bj * HALF + 4 * n) : (f32x4){0.f, 0.f, 0.f, 0.f};
#pragma unroll
        for (int ai = 0; ai < 2; ++ai)
#pragma unroll
            for (int m = 0; m < 4; ++m) { bf16_t* rowp = base + (size_t)(row0 + ai * HALF + m * 16) * ldc + col0;
#pragma unroll
                for (int bj = 0; bj < 2; ++bj) { f32x4 v0 = acc[ai][bj][m][0] + bv[bj][0], v1 = acc[ai][bj][m][1] + bv[bj][1];
                    if (ACT == 1) { f32x2 a = gelu_pk((f32x2){v0[0], v0[1]}), b = gelu_pk((f32x2){v0[2], v0[3]}), c = gelu_pk((f32x2){v1[0], v1[1]}), d = gelu_pk((f32x2){v1[2], v1[3]});
                        v0 = (f32x4){a.x, a.y, b.x, b.y}; v1 = (f32x4){c.x, c.y, d.x, d.y}; }
                    v0 = v0 * sc; v1 = v1 * sc; u32x4 w; w.x = cvt_pk_bf16(v0[0], v0[1]); w.y = cvt_pk_bf16(v0[2], v0[3]); w.z = cvt_pk_bf16(v1[0], v1[1]); w.w = cvt_pk_bf16(v1[2], v1[3]);
                    *(u32x4*)(rowp + bj * HALF) = w; } }
    }
};
template <bool RB_IN, bool RB_OUT, bool WITH_SSQ> struct EpiRes {
    static constexpr bool PERM = true, AFTER_DRAIN = false, ACC_INIT = true;
    static __host__ __device__ __forceinline__ int a_row0(int pm) { return pm * BM; }
    static __host__ __device__ __forceinline__ int b_row0(int pn) { return pn * BM; }
    const void* base; void* out; int ldc; float* ssq;
    static __device__ __forceinline__ f32x4 up2(unsigned lo, unsigned hi) { return (f32x4){__builtin_bit_cast(float, lo << 16), __builtin_bit_cast(float, lo & 0xffff0000u), __builtin_bit_cast(float, hi << 16), __builtin_bit_cast(float, hi & 0xffff0000u)}; }
    __device__ __forceinline__ void init(f32x4 (&acc)[2][2][4][2], const Unit& u, int wr, int wc, int fr, int fq) const {
        const int row0 = u.pm * BM + wr * 64 + fr, col0 = u.pn * BM + wc * 32 + 8 * fq;
#pragma unroll
        for (int ai = 0; ai < 2; ++ai)
#pragma unroll
            for (int m = 0; m < 4; ++m) { const size_t ro = (size_t)(row0 + ai * HALF + m * 16) * ldc + col0;
#pragma unroll
                for (int bj = 0; bj < 2; ++bj) { const size_t o = ro + bj * HALF;
                    if constexpr (RB_IN) { const u32x4 w = *(const u32x4*)((const bf16_t*)base + o); acc[ai][bj][m][0] = up2(w.x, w.y); acc[ai][bj][m][1] = up2(w.z, w.w); }
                    else { acc[ai][bj][m][0] = *(const f32x4*)((const float*)base + o); acc[ai][bj][m][1] = *(const f32x4*)((const float*)base + o + 4); } } }
    }
    __device__ __forceinline__ void operator()(const f32x4 (&acc)[2][2][4][2], const Unit& u, int wr, int wc, int fr, int fq, int ui) const {
        const int row0 = u.pm * BM + wr * 64 + fr, col0 = u.pn * BM + wc * 32 + 8 * fq;
#pragma unroll
        for (int ai = 0; ai < 2; ++ai)
#pragma unroll
            for (int m = 0; m < 4; ++m) { const size_t ro = (size_t)(row0 + ai * HALF + m * 16) * ldc + col0; float q = 0.f;
#pragma unroll
                for (int bj = 0; bj < 2; ++bj) { const size_t o = ro + bj * HALF; const f32x4 v0 = acc[ai][bj][m][0], v1 = acc[ai][bj][m][1];
                    if constexpr (RB_OUT) { u32x4 w; w.x = cvt_pk_bf16(v0[0], v0[1]); w.y = cvt_pk_bf16(v0[2], v0[3]); w.z = cvt_pk_bf16(v1[0], v1[1]); w.w = cvt_pk_bf16(v1[2], v1[3]); *(u32x4*)((bf16_t*)out + o) = w; }
                    else { *(f32x4*)((float*)out + o) = v0; *(f32x4*)((float*)out + o + 4) = v1; }
                    if constexpr (WITH_SSQ) q += ((v0[0] * v0[0] + v0[1] * v0[1]) + (v0[2] * v0[2] + v0[3] * v0[3])) + ((v1[0] * v1[0] + v1[1] * v1[1]) + (v1[2] * v1[2] + v1[3] * v1[3])); }
                if constexpr (WITH_SSQ) { q += __shfl_xor(q, 16); q += __shfl_xor(q, 32); if (fq == 0) ssq[(size_t)(row0 + ai * HALF + m * 16) * 32 + 4 * u.pn + wc] = q; } }
    }
};
struct EpiQKV {
    static constexpr bool PERM = true, AFTER_DRAIN = false, ACC_INIT = false;
    static __host__ __device__ __forceinline__ int a_row0(int pm) { return pm * BM; }
    static __host__ __device__ __forceinline__ int b_row0(int pn) { return pn * BM; }
    bf16_t* O; int ldc; const float* qg; const float* kg; PG8_LAS float* part; float qscale;
    __device__ __forceinline__ void operator()(const f32x4 (&acc)[2][2][4][2], const Unit& u, int wr, int wc, int fr, int fq, int ui) const {
        const int kind = u.pn >> 3;
        const int row0 = u.pm * BM + wr * 64 + fr, col0 = u.pn * BM + wc * 32 + 8 * fq;
        if (kind < 2) {
#pragma unroll
            for (int ai = 0; ai < 2; ++ai)
#pragma unroll
                for (int m = 0; m < 4; ++m)
#pragma unroll
                    for (int bj = 0; bj < 2; ++bj) { const f32x4 a = acc[ai][bj][m][0], b = acc[ai][bj][m][1];
                        float q = ((a[0] * a[0] + a[1] * a[1]) + (a[2] * a[2] + a[3] * a[3])) + ((b[0] * b[0] + b[1] * b[1]) + (b[2] * b[2] + b[3] * b[3]));
                        q += __shfl_xor(q, 16); q += __shfl_xor(q, 32);
                        if (fq == 0) part[((ai * HALF + wr * 64 + m * 16 + fr) * 2 + bj) * 4 + wc] = q; }
        }
        asm volatile("s_waitcnt lgkmcnt(0)" ::: "memory"); __builtin_amdgcn_s_barrier(); asm volatile("" ::: "memory");
        f32x4 g0 = (f32x4){1.f, 1.f, 1.f, 1.f}, g1 = g0;
        if (kind < 2) { const float* gp = (kind == 0 ? qg : kg) + wc * 32 + 8 * fq; g0 = *(const f32x4*)gp; g1 = *(const f32x4*)(gp + 4); }
        const float sc = (kind == 0) ? qscale : 1.f;
#pragma unroll
        for (int ai = 0; ai < 2; ++ai)
#pragma unroll
            for (int m = 0; m < 4; ++m) { bf16_t* rowp = O + (size_t)(row0 + ai * HALF + m * 16) * ldc + col0;
#pragma unroll
                for (int bj = 0; bj < 2; ++bj) { float rs = 1.f;
                    if (kind < 2) { const f32x4 pp = *(const PG8_LAS f32x4*)(part + ((ai * HALF + wr * 64 + m * 16 + fr) * 2 + bj) * 4); rs = sc * __builtin_amdgcn_rsqf(((pp[0] + pp[1]) + (pp[2] + pp[3])) * (1.f / 128.f) + 1e-6f); }
                    const f32x4 v0 = acc[ai][bj][m][0] * g0 * rs, v1 = acc[ai][bj][m][1] * g1 * rs;
                    u32x4 w; w.x = cvt_pk_bf16(v0[0], v0[1]); w.y = cvt_pk_bf16(v0[2], v0[3]); w.z = cvt_pk_bf16(v1[0], v1[1]); w.w = cvt_pk_bf16(v1[2], v1[3]);
                    *(u32x4*)(rowp + bj * HALF) = w; } }
    }
};
__device__ __forceinline__ float dpp_ror1(float v) { return __builtin_bit_cast(float, __builtin_amdgcn_mov_dpp(__builtin_bit_cast(int, v), 0x121, 0xf, 0xf, true)); }
__device__ __forceinline__ float dpp_ror2(float v) { return __builtin_bit_cast(float, __builtin_amdgcn_mov_dpp(__builtin_bit_cast(int, v), 0x122, 0xf, 0xf, true)); }
struct EpiConvGate {
    static constexpr bool PERM = true, AFTER_DRAIN = false, ACC_INIT = false;
    static constexpr int TPS = 17, TSTRIDE = 241, SEQL = 4096, FF = 5632;
    static __host__ __device__ __forceinline__ int a_row0(int pm) { return (pm / TPS) * SEQL + (pm % TPS) * TSTRIDE - 2; }
    static __host__ __device__ __forceinline__ int b_row0(int pn) { return pn * BM; }
    bf16_t* G; const float* cw; const float* cb; PG8_LAS float* tails; const float* ssq;
    __device__ __forceinline__ void operator()(const f32x4 (&acc)[2][2][4][2], const Unit& u, int wr, int wc, int fr, int fq, int ui) const {
        const int wid = wr * 4 + wc, seq = u.pm / TPS, tbase = (u.pm % TPS) * TSTRIDE - 2;
        const int ch0 = 128 * u.pn + 32 * wc + 8 * fq;
        if (fr >= 14) {
#pragma unroll
            for (int ai = 0; ai < 2; ++ai)
#pragma unroll
                for (int bj = 0; bj < 2; ++bj)
#pragma unroll
                    for (int n = 0; n < 2; ++n) *(PG8_LAS f32x4*)(tails + (((wid * 2 + ai) * 2 + (fr - 14)) * 2 + bj) * 32 + fq * 8 + n * 4) = acc[ai][bj][3][n];
        }
        const PG8_LAS float* rsl = tails + 2048 + 256 * ui;
        PG8_LAS float* coef = tails + 2048 + 12 * 256;
        { const int tid_ = threadIdx.x; if (tid_ < 256) { const int a_ = tid_ >> 5, c_ = tid_ & 31;
            const float* src = (a_ < 6 ? cw + (a_ >> 1) * 2 * FF : cb) + (a_ & 1) * FF + 128 * u.pn + 4 * c_;
            *(PG8_LAS f32x4*)(coef + a_ * 128 + 4 * c_) = *(const f32x4*)src; } }
        asm volatile("s_waitcnt lgkmcnt(0)" ::: "memory"); __builtin_amdgcn_s_barrier(); asm volatile("" ::: "memory");
        const bool is15 = (fr == 15), ge14 = (fr >= 14);
#pragma unroll
        for (int ai = 0; ai < 2; ++ai) {
            const bool has_src = !(ai == 0 && wr == 0);
            const int swid = (wr ^ 1) * 4 + wc, sai = (wr == 1) ? ai : ai - 1;
#pragma unroll
            for (int n = 0; n < 2; ++n) {
                f32x4 gv[4];
#pragma unroll
                for (int bj = 0; bj < 2; ++bj) {
                    const PG8_LAS float* cfp = coef + bj * 128 + 32 * wc + 8 * fq + 4 * n;
                    const f32x4 w0 = *(const PG8_LAS f32x4*)cfp, w1 = *(const PG8_LAS f32x4*)(cfp + 256), w2 = *(const PG8_LAS f32x4*)(cfp + 512), bb = *(const PG8_LAS f32x4*)(cfp + 768);
                    f32x4 prev = (f32x4){0.f, 0.f, 0.f, 0.f};
                    if (ge14 && has_src) { prev = *(const PG8_LAS f32x4*)(tails + (((swid * 2 + sai) * 2 + (fr - 14)) * 2 + bj) * 32 + fq * 8 + n * 4);
                        if (ssq) prev = prev * rsl[128 * ai + 64 * wr - 16 + fr]; }
#pragma unroll
                    for (int m = 0; m < 4; ++m) {
                        f32x4 cur = acc[ai][bj][m][n]; if (ssq) cur = cur * rsl[128 * ai + 64 * wr + 16 * m + fr];
                        const int t = tbase + 128 * ai + 64 * wr + 16 * m + fr;
                        f32x4 cv;
#pragma unroll
                        for (int e = 0; e < 4; ++e) {
                            float p1 = dpp_ror1(is15 ? prev[e] : cur[e]), p2 = dpp_ror2(ge14 ? prev[e] : cur[e]);
                            if (ai == 0 && m == 0) { p1 = (t >= 1) ? p1 : 0.f; p2 = (t >= 2) ? p2 : 0.f; }
                            cv[e] = bb[e] + w0[e] * p2 + w1[e] * p1 + w2[e] * cur[e]; }
                        if (bj == 0) {
#pragma unroll
                            for (int e = 0; e < 4; ++e) gv[m][e] = cv[e] * __builtin_amdgcn_rcpf(1.f + __expf(-cv[e]));
                        } else { const f32x4 o = gv[m] * cv; const int rl = 128 * ai + 64 * wr + 16 * m + fr;
                            if (rl >= 2 && rl < 2 + TSTRIDE && t < SEQL) { typedef unsigned u32x2 __attribute__((ext_vector_type(2))); u32x2 w; w.x = cvt_pk_bf16(o[0], o[1]); w.y = cvt_pk_bf16(o[2], o[3]);
                                *(u32x2*)(G + (size_t)(seq * SEQL + t) * FF + ch0 + 4 * n) = w; } }
                        prev = cur;
                    }
                }
            }
        }
    }
};
struct EpiConvGateT {
    static constexpr bool PERM = true, AFTER_DRAIN = false, ACC_INIT = false;
    static constexpr int TPS = 17, TSTRIDE = 241, SEQL = 4096, FF = 5632;
    static __host__ __device__ __forceinline__ int a_row0(int pm) { return pm * BM; }
    static __host__ __device__ __forceinline__ int b_row0(int pn) { return (pn / TPS) * SEQL + (pn % TPS) * TSTRIDE - 2; }
    bf16_t* G; const float* cw; const float* cb; PG8_LAS float* xl;
    __device__ __forceinline__ void operator()(f32x4 (&acc)[2][2][4][2], const Unit& u, int wr, int wc, int fr, int fq, int ui) const {
        const int wid = wr * 4 + wc, lane = fq * 16 + fr, seq = u.pn / TPS, tbase = (u.pn % TPS) * TSTRIDE - 2;
        PG8_LAS unsigned* tails = (PG8_LAS unsigned*)xl; PG8_LAS unsigned short* ob = (PG8_LAS unsigned short*)(xl + 2048) + wid * 512; PG8_LAS float* coef = xl + 4096; const PG8_LAS float* rsl = xl + 5120 + 256 * ui;
#pragma unroll
        for (int bj = 0; bj < 2; ++bj) { const f32x4 r0 = *(const PG8_LAS f32x4*)(rsl + 128 * bj + 32 * wc + 8 * fq), r1 = *(const PG8_LAS f32x4*)(rsl + 128 * bj + 32 * wc + 8 * fq + 4);
#pragma unroll
            for (int ai = 0; ai < 2; ++ai)
#pragma unroll
                for (int m = 0; m < 4; ++m) { acc[ai][bj][m][0] = acc[ai][bj][m][0] * r0; acc[ai][bj][m][1] = acc[ai][bj][m][1] * r1; } }
        if (fq == 3) {
#pragma unroll
            for (int bj = 0; bj < 2; ++bj)
#pragma unroll
                for (int ai = 0; ai < 2; ++ai)
#pragma unroll
                    for (int m = 0; m < 4; ++m) tails[((wid * 2 + bj) * 8 + ai * 4 + m) * 16 + fr] = cvt_pk_bf16(acc[ai][bj][m][1][2], acc[ai][bj][m][1][3]);
        }
        { const int tid_ = threadIdx.x; if (tid_ < 256) { const int a_ = tid_ >> 5, c_ = tid_ & 31, up_ = a_ >> 2, j_ = a_ & 3;
            const float* src = (j_ < 3 ? cw + j_ * 2 * FF : cb) + up_ * FF + 128 * u.pm + 4 * c_;
            *(PG8_LAS f32x4*)(coef + a_ * 128 + 4 * c_) = *(const f32x4*)src; } }
        asm volatile("s_waitcnt lgkmcnt(0)" ::: "memory"); __builtin_amdgcn_s_barrier(); asm volatile("" ::: "memory");
#pragma unroll
        for (int bj = 0; bj < 2; ++bj) {
            const bool has_src = (wc > 0) || (bj == 1);
            const int swid = (wc > 0) ? wid - 1 : wr * 4 + 3, sbj = (wc > 0) ? bj : 0;
            const bool firstgrp = (tbase < 0) && (bj == 0) && (wc == 0) && (fq == 0);
#pragma unroll
            for (int mp = 0; mp < 2; ++mp) {
                unsigned pk[2][2][2];
#pragma unroll
                for (int mq = 0; mq < 2; ++mq) { const int m = 2 * mp + mq;
                    float cv[2][8];
#pragma unroll
                    for (int ai = 0; ai < 2; ++ai) {
                        float sq[8];
#pragma unroll
                        for (int j = 0; j < 8; ++j) sq[j] = acc[ai][bj][m][j >> 2][j & 3];
                        float p6 = __shfl_up(sq[6], 16), p7 = __shfl_up(sq[7], 16);
                        if (fq == 0) { unsigned tv = 0u; if (has_src) tv = tails[((swid * 2 + sbj) * 8 + ai * 4 + m) * 16 + fr];
                            p6 = __builtin_bit_cast(float, tv << 16); p7 = __builtin_bit_cast(float, tv & 0xffff0000u); }
                        if (firstgrp) { sq[0] = 0.f; sq[1] = 0.f; }
                        const PG8_LAS float* cf = coef + ai * 512 + 64 * wr + 16 * m + fr; const float w0 = cf[0], w1 = cf[128], w2 = cf[256], bb = cf[384];
                        cv[ai][0] = bb + w0 * p6 + w1 * p7 + w2 * sq[0];
                        cv[ai][1] = bb + w0 * p7 + w1 * sq[0] + w2 * sq[1];
#pragma unroll
                        for (int j = 2; j < 8; ++j) cv[ai][j] = bb + w0 * sq[j - 2] + w1 * sq[j - 1] + w2 * sq[j];
                    }
                    float o[8];
#pragma unroll
                    for (int j = 0; j < 8; ++j) o[j] = cv[0][j] * __builtin_amdgcn_rcpf(1.f + __expf(-cv[0][j])) * cv[1][j];
#pragma unroll
                    for (int n = 0; n < 2; ++n) { pk[mq][n][0] = cvt_pk_bf16(o[4 * n], o[4 * n + 1]); pk[mq][n][1] = cvt_pk_bf16(o[4 * n + 2], o[4 * n + 3]); }
                }
#pragma unroll
                for (int n = 0; n < 2; ++n) {
#pragma unroll
                    for (int mq = 0; mq < 2; ++mq) {
                        ob[(4 * fq + 0) * 32 + 16 * mq + fr] = (unsigned short)(pk[mq][n][0] & 0xffffu); ob[(4 * fq + 1) * 32 + 16 * mq + fr] = (unsigned short)(pk[mq][n][0] >> 16);
                        ob[(4 * fq + 2) * 32 + 16 * mq + fr] = (unsigned short)(pk[mq][n][1] & 0xffffu); ob[(4 * fq + 3) * 32 + 16 * mq + fr] = (unsigned short)(pk[mq][n][1] >> 16); }
                    asm volatile("s_waitcnt lgkmcnt(0)" ::: "memory");
                    { const int trow = lane >> 2, chunk = lane & 3; const u32x4 v = *(const PG8_LAS u32x4*)(ob + trow * 32 + chunk * 8);
                      const int tl = 128 * bj + 32 * wc + 8 * (trow >> 2) + 4 * n + (trow & 3), t = tbase + tl;
                      asm volatile("s_waitcnt lgkmcnt(0)" ::: "memory");
                      if (tl >= 2 && tl < 2 + TSTRIDE && t < SEQL) *(u32x4*)(G + (size_t)(seq * SEQL + t) * FF + 128 * u.pm + 64 * wr + 32 * mp + 8 * chunk) = v; }
                }
            }
        }
    }
};
template <class Epi, class Sched, bool ALIGN_EPI = false, bool SP2 = false>
__device__ __forceinline__ void gemm_phase(PG8_LAS unsigned char* lds, const Gemm g, const Sched& S, const Epi& E) {
    const int tid = threadIdx.x, wid = __builtin_amdgcn_readfirstlane(tid >> 6), lane = tid & 63, wr = wid >> 2, wc = wid & 3, fr = lane & 15, fq = lane >> 4;
    const int K = g.K, nt = K / BK;
    unsigned voffA[2], voffB[2];
#pragma unroll
    for (int i = 0; i < 2; ++i) { int R, C; stage_rc(tid * 16 + i * 8192, R, C); const int Rb = Epi::PERM ? ((R & ~31) + perm32(R & 31)) : R;
        voffA[i] = (unsigned)(R * K + C) * 2u; voffB[i] = (unsigned)(Rb * K + C) * 2u; }
    const size_t kstep = (size_t)(BK * 2);
    const size_t hstep = (size_t)HALF * K * 2;
    const size_t tstep = 2 * hstep;
    const unsigned ldsw = (unsigned)wid * 1024u;
    const int aoff = lds_byte(wr * 64 + fr, fq * 8), boff = lds_byte(wc * 32 + fr, fq * 8);
#define PG8_SA(b, h) (((b) * 2 + (h)) * HTB)
#define PG8_SB(b, h) ((4 + (b) * 2 + (h)) * HTB)
#define PG8_STAGE(bufoff, gbase, voff) do { _Pragma("unroll") for (int _i = 0; _i < 2; ++_i) \
        __builtin_amdgcn_global_load_lds((const unsigned*)((const char*)(gbase) + (voff)[_i]), (PG8_LAS unsigned*)(lds + (bufoff) + ldsw + _i * 8192), 16, 0, 0); } while (0)
#define PG8_LDA(dst, b, h) do { _Pragma("unroll") for (int m = 0; m < 4; ++m) _Pragma("unroll") for (int k = 0; k < 2; ++k) dst[m][k] = *(const PG8_LAS bf16x8*)(lds + PG8_SA(b, h) + aoff + m * 2048 + k * 1024); } while (0)
#define PG8_LDB(dst, b, h) do { _Pragma("unroll") for (int n = 0; n < 2; ++n) _Pragma("unroll") for (int k = 0; k < 2; ++k) dst[n][k] = *(const PG8_LAS bf16x8*)(lds + PG8_SB(b, h) + boff + n * 2048 + k * 1024); } while (0)
#define PG8_MMA(ai, bj, At, Bt) do { __builtin_amdgcn_s_setprio(1); _Pragma("unroll") for (int m = 0; m < 4; ++m) _Pragma("unroll") for (int n = 0; n < 2; ++n) _Pragma("unroll") for (int k = 0; k < 2; ++k) \
        acc[ai][bj][m][n] = __builtin_amdgcn_mfma_f32_16x16x32_bf16(Bt[n][k], At[m][k], acc[ai][bj][m][n], 0, 0, 0); __builtin_amdgcn_s_setprio(0); } while (0)
#define PG8_WAIT_V(n) asm volatile("s_waitcnt vmcnt(" #n ")" ::: "memory")
#define PG8_WAIT_L(n) asm volatile("s_waitcnt lgkmcnt(" #n ")" ::: "memory")
#define PG8_BAR __builtin_amdgcn_s_barrier()
#define PG8_SCHED __builtin_amdgcn_sched_barrier(0)
    Unit cur, nxt; int ui = 0;
    if (!S.next(0, cur)) return;
    f32x4 acc[2][2][4][2];
    if constexpr (Epi::ACC_INIT) E.init(acc, cur, wr, wc, fr, fq); else {
#pragma unroll
    for (int a = 0; a < 2; ++a)
#pragma unroll
        for (int b = 0; b < 2; ++b)
#pragma unroll
            for (int m = 0; m < 4; ++m)
#pragma unroll
                for (int n = 0; n < 2; ++n) acc[a][b][m][n] = (f32x4){0.f, 0.f, 0.f, 0.f}; }
    bf16x8 At[4][2], B0[2][2], B1[2][2];
    const char* cA = (const char*)g.A + (long)Epi::a_row0(cur.pm) * (long)(K * 2); const char* cB = (const char*)g.Bt + (long)Epi::b_row0(cur.pn) * (long)(K * 2);
    S.a_ready(cur);
    if constexpr (SP2) {
        PG8_STAGE(PG8_SB(0, 0), cB, voffB); PG8_STAGE(PG8_SB(0, 1), cB + hstep, voffB); PG8_STAGE(PG8_SA(0, 0), cA, voffA); PG8_STAGE(PG8_SA(0, 1), cA + hstep, voffA);
        if (wr == 1) PG8_BAR;
        PG8_WAIT_V(2); PG8_BAR;
        PG8_STAGE(PG8_SB(1, 0), cB + kstep, voffB); PG8_STAGE(PG8_SA(1, 0), cA + kstep, voffA); PG8_STAGE(PG8_SB(1, 1), cB + hstep + kstep, voffB);
        PG8_WAIT_V(6); PG8_BAR;
    } else {
        PG8_STAGE(PG8_SB(0, 0), cB, voffB); PG8_STAGE(PG8_SA(0, 0), cA, voffA); PG8_STAGE(PG8_SB(0, 1), cB + hstep, voffB); PG8_STAGE(PG8_SA(0, 1), cA + hstep, voffA);
        if (wr == 1) PG8_BAR;
        PG8_WAIT_V(4); PG8_BAR;
        PG8_STAGE(PG8_SB(1, 0), cB + kstep, voffB); PG8_STAGE(PG8_SA(1, 0), cA + kstep, voffA); PG8_STAGE(PG8_SB(1, 1), cB + hstep + kstep, voffB);
        PG8_WAIT_V(6); PG8_BAR;
    }
    for (;;) {
        const bool has_next = S.next(ui + 1, nxt);
        const char* nA = has_next ? (const char*)g.A + (long)Epi::a_row0(nxt.pm) * (long)(K * 2) : cA; const char* nB = has_next ? (const char*)g.Bt + (long)Epi::b_row0(nxt.pn) * (long)(K * 2) : cB;
        for (int t = 0; t < nt; t += 2) {
            const bool last = (t == nt - 2);
            const char* a1 = cA + (size_t)(t + 1) * kstep;
            const char* a2 = last ? nA : cA + (size_t)(t + 2) * kstep; const char* b2 = last ? nB : cB + (size_t)(t + 2) * kstep;
            const char* a3 = a2 + kstep; const char* b3 = b2 + kstep;
            if (last && has_next) S.a_ready(nxt);
            if constexpr (SP2) {
            PG8_LDB(B0, 0, 0); PG8_LDB(B1, 0, 1); PG8_SCHED; PG8_LDA(At, 0, 0); PG8_STAGE(PG8_SA(1, 1), a1 + hstep, voffA);
            PG8_WAIT_V(8); PG8_WAIT_L(0); PG8_BAR; PG8_MMA(0, 0, At, B0); PG8_MMA(0, 1, At, B1); PG8_BAR; PG8_SCHED;
            PG8_LDA(At, 0, 1); PG8_STAGE(PG8_SB(0, 0), b2, voffB); PG8_STAGE(PG8_SB(0, 1), b2 + hstep, voffB); PG8_STAGE(PG8_SA(0, 0), a2, voffA);
            PG8_WAIT_V(8); PG8_WAIT_L(0); PG8_BAR; PG8_MMA(1, 0, At, B0); PG8_MMA(1, 1, At, B1); PG8_BAR; PG8_SCHED;
            PG8_LDB(B0, 1, 0); PG8_LDB(B1, 1, 1); PG8_SCHED; PG8_LDA(At, 1, 0); PG8_STAGE(PG8_SA(0, 1), a2 + hstep, voffA);
            PG8_WAIT_V(8); PG8_WAIT_L(0); PG8_BAR; PG8_MMA(0, 0, At, B0); PG8_MMA(0, 1, At, B1); PG8_BAR; PG8_SCHED;
            PG8_LDA(At, 1, 1); PG8_STAGE(PG8_SB(1, 0), b3, voffB); PG8_STAGE(PG8_SB(1, 1), b3 + hstep, voffB); PG8_STAGE(PG8_SA(1, 0), a3, voffA);
            PG8_WAIT_V(8); PG8_WAIT_L(0); PG8_BAR; PG8_MMA(1, 0, At, B0); PG8_MMA(1, 1, At, B1); PG8_BAR; PG8_SCHED;
            } else {
            PG8_LDB(B0, 0, 0); PG8_SCHED; PG8_LDA(At, 0, 0); PG8_STAGE(PG8_SA(1, 1), a1 + hstep, voffA);
            PG8_WAIT_L(8); PG8_BAR; PG8_WAIT_L(0); PG8_MMA(0, 0, At, B0); PG8_BAR; PG8_SCHED;
            PG8_LDB(B1, 0, 1); PG8_STAGE(PG8_SB(0, 0), b2, voffB);
            PG8_BAR; PG8_WAIT_L(0); PG8_MMA(0, 1, At, B1); PG8_BAR;
            PG8_LDA(At, 0, 1); PG8_STAGE(PG8_SA(0, 0), a2, voffA);
            PG8_BAR; PG8_WAIT_L(0); PG8_MMA(1, 0, At, B0); PG8_BAR; PG8_SCHED;
            PG8_STAGE(PG8_SB(0, 1), b2 + hstep, voffB);
            PG8_WAIT_V(6); PG8_BAR; PG8_MMA(1, 1, At, B1); PG8_BAR;
            PG8_LDB(B0, 1, 0); PG8_SCHED; PG8_LDA(At, 1, 0); PG8_STAGE(PG8_SA(0, 1), a2 + hstep, voffA);
            PG8_WAIT_L(8); PG8_BAR; PG8_WAIT_L(0); PG8_MMA(0, 0, At, B0); PG8_BAR; PG8_SCHED;
            PG8_LDB(B1, 1, 1); PG8_STAGE(PG8_SB(1, 0), b3, voffB);
            PG8_BAR; PG8_WAIT_L(0); PG8_MMA(0, 1, At, B1); PG8_BAR;
            PG8_LDA(At, 1, 1); PG8_STAGE(PG8_SA(1, 0), a3, voffA);
            PG8_BAR; PG8_WAIT_L(0); PG8_MMA(1, 0, At, B0); PG8_BAR; PG8_SCHED;
            PG8_STAGE(PG8_SB(1, 1), b3 + hstep, voffB);
            PG8_WAIT_V(6); PG8_BAR; PG8_MMA(1, 1, At, B1); PG8_BAR;
            }
        }
        if constexpr (ALIGN_EPI) { if (wr == 0) PG8_BAR; }
        if constexpr (!Epi::AFTER_DRAIN) { E(acc, cur, wr, wc, fr, fq, ui); S.done(cur); }
        if (!has_next) break;
        if constexpr (Epi::ACC_INIT) E.init(acc, nxt, wr, wc, fr, fq); else {
#pragma unroll
        for (int a = 0; a < 2; ++a)
#pragma unroll
            for (int b = 0; b < 2; ++b)
#pragma unroll
                for (int m = 0; m < 4; ++m)
#pragma unroll
                    for (int n = 0; n < 2; ++n) acc[a][b][m][n] = (f32x4){0.f, 0.f, 0.f, 0.f}; }
        cur = nxt; cA = nA; cB = nB; ++ui;
        if constexpr (ALIGN_EPI) { if (wr == 1) PG8_BAR; }
    }
    PG8_WAIT_V(0);
    if constexpr (!ALIGN_EPI) { if (wr == 0) PG8_BAR; }
    PG8_BAR;
    if constexpr (Epi::AFTER_DRAIN) { E.fused(acc, cur, wr, wc, fr, fq, lds, wid, lane); S.done(cur); }
#undef PG8_SA
#undef PG8_SB
#undef PG8_STAGE
#undef PG8_LDA
#undef PG8_LDB
#undef PG8_MMA
#undef PG8_WAIT_V
#undef PG8_WAIT_L
#undef PG8_BAR
#undef PG8_SCHED
}
}

constexpr int BATCH = 2, SEQ = 4096, DM = 2048, MROWS = BATCH * SEQ;
constexpr int AH = 16, AHD = 128, NQKV = 3 * DM;
constexpr int LH = 4, LDV = 512, LDK = 256, QKW = 1024, INW = 6152, INW_MAIN = 6144;
constexpr int FFN = 5632, FFN2 = 2 * FFN;
constexpr float NORM_EPS = 1e-6f;

typedef unsigned short bf16;
typedef unsigned v4u __attribute__((ext_vector_type(4)));
typedef unsigned v2u __attribute__((ext_vector_type(2)));
typedef float f32x4 __attribute__((ext_vector_type(4)));
typedef float f32x2 __attribute__((ext_vector_type(2)));
#define LAS __attribute__((address_space(3)))

__device__ __forceinline__ unsigned f2bf(float f) { unsigned u = __builtin_bit_cast(unsigned, f); return (u + 0x7fffu + ((u >> 16) & 1u)) >> 16; }
__device__ __forceinline__ unsigned pk2(float lo, float hi) { unsigned r; asm("v_cvt_pk_bf16_f32 %0, %1, %2" : "=v"(r) : "v"(lo), "v"(hi)); return r; }
template <int N> __device__ __forceinline__ float dpp_ror(float v) { return __builtin_bit_cast(float, __builtin_amdgcn_mov_dpp(__builtin_bit_cast(int, v), 0x120 + N, 0xf, 0xf, true)); }
__device__ __forceinline__ float row16_sum(float v) { v += dpp_ror<1>(v); v += dpp_ror<2>(v); v += dpp_ror<4>(v); v += dpp_ror<8>(v); return v; }
__device__ __forceinline__ float bf2f(unsigned short b) { return __builtin_bit_cast(float, (unsigned)b << 16); }
__device__ __forceinline__ float bflo(unsigned w) { return __builtin_bit_cast(float, w << 16); }
__device__ __forceinline__ float bfhi(unsigned w) { return __builtin_bit_cast(float, w & 0xffff0000u); }
__device__ __forceinline__ float wave_sum(float v) {
#pragma unroll
    for (int o = 1; o < 64; o <<= 1) v += __shfl_xor(v, o);
    return v;
}
__device__ __forceinline__ float sigmoidf_(float x) { return __builtin_amdgcn_rcpf(1.f + __expf(-x)); }
__device__ __forceinline__ float siluf_(float x) { return x * __builtin_amdgcn_rcpf(1.f + __expf(-x)); }

constexpr size_t MiB = 1u << 20;
constexpr size_t WS_CTL = 0;
constexpr size_t WS_WQKV = 1 * MiB;
constexpr size_t WS_WO   = WS_WQKV + (size_t)NQKV * DM * 2;
constexpr size_t WS_WIN  = WS_WO + (size_t)DM * DM * 2;
constexpr size_t WS_WOUT = WS_WIN + (size_t)INW_MAIN * DM * 2;
constexpr size_t WS_WUP  = WS_WOUT + (size_t)DM * DM * 2;
constexpr size_t WS_WDN  = WS_WUP + 2 * (size_t)FFN2 * DM * 2;
constexpr size_t WS_HN   = WS_WDN + 2 * (size_t)DM * FFN * 2;
constexpr size_t WS_G    = WS_HN + (size_t)MROWS * DM * 2;
constexpr size_t WS_R    = WS_G + (size_t)MROWS * FFN * 2;
constexpr size_t WS_QKV  = WS_R;
constexpr size_t WS_O    = WS_QKV + (size_t)MROWS * NQKV * 2;
constexpr size_t WS_QKC  = WS_O + (size_t)MROWS * DM * 2;
constexpr size_t WS_HS   = WS_QKC + (size_t)MROWS * DM * 2;
constexpr size_t WS_U    = WS_R;
constexpr size_t WS_REND = WS_HS + (size_t)MROWS * DM * 4;
static_assert(WS_U + (size_t)MROWS * FFN2 * 2 <= WS_REND, "U overlay");
constexpr size_t WS_GATES = WS_REND;
constexpr size_t WS_SU   = WS_GATES + (size_t)MROWS * 8 * 4;
constexpr size_t WS_SM   = WS_SU + 8 * SEQ * 4;
constexpr size_t WS_SE   = WS_SM + 8 * SEQ * 4;
constexpr size_t WS_NST  = WS_SE + 8 * SEQ * 4;
constexpr size_t WS_CST  = WS_NST + 8 * 64 * 256 * 4;
constexpr size_t WS_SSQ  = WS_CST + (size_t)8 * 64 * 17 * 16384;
constexpr size_t WS_GWT  = WS_SSQ + (size_t)MROWS * 32 * 4;
constexpr size_t WS_XR   = WS_HS;
constexpr size_t WS_END  = WS_GWT + (size_t)DM * 8 * 4;
static_assert(WS_END <= 738000000, "workspace");

__device__ __forceinline__ void transpose_load(const float* W, int ldn, int nblk, int item, int lane, f32x4 (&v)[8]) {
    const int kb = item / nblk, nb = item % nblk, k0 = 64 * kb, n0 = 32 * nb;
#pragma unroll
    for (int i = 0; i < 8; ++i) v[i] = *(const f32x4*)(W + (size_t)(k0 + 8 * i + (lane >> 3)) * ldn + n0 + 4 * (lane & 7));
}
__device__ __forceinline__ void transpose_store(const f32x4 (&v)[8], int K, int nblk, bf16* WT, LAS float* scr, int item, int lane, bool gate_perm, const LAS float* kgain) {
    const int kb = item / nblk, nb = item % nblk, k0 = 64 * kb, n0 = 32 * nb;
    const int r0 = !gate_perm ? n0 : (n0 < FFN ? (n0 / 128) * 256 + (n0 % 128) : ((n0 - FFN) / 128) * 256 + 128 + ((n0 - FFN) % 128));
#pragma unroll
    for (int i = 0; i < 8; ++i) { LAS float* d = scr + (8 * i + (lane >> 3)) * 33 + 4 * (lane & 7); d[0] = v[i][0]; d[1] = v[i][1]; d[2] = v[i][2]; d[3] = v[i][3]; }
    asm volatile("s_waitcnt lgkmcnt(0)" ::: "memory");
    const int c = lane & 7;
    f32x4 ga = (f32x4){1.f, 1.f, 1.f, 1.f}, gb = ga;
    if (kgain) { ga = *(const LAS f32x4*)(kgain + k0 + 8 * c); gb = *(const LAS f32x4*)(kgain + k0 + 8 * c + 4); }
#pragma unroll
    for (int j = 0; j < 4; ++j) { const int n = (lane >> 3) + 8 * j; const LAS float* s = scr + (8 * c) * 33 + n;
        v4u o; o.x = pk2(s[0 * 33] * ga[0], s[1 * 33] * ga[1]); o.y = pk2(s[2 * 33] * ga[2], s[3 * 33] * ga[3]); o.z = pk2(s[4 * 33] * gb[0], s[5 * 33] * gb[1]); o.w = pk2(s[6 * 33] * gb[2], s[7 * 33] * gb[3]);
        *(v4u*)(WT + (size_t)(r0 + n) * K + k0 + 8 * c) = o; }
    asm volatile("s_waitcnt lgkmcnt(0)" ::: "memory");
}

#define XB_TMO      128
#define XB_XCNT(j)  (256  + 64 * (j))
#define XB_XSUB(j)  (1280 + 64 * (j))
#define XB_XGEN(j)  (2304 + 64 * (j))
#define XB_TOP      3328
#define XB_TOPGEN   3392
#define XCD_BAR_WORDS 3456
#define XB_SPIN_CAP (1u << 18)

__device__ __forceinline__ unsigned xb_ld(unsigned* p)              { return __hip_atomic_load(p, __ATOMIC_RELAXED, __HIP_MEMORY_SCOPE_AGENT); }
__device__ __forceinline__ unsigned xb_add(unsigned* p, unsigned v) { return __hip_atomic_fetch_add(p, v, __ATOMIC_RELAXED, __HIP_MEMORY_SCOPE_AGENT); }
__device__ __forceinline__ unsigned xb_xcc_id() { return (unsigned)__builtin_amdgcn_s_getreg((3 << 11) | 20) & 0xFu; }
#define XB_SPIN(cond, bar) do { unsigned _sp = 0; while (cond) { __builtin_amdgcn_s_sleep(1); \
    if ((++_sp & 255u) == 0u) { if (xb_ld(&(bar)[XB_TMO])) break; if (_sp > XB_SPIN_CAP) { atomicAdd(&(bar)[XB_TMO], 1u); break; } } } } while (0)

struct XcdBarrier {
    unsigned* bar; unsigned x;
    volatile LAS unsigned* st;
};

__device__ __forceinline__ XcdBarrier xcd_barrier_post(unsigned* bar, volatile LAS unsigned* st) {
    XcdBarrier b; b.bar = bar; b.x = xb_xcc_id(); b.st = st;
    if (threadIdx.x == 0) (void)xb_add(&bar[XB_XCNT(b.x)], 1u);
    return b;
}
__device__ __forceinline__ void xcd_barrier_complete(unsigned* bar, unsigned x, unsigned& nloc, unsigned& nx) {
    const unsigned G = gridDim.x * gridDim.y * gridDim.z;
    unsigned sum, cnt, mine, sp = 0u;
    for (;;) {
        sum = 0u; cnt = 0u; mine = 0u;
#pragma unroll
        for (unsigned j = 0; j < 16; ++j) { const unsigned c = xb_ld(&bar[XB_XCNT(j)]); sum += c; cnt += (c > 0u) ? 1u : 0u; mine = (j == x) ? c : mine; }
        if (sum == G) break;
        __builtin_amdgcn_s_sleep(1);
        if ((++sp & 255u) == 0u) { if (xb_ld(&bar[XB_TMO])) break; if (sp > XB_SPIN_CAP) { atomicAdd(&bar[XB_TMO], 1u); break; } }
    }
    nloc = mine > 0u ? mine : 1u; nx = cnt > 0u ? cnt : 1u;
}

__device__ __forceinline__ void xcd_barrier(const XcdBarrier& b) {
    asm volatile("s_waitcnt vmcnt(0)" ::: "memory");
    __syncthreads();
    if (threadIdx.x == 0) {
        unsigned* bar = b.bar;
        __builtin_amdgcn_s_waitcnt(0);
        unsigned nloc = b.st[0], nx = b.st[1];
        if (nloc == 0u) { xcd_barrier_complete(bar, b.x, nloc, nx); b.st[0] = nloc; b.st[1] = nx; }
        const unsigned old = xb_add(&bar[XB_XSUB(b.x)], 1u);
        const unsigned gen = old / nloc;
        if (old + 1u == (gen + 1u) * nloc) {
            __builtin_amdgcn_fence(__ATOMIC_RELEASE, "agent");
            asm volatile("s_waitcnt vmcnt(0)" ::: "memory");
            const unsigned og = xb_add(&bar[XB_TOP], 1u);
            const unsigned tg = og / nx;
            if (og + 1u == (tg + 1u) * nx) xb_add(&bar[XB_TOPGEN], 1u);
            else XB_SPIN(xb_ld(&bar[XB_TOPGEN]) == tg, bar);
            __builtin_amdgcn_fence(__ATOMIC_ACQUIRE, "agent");
            xb_add(&bar[XB_XGEN(b.x)], 1u);
            asm volatile("s_waitcnt vmcnt(0)" ::: "memory");
        } else {
            XB_SPIN(xb_ld(&bar[XB_XGEN(b.x)]) == gen, bar);
            __builtin_amdgcn_fence(__ATOMIC_ACQUIRE, "agent");
            asm volatile("s_waitcnt vmcnt(0)" ::: "memory");
        }
    }
    __syncthreads();
}


constexpr int NWAVES = 8, NTHREADS = 512;
constexpr int RING_BYTES = 131072;
constexpr int MISC_OFF = 163840 - 256;
constexpr int LDS_BYTES = 163840;
constexpr int CW_BAR = 4096;
constexpr size_t CTL_ZERO_BYTES = 64 * 1024;

struct Args { const float* in[18]; float* out; unsigned char* ws; int ph_lo, ph_hi; };

struct Frame {
    LAS unsigned char* lds; int tid, lane, wave, vcu, G;
};

__device__ __forceinline__ void p_convert(const Frame& F, const float* W, bf16* WT, int K, int ldn, int N, bool gate_perm = false, int rank = 0, int nranks = 0, const float* kgain = nullptr) {
    LAS float* scr = (LAS float*)(F.lds + F.wave * 16384);
    if (nranks == 0) { nranks = F.G; rank = F.vcu; }
    if (rank < 0 || rank >= nranks) return;
    const int gw = rank * NWAVES + F.wave, NGW = nranks * NWAVES;
    const int nblk = N / 32, items = (K / 64) * nblk;
    const LAS float* kgl = nullptr;
    if (kgain) { LAS float* gl = (LAS float*)(F.lds + NWAVES * 16384); __syncthreads();
        for (int i = F.tid; i < K / 4; i += NTHREADS) *(LAS f32x4*)(gl + 4 * i) = *(const f32x4*)(kgain + 4 * i);
        __syncthreads(); kgl = gl; }
    f32x4 cur[8], nxt[8];
    if (gw < items) transpose_load(W, ldn, nblk, gw, F.lane, nxt);
    for (int it = gw; it < items; it += NGW) {
#pragma unroll
        for (int i = 0; i < 8; ++i) cur[i] = nxt[i];
        if (it + NGW < items) transpose_load(W, ldn, nblk, it + NGW, F.lane, nxt);
        transpose_store(cur, K, nblk, WT, scr, it, F.lane, gate_perm, kgl);
    }
}

__device__ __forceinline__ void p_pack_gates(const Frame& F, const float* w_in, float* gwt) {
    for (int id = F.vcu * NTHREADS + F.tid; id < DM * 2; id += F.G * NTHREADS) { const int k = id >> 1, hf = id & 1; *(f32x4*)(gwt + k * 8 + hf * 4) = *(const f32x4*)(w_in + (size_t)k * INW + INW_MAIN + hf * 4); }
}
template <bool XBF> __device__ __forceinline__ int nrm_idx(int q, int lane) { return XBF ? 2 * (64 * (q >> 1) + lane) + (q & 1) : 64 * q + lane; }
template <bool XBF> __device__ __forceinline__ f32x4 nrm_ld(const void* x, size_t row, int q, int lane) {
    if constexpr (XBF) { const v2u w = ((const v2u*)((const bf16*)x + row * DM))[nrm_idx<XBF>(q, lane)]; return (f32x4){bflo(w.x), bfhi(w.x), bflo(w.y), bfhi(w.y)}; }
    else return ((const f32x4*)((const float*)x + row * DM))[nrm_idx<XBF>(q, lane)];
}
template <bool XBF> __device__ __forceinline__ void p_rmsnorm(const Frame& F, const void* x, const float* g, bf16* hn, const float* w_in, const float* gate_bias, float* gates) {
    const int gw = F.vcu * NWAVES + F.wave, NGW = F.G * NWAVES, lane = F.lane;
    LAS float* gwl = (LAS float*)F.lds;
    if (w_in) { __syncthreads();
#pragma unroll
        for (int i = 0; i < 8; ++i) { const int id = F.tid + NTHREADS * i, k = id >> 1; *(LAS f32x4*)(gwl + (k >> 3) * 68 + (k & 7) * 8 + (id & 1) * 4) = *(const f32x4*)(w_in + id * 4); }
        __syncthreads(); }
    f32x4 gg[8], nx[8];
#pragma unroll
    for (int j = 0; j < 8; ++j) gg[j] = ((const f32x4*)g)[nrm_idx<XBF>(j, lane)];
    if (gw < MROWS) {
#pragma unroll
        for (int j = 0; j < 8; ++j) nx[j] = nrm_ld<XBF>(x, (size_t)gw, j, lane); }
    for (int row = gw; row < MROWS; row += NGW) {
        f32x4 v[8]; float s = 0.f;
#pragma unroll
        for (int j = 0; j < 8; ++j) { v[j] = nx[j]; s += (v[j].x * v[j].x + v[j].y * v[j].y) + (v[j].z * v[j].z + v[j].w * v[j].w); }
        if (row + NGW < MROWS) {
#pragma unroll
            for (int j = 0; j < 8; ++j) nx[j] = nrm_ld<XBF>(x, (size_t)(row + NGW), j, lane); }
        const float rstd = 1.f / sqrtf(wave_sum(s) * (1.f / DM) + NORM_EPS);
#pragma unroll
        for (int j = 0; j < 8; ++j) v[j] = v[j] * rstd * gg[j];
        if constexpr (XBF) { v4u* o16 = (v4u*)(hn + (size_t)row * DM) + lane;
#pragma unroll
            for (int jj = 0; jj < 4; ++jj) { v4u w; w.x = pk2(v[2 * jj].x, v[2 * jj].y); w.y = pk2(v[2 * jj].z, v[2 * jj].w); w.z = pk2(v[2 * jj + 1].x, v[2 * jj + 1].y); w.w = pk2(v[2 * jj + 1].z, v[2 * jj + 1].w); o16[64 * jj] = w; } }
        else {
            const bool odd = lane & 1; bf16* ob_ = hn + (size_t)row * DM;
#pragma unroll
            for (int jj = 0; jj < 4; ++jj) { const unsigned a0 = pk2(v[2 * jj].x, v[2 * jj].y), a1 = pk2(v[2 * jj].z, v[2 * jj].w), b0 = pk2(v[2 * jj + 1].x, v[2 * jj + 1].y), b1 = pk2(v[2 * jj + 1].z, v[2 * jj + 1].w);
                const unsigned s0 = odd ? a0 : b0, s1 = odd ? a1 : b1;
                const unsigned r0 = (unsigned)__builtin_amdgcn_mov_dpp((int)s0, 0xB1, 0xf, 0xf, true), r1 = (unsigned)__builtin_amdgcn_mov_dpp((int)s1, 0xB1, 0xf, 0xf, true);
                v4u w; if (odd) { w.x = r0; w.y = r1; w.z = b0; w.w = b1; } else { w.x = a0; w.y = a1; w.z = r0; w.w = r1; }
                *(v4u*)(ob_ + 4 * (64 * (2 * jj + (odd ? 1 : 0)) + (lane & ~1))) = w; } }
        if (w_in) {
            float acc[8];
#pragma unroll
            for (int q = 0; q < 8; ++q) acc[q] = 0.f;
#pragma unroll
            for (int j = 0; j < 8; ++j) { asm volatile("" ::: "memory");
#pragma unroll
                for (int e = 0; e < 4; ++e) { const int k = 4 * nrm_idx<XBF>(j, lane) + e; const LAS float* wp = gwl + (k >> 3) * 68 + (k & 7) * 8; const f32x4 a = *(const LAS f32x4*)wp, b = *(const LAS f32x4*)(wp + 4); const float hv = v[j][e];
                    acc[0] += hv * a.x; acc[1] += hv * a.y; acc[2] += hv * a.z; acc[3] += hv * a.w; acc[4] += hv * b.x; acc[5] += hv * b.y; acc[6] += hv * b.z; acc[7] += hv * b.w; } }
#pragma unroll
            for (int q = 0; q < 8; ++q) acc[q] = wave_sum(acc[q]);
            if (lane < 8) { float r = acc[0];
#pragma unroll
                for (int q = 1; q < 8; ++q) r = (lane == q) ? acc[q] : r;
                gates[(size_t)row * 8 + lane] = r + gate_bias[lane]; }
        }
    }
}

__device__ __forceinline__ void unpack8(const v4u v, float (&f)[8]) { f[0] = bflo(v.x); f[1] = bfhi(v.x); f[2] = bflo(v.y); f[3] = bfhi(v.y); f[4] = bflo(v.z); f[5] = bfhi(v.z); f[6] = bflo(v.w); f[7] = bfhi(v.w); }
__device__ __forceinline__ void p_lstm_conv(const Frame& F, const bf16* z, const float* cw, const float* cb, bf16* qk) {
    constexpr int NCH = DM / 8, SEGR = 16, NSEG = MROWS / SEGR;
    const int total = NCH * NSEG, stride = F.G * NTHREADS;
    for (int item = F.vcu * NTHREADS + F.tid; item < total; item += stride) {
        const int cc = item % NCH, seg = item / NCH, c = 8 * cc, r0 = seg * SEGR, t0 = r0 & (SEQ - 1);
        float w[4][8], bb[8];
        { const f32x4 b0 = *(const f32x4*)(cb + c), b1 = *(const f32x4*)(cb + c + 4);
#pragma unroll
          for (int e = 0; e < 4; ++e) { bb[e] = b0[e]; bb[4 + e] = b1[e]; }
#pragma unroll
          for (int j = 0; j < 4; ++j) { const f32x4 w0 = *(const f32x4*)(cw + j * DM + c), w1 = *(const f32x4*)(cw + j * DM + c + 4);
#pragma unroll
              for (int e = 0; e < 4; ++e) { w[j][e] = w0[e]; w[j][4 + e] = w1[e]; } } }
        const float sc = (c >= QKW) ? 0.0625f : 1.f;
        float x3[8], x2[8], x1[8];
#pragma unroll
        for (int e = 0; e < 8; ++e) { x3[e] = 0.f; x2[e] = 0.f; x1[e] = 0.f; }
        if (t0 > 0) { unpack8(*(const v4u*)(z + (size_t)(r0 - 3) * INW_MAIN + c), x3); unpack8(*(const v4u*)(z + (size_t)(r0 - 2) * INW_MAIN + c), x2); unpack8(*(const v4u*)(z + (size_t)(r0 - 1) * INW_MAIN + c), x1); }
#pragma unroll 4
        for (int r = 0; r < SEGR; ++r) {
            float x0[8]; unpack8(*(const v4u*)(z + (size_t)(r0 + r) * INW_MAIN + c), x0);
            float o[8];
#pragma unroll
            for (int e = 0; e < 8; ++e) { const float a = bb[e] + w[0][e] * x3[e] + w[1][e] * x2[e] + w[2][e] * x1[e] + w[3][e] * x0[e]; o[e] = siluf_(a) * sc; x3[e] = x2[e]; x2[e] = x1[e]; x1[e] = x0[e]; }
            v4u ow; ow.x = pk2(o[0], o[1]); ow.y = pk2(o[2], o[3]); ow.z = pk2(o[4], o[5]); ow.w = pk2(o[6], o[7]);
            *(v4u*)(qk + (size_t)(r0 + r) * DM + c) = ow;
        }
    }
}

typedef short bf16x8 __attribute__((ext_vector_type(8)));
typedef short s16x4 __attribute__((ext_vector_type(4)));
typedef float f32x16 __attribute__((ext_vector_type(16)));
typedef __attribute__((address_space(3))) const unsigned char* lds_cptr;
__device__ __forceinline__ s16x4 vtr(lds_cptr p) { return __builtin_bit_cast(s16x4, __builtin_amdgcn_ds_read_tr16_b64_v4i16((__attribute__((address_space(3))) s16x4*)p)); }
__device__ __forceinline__ bf16x8 cat8(s16x4 lo, s16x4 hi) { return (bf16x8){lo[0], lo[1], lo[2], lo[3], hi[0], hi[1], hi[2], hi[3]}; }

constexpr int NSL = 17;
constexpr size_t CST_SLICE = 16384;
constexpr int L2_KSTR = 576, L2_KBUF = 64 * L2_KSTR;
constexpr int L2_VBUF = 64 * 64;

__device__ __forceinline__ float log_sigmoidf_(float x) { return (x >= 0.f) ? -log1pf(__expf(-x)) : x - log1pf(__expf(x)); }
__device__ __forceinline__ void p_lstm_scan2(const Frame& F, const float* gates, float* U, float* Mx, float* E) {
    if (F.vcu >= 8) return;
    const int bh = F.vcu, b = bh >> 2, h = bh & 3, tid = F.tid, lane = F.lane, w = F.wave, t0 = tid * 8;
    LAS float* wsum = (LAS float*)F.lds; LAS float* wmax = wsum + 8;
    const float* gb = gates + (size_t)(b * SEQ + t0) * 8;
    float lf[8], li[8];
#pragma unroll
    for (int i = 0; i < 8; ++i) { lf[i] = gb[i * 8 + 4 + h]; li[i] = gb[i * 8 + h]; }
    float s = 0.f;
#pragma unroll
    for (int i = 0; i < 8; ++i) { lf[i] = log_sigmoidf_(lf[i]); s += lf[i]; }
    float inc = s;
#pragma unroll
    for (int o = 1; o < 64; o <<= 1) { const float y = __shfl_up(inc, o); if (lane >= o) inc += y; }
    __syncthreads();
    if (lane == 63) wsum[w] = inc;
    __syncthreads();
    float base = 0.f;
#pragma unroll
    for (int q = 0; q < 8; ++q) base += (q < w) ? wsum[q] : 0.f;
    float Fc = base + inc - s, lm = -INFINITY; float u[8], Fv[8];
#pragma unroll
    for (int i = 0; i < 8; ++i) { Fc += lf[i]; Fv[i] = Fc; u[i] = li[i] - Fc; lm = fmaxf(lm, u[i]); }
    float pm = lm;
#pragma unroll
    for (int o = 1; o < 64; o <<= 1) { const float y = __shfl_up(pm, o); if (lane >= o) pm = fmaxf(pm, y); }
    if (lane == 63) wmax[w] = pm;
    __syncthreads();
    float mm = __shfl_up(pm, 1); if (lane == 0) mm = 0.f;
#pragma unroll
    for (int q = 0; q < 8; ++q) mm = fmaxf(mm, (q < w) ? wmax[q] : 0.f);
    mm = fmaxf(mm, 0.f);
#pragma unroll
    for (int i = 0; i < 8; ++i) { mm = fmaxf(mm, u[i]); U[bh * SEQ + t0 + i] = u[i]; Mx[bh * SEQ + t0 + i] = mm; E[bh * SEQ + t0 + i] = __expf(-(Fv[i] + mm)); }
    __syncthreads();
}

constexpr int S2_KSTR = 320, S2_KBUF = 64 * S2_KSTR;
constexpr int S2_VSTR = 192, S2_VBUF = 64 * S2_VSTR;
constexpr int S2_NWG = 128;
__device__ __forceinline__ void p_lstm_state(const Frame& F, const bf16* qk, const bf16* z, const float* U, const float* Mx, unsigned char* cst, float* nst) {
    const int item = F.vcu; if (item >= S2_NWG) return;
    const int bh = item >> 4, dkh = (item >> 3) & 1, dvp = item & 7, b = bh >> 2, h = bh & 3;
    const int tid = F.tid, lane = F.lane, w = F.wave, hi = lane >> 5, g1 = (lane >> 4) & 1, q4 = (lane & 15) >> 2, p4 = lane & 3, kbk = w & 3, vbk = w >> 2;
    LAS unsigned char* kb0 = F.lds; LAS unsigned char* vb0 = F.lds + 2 * S2_KBUF;
    const size_t rbase = (size_t)b * SEQ;
    const bf16* kg = qk + rbase * DM + QKW + h * LDK + 128 * dkh;
    const bf16* vg = z + rbase * INW_MAIN + 2 * QKW + h * LDV + 64 * dvp;
    const float* Ub = U + bh * SEQ; const float* Mb = Mx + bh * SEQ;
    const bool donorm = (dvp == 0);
    f32x16 acc;
#pragma unroll
    for (int r = 0; r < 16; ++r) acc[r] = 0.f;
    v4u kreg[4][2]; v4u vreg[4];
    LAS float* wtl = (LAS float*)(F.lds + 2 * S2_KBUF + 2 * S2_VBUF); LAS float* decl = wtl + SEQ; LAS float* nl = decl + 64;
    __syncthreads();
#pragma unroll
    for (int i = 0; i < 8; ++i) { const int t = tid + 512 * i; wtl[t] = __expf(Ub[t] - Mb[(t & ~63) + 63]); }
    if (tid < 64) decl[tid] = __expf((tid > 0 ? Mb[tid * 64 - 1] : 0.f) - Mb[tid * 64 + 63]);
    const int krow = tid >> 4, kch = tid & 15, vrow = tid >> 3, vch = tid & 7, nd = tid & 127, ntq = tid >> 7;
    float nacc = 0.f;
#define L2_LOAD(c, sl) do { const int t0_ = (c) * 64; \
        _Pragma("unroll") for (int i_ = 0; i_ < 2; ++i_) kreg[sl][i_] = *(const v4u*)(kg + (size_t)(t0_ + krow + 32 * i_) * DM + kch * 8); \
        vreg[sl] = *(const v4u*)(vg + (size_t)(t0_ + vrow) * INW_MAIN + vch * 8); } while (0)
#define L2_STORE(sl, buf, c_) do { \
        _Pragma("unroll") for (int i_ = 0; i_ < 2; ++i_) *(LAS v4u*)(kb0 + (buf) * S2_KBUF + (krow + 32 * i_) * S2_KSTR + kch * 16) = kreg[sl][i_]; \
        { const float wt_ = wtl[(c_) * 64 + vrow]; v4u o_; const v4u vr_ = vreg[sl]; \
            o_.x = pk2(bflo(vr_.x) * wt_, bfhi(vr_.x) * wt_); o_.y = pk2(bflo(vr_.y) * wt_, bfhi(vr_.y) * wt_); o_.z = pk2(bflo(vr_.z) * wt_, bfhi(vr_.z) * wt_); o_.w = pk2(bflo(vr_.w) * wt_, bfhi(vr_.w) * wt_); \
            *(LAS v4u*)(vb0 + (buf) * S2_VBUF + vrow * S2_VSTR + vch * 16) = o_; } } while (0)
    const int koff = (8 * hi + q4) * S2_KSTR + (32 * kbk + 16 * g1 + 4 * p4) * 2;
    const int voff = (8 * hi + q4) * S2_VSTR + (32 * vbk + 16 * g1 + 4 * p4) * 2;
    unsigned char* cdst = cst + ((size_t)(bh * 64) * NSL + (2 * dvp + vbk)) * CST_SLICE + ((size_t)((4 * dkh + kbk) * 2) * 64 + lane) * 16;
    float* ndst = nst + (size_t)(bh * 64) * LDK + 128 * dkh + nd;
    __syncthreads();
    L2_LOAD(0, 0); L2_LOAD(1, 1); L2_LOAD(2, 2); L2_LOAD(3, 3);
    L2_STORE(0, 0, 0);
    __syncthreads();
#define L2_CSTORE(c_) do { unsigned char* d = cdst + (size_t)(c_) * NSL * CST_SLICE; \
          _Pragma("unroll") for (int s_ = 0; s_ < 2; ++s_) { v4u o; o.x = pk2(acc[8 * s_ + 0], acc[8 * s_ + 1]); o.y = pk2(acc[8 * s_ + 2], acc[8 * s_ + 3]); o.z = pk2(acc[8 * s_ + 4], acc[8 * s_ + 5]); o.w = pk2(acc[8 * s_ + 6], acc[8 * s_ + 7]); \
              *(v4u*)(d + s_ * 1024) = o; } } while (0)
#define L2_ITER(c, sl, sln) do { \
        const float decay = decl[c]; \
        if (donorm) { nl[(((c) & 1) * 4 + ntq) * 128 + nd] = nacc; \
            if ((c) > 0 && tid < 128) { const LAS float* np_ = nl + ((((c) - 1) & 1) * 4) * 128 + tid; ndst[(size_t)((c) - 1) * LDK] = (np_[0] + np_[128]) + (np_[256] + np_[384]); } \
            float np = 0.f; const LAS unsigned char* kr_ = kb0 + ((c) & 1) * S2_KBUF + (16 * ntq) * S2_KSTR + nd * 2; const LAS float* wr_ = wtl + (c) * 64 + 16 * ntq; \
            _Pragma("unroll") for (int t_ = 0; t_ < 16; ++t_) np += wr_[t_] * bf2f(*(const LAS unsigned short*)(kr_ + t_ * S2_KSTR)); \
            nacc = nacc * decay + np; } \
        _Pragma("unroll") for (int r = 0; r < 16; ++r) acc[r] *= decay; \
        { lds_cptr kp = (lds_cptr)(kb0 + ((c) & 1) * S2_KBUF + koff); lds_cptr vp = (lds_cptr)(vb0 + ((c) & 1) * S2_VBUF + voff); \
          _Pragma("unroll") for (int ks = 0; ks < 4; ++ks) { \
              const bf16x8 a = cat8(vtr(kp + ks * 16 * S2_KSTR), vtr(kp + ks * 16 * S2_KSTR + 4 * S2_KSTR)); \
              const bf16x8 bb = cat8(vtr(vp + ks * 16 * S2_VSTR), vtr(vp + ks * 16 * S2_VSTR + 4 * S2_VSTR)); \
              acc = __builtin_amdgcn_mfma_f32_32x32x16_bf16(a, bb, acc, 0, 0, 0); } } \
        if ((c) + 1 < 64) { L2_STORE(sln, ((c) + 1) & 1, (c) + 1); } \
        if ((c) + 4 < 64) L2_LOAD((c) + 4, sl); \
        if ((c) + 1 < 64) L2_CSTORE((c) + 1);            \
        asm volatile("s_waitcnt lgkmcnt(0)" ::: "memory"); __builtin_amdgcn_s_barrier(); asm volatile("" ::: "memory"); } while (0)
    L2_CSTORE(0);
    for (int c4 = 0; c4 < 64; c4 += 4) { L2_ITER(c4, 0, 1); L2_ITER(c4 + 1, 1, 2); L2_ITER(c4 + 2, 2, 3); L2_ITER(c4 + 3, 3, 0); }
    if (donorm && tid < 128) { const LAS float* np_ = nl + 4 * 128 + tid; ndst[(size_t)63 * LDK] = (np_[0] + np_[128]) + (np_[256] + np_[384]); }
#undef L2_ITER
#undef L2_CSTORE
#undef L2_LOAD
#undef L2_STORE
}

constexpr int L3_QSTR = 528, L3_VSTR = 1088, L3_WSTR = 144;
constexpr int L3_Q = 0, L3_K = L3_Q + 64 * L3_QSTR, L3_V = L3_K + 64 * L3_QSTR, L3_W = L3_V + 64 * L3_VSTR, L3_SC = L3_W + 64 * L3_WSTR, L3_END = L3_SC + 8192;
__device__ __forceinline__ void p_lstm_out(const Frame& F, const bf16* qk, const bf16* z, const float* U, const float* Mx, const float* E, const unsigned char* cst, const float* nst, const float* hgain, bf16* O) {
    const int tid = F.tid, lane = F.lane, w = F.wave, hi = lane >> 5, g1 = (lane >> 4) & 1, q4 = (lane & 15) >> 2, p4 = lane & 3, l31 = lane & 31;
    LAS unsigned char* lds = F.lds;
    LAS float* sc = (LAS float*)(lds + L3_SC);
    LAS float* uS = sc, *Mrow = sc + 64, *inter = sc + 128, *Erow = sc + 192, *dinv = sc + 256, *nvec = sc + 320, *ssq = sc + 576, *rstdv = sc + 1088;
    for (int item = F.vcu; item < 8 * 64; item += F.G) {
        const int bh = item >> 6, c = item & 63, b = bh >> 2, h = bh & 3, t0 = c * 64;
        const size_t row0 = (size_t)b * SEQ + t0;
        __syncthreads();
        { v4u rq[4], rk[4], rv[8];
#pragma unroll
          for (int i = 0; i < 4; ++i) { const int id = tid + 512 * i, r = id >> 5, ch = id & 31;
              rq[i] = *(const v4u*)(qk + (row0 + r) * DM + h * LDK + ch * 8); rk[i] = *(const v4u*)(qk + (row0 + r) * DM + QKW + h * LDK + ch * 8); }
#pragma unroll
          for (int i = 0; i < 8; ++i) { const int id = tid + 512 * i, r = id >> 6, ch = id & 63; rv[i] = *(const v4u*)(z + (row0 + r) * INW_MAIN + 2 * QKW + h * LDV + ch * 8); }
#pragma unroll
          for (int i = 0; i < 4; ++i) { const int id = tid + 512 * i, r = id >> 5, ch = id & 31;
              *(LAS v4u*)(lds + L3_Q + r * L3_QSTR + ch * 16) = rq[i]; *(LAS v4u*)(lds + L3_K + r * L3_QSTR + ch * 16) = rk[i]; }
#pragma unroll
          for (int i = 0; i < 8; ++i) { const int id = tid + 512 * i, r = id >> 6, ch = id & 63; *(LAS v4u*)(lds + L3_V + r * L3_VSTR + ch * 16) = rv[i]; } }
        if (tid < 64) { const float mr = Mx[bh * SEQ + t0 + tid]; const float mp = (c > 0) ? Mx[bh * SEQ + t0 - 1] : 0.f;
            uS[tid] = U[bh * SEQ + t0 + tid]; Mrow[tid] = mr; inter[tid] = __expf(mp - mr); Erow[tid] = E[bh * SEQ + t0 + tid]; }
        else if (tid < 128) { const int i4 = tid - 64; *(LAS f32x4*)(nvec + 4 * i4) = *(const f32x4*)(nst + (size_t)(bh * 64 + c) * LDK + 4 * i4); }
        __syncthreads();
        { const int rt = w >> 1, i15 = lane & 15, quad = lane >> 4;
#pragma unroll
          for (int cc = 0; cc < 2; ++cc) { const int ct = 2 * (w & 1) + cc;
              pg8::f32x4 sacc = (pg8::f32x4){0.f, 0.f, 0.f, 0.f};
              if (ct <= rt) {
                  const LAS unsigned char* qa = lds + L3_Q + (16 * rt + i15) * L3_QSTR + quad * 16; const LAS unsigned char* ka = lds + L3_K + (16 * ct + i15) * L3_QSTR + quad * 16;
#pragma unroll
                  for (int ks = 0; ks < 8; ++ks) { const bf16x8 a = *(const LAS bf16x8*)(qa + ks * 64), bb = *(const LAS bf16x8*)(ka + ks * 64);
                      sacc = __builtin_amdgcn_mfma_f32_16x16x32_bf16(a, bb, sacc, 0, 0, 0); } }
              const int s_ = 16 * ct + i15; const float us = uS[s_];
#pragma unroll
              for (int e = 0; e < 4; ++e) { const int l_ = 16 * rt + 4 * quad + e; const float wv = (s_ <= l_) ? sacc[e] * __expf(us - Mrow[l_]) : 0.f;
                  *(LAS unsigned short*)(lds + L3_W + l_ * L3_WSTR + s_ * 2) = (unsigned short)f2bf(wv); } } }
        __syncthreads();
        { const int r = tid >> 3, part = tid & 7; const v4u wv = *(const LAS v4u*)(lds + L3_W + r * L3_WSTR + part * 16);
          float rs = (bflo(wv.x) + bfhi(wv.x)) + (bflo(wv.y) + bfhi(wv.y)) + (bflo(wv.z) + bfhi(wv.z)) + (bflo(wv.w) + bfhi(wv.w)); float qn = 0.f;
#pragma unroll
          for (int i = 0; i < 4; ++i) { const v4u qv = *(const LAS v4u*)(lds + L3_Q + r * L3_QSTR + part * 64 + i * 16); const LAS float* np = nvec + part * 32 + i * 8;
              qn += bflo(qv.x) * np[0] + bfhi(qv.x) * np[1] + bflo(qv.y) * np[2] + bfhi(qv.y) * np[3] + bflo(qv.z) * np[4] + bfhi(qv.z) * np[5] + bflo(qv.w) * np[6] + bfhi(qv.w) * np[7]; }
          float den = inter[r] * qn + rs; den += __shfl_xor(den, 1); den += __shfl_xor(den, 2); den += __shfl_xor(den, 4);
          if (part == 0) dinv[r] = 1.f / fmaxf(fabsf(den), Erow[r]); }
        f32x16 acc[2][2];
#pragma unroll
        for (int a = 0; a < 2; ++a)
#pragma unroll
            for (int bq = 0; bq < 2; ++bq)
#pragma unroll
                for (int r = 0; r < 16; ++r) acc[a][bq][r] = 0.f;
        { const unsigned char* cb = cst + ((size_t)(bh * 64 + c) * NSL + 2 * w) * CST_SLICE + (size_t)lane * 16;
          const LAS unsigned char* qa = lds + L3_Q + l31 * L3_QSTR + hi * 8;
          bf16x8 bfr[2][8];
#pragma unroll
          for (int q = 0; q < 4; ++q) { bfr[0][2 * q] = *(const bf16x8*)(cb + q * 1024); bfr[0][2 * q + 1] = *(const bf16x8*)(cb + CST_SLICE + q * 1024); }
#pragma unroll
          for (int gq = 0; gq < 4; ++gq) {
              if (gq < 3) {
#pragma unroll
                  for (int q = 0; q < 4; ++q) { bfr[(gq + 1) & 1][2 * q] = *(const bf16x8*)(cb + (4 * (gq + 1) + q) * 1024); bfr[(gq + 1) & 1][2 * q + 1] = *(const bf16x8*)(cb + CST_SLICE + (4 * (gq + 1) + q) * 1024); } }
#pragma unroll
              for (int q = 0; q < 4; ++q) { const int kk = 4 * gq + q; const bf16x8 b0 = bfr[gq & 1][2 * q], b1 = bfr[gq & 1][2 * q + 1];
                  bf16x8 a[2];
#pragma unroll
                  for (int rt = 0; rt < 2; ++rt) { const s16x4 lo = *(const LAS s16x4*)(qa + rt * 32 * L3_QSTR + kk * 32), hh = *(const LAS s16x4*)(qa + rt * 32 * L3_QSTR + kk * 32 + 16); a[rt] = cat8(lo, hh); }
                  acc[0][0] = __builtin_amdgcn_mfma_f32_32x32x16_bf16(a[0], b0, acc[0][0], 0, 0, 0);
                  acc[0][1] = __builtin_amdgcn_mfma_f32_32x32x16_bf16(a[0], b1, acc[0][1], 0, 0, 0);
                  acc[1][0] = __builtin_amdgcn_mfma_f32_32x32x16_bf16(a[1], b0, acc[1][0], 0, 0, 0);
                  acc[1][1] = __builtin_amdgcn_mfma_f32_32x32x16_bf16(a[1], b1, acc[1][1], 0, 0, 0); }
              __builtin_amdgcn_sched_barrier(0); } }
#pragma unroll
        for (int rt = 0; rt < 2; ++rt)
#pragma unroll
            for (int r = 0; r < 16; ++r) { const float f = inter[32 * rt + (r & 3) + 8 * (r >> 2) + 4 * hi]; acc[rt][0][r] *= f; acc[rt][1][r] *= f; }
        { const LAS unsigned char* wa = lds + L3_W + l31 * L3_WSTR + hi * 16;
          lds_cptr vp = (lds_cptr)(lds + L3_V + (8 * hi + q4) * L3_VSTR + (64 * w + 16 * g1 + 4 * p4) * 2);
#pragma unroll
          for (int ks = 0; ks < 4; ++ks) {
              const bf16x8 a0 = *(const LAS bf16x8*)(wa + ks * 32), a1 = *(const LAS bf16x8*)(wa + 32 * L3_WSTR + ks * 32);
              const bf16x8 b0 = cat8(vtr(vp + ks * 16 * L3_VSTR), vtr(vp + ks * 16 * L3_VSTR + 4 * L3_VSTR));
              const bf16x8 b1 = cat8(vtr(vp + ks * 16 * L3_VSTR + 64), vtr(vp + ks * 16 * L3_VSTR + 4 * L3_VSTR + 64));
              acc[0][0] = __builtin_amdgcn_mfma_f32_32x32x16_bf16(a0, b0, acc[0][0], 0, 0, 0);
              acc[0][1] = __builtin_amdgcn_mfma_f32_32x32x16_bf16(a0, b1, acc[0][1], 0, 0, 0);
              acc[1][0] = __builtin_amdgcn_mfma_f32_32x32x16_bf16(a1, b0, acc[1][0], 0, 0, 0);
              acc[1][1] = __builtin_amdgcn_mfma_f32_32x32x16_bf16(a1, b1, acc[1][1], 0, 0, 0); } }
        __syncthreads();
        { LAS unsigned short* hb = (LAS unsigned short*)(lds + L3_V);
#pragma unroll
          for (int rt = 0; rt < 2; ++rt)
#pragma unroll
              for (int r = 0; r < 16; ++r) { const int l_ = 32 * rt + (r & 3) + 8 * (r >> 2) + 4 * hi; const float dn = dinv[l_];
                  const float x0 = acc[rt][0][r] * dn, x1 = acc[rt][1][r] * dn;
                  const unsigned pw = pk2(x0, x1);
                  hb[l_ * (L3_VSTR / 2) + 64 * w + l31] = (unsigned short)(pw & 0xffffu); hb[l_ * (L3_VSTR / 2) + 64 * w + 32 + l31] = (unsigned short)(pw >> 16);
                  float q2 = x0 * x0 + x1 * x1; q2 += __shfl_xor(q2, 1); q2 += __shfl_xor(q2, 2); q2 += __shfl_xor(q2, 4); q2 += __shfl_xor(q2, 8); q2 += __shfl_xor(q2, 16);
                  if (l31 == 0) ssq[w * 64 + l_] = q2; } }
        __syncthreads();
        if (tid < 64) { float tot = 0.f;
#pragma unroll
            for (int ww = 0; ww < 8; ++ww) tot += ssq[ww * 64 + tid];
            rstdv[tid] = 1.f / sqrtf(tot * (1.f / LDV) + NORM_EPS); }
        __syncthreads();
        { const int ch = tid & 63; const f32x4 ga = *(const f32x4*)(hgain + h * LDV + ch * 8), gb = *(const f32x4*)(hgain + h * LDV + ch * 8 + 4);
#pragma unroll 2
          for (int i = 0; i < 8; ++i) { const int r = (tid >> 6) + 8 * i;
              const v4u ogv = *(const v4u*)(z + (row0 + r) * INW_MAIN + 2 * QKW + DM + h * LDV + ch * 8);
              const v4u hv = *(const LAS v4u*)(lds + L3_V + r * L3_VSTR + ch * 16);
              float hf[8], gf[8]; unpack8(hv, hf); unpack8(ogv, gf);
              const float rstd = rstdv[r];
#pragma unroll
              for (int e = 0; e < 8; ++e) gf[e] = rstd * __builtin_amdgcn_rcpf(1.f + __expf(-gf[e]));
              v4u o; o.x = pk2(hf[0] * ga[0] * gf[0], hf[1] * ga[1] * gf[1]); o.y = pk2(hf[2] * ga[2] * gf[2], hf[3] * ga[3] * gf[3]);
              o.z = pk2(hf[4] * gb[0] * gf[4], hf[5] * gb[1] * gf[5]); o.w = pk2(hf[6] * gb[2] * gf[6], hf[7] * gb[3] * gf[7]);
              *(v4u*)(O + (row0 + r) * DM + h * LDV + ch * 8) = o; } }
    }
    __syncthreads();
}


constexpr int AT_K = 0, AT_V = 65536;
__device__ __forceinline__ void p_attn(const Frame& F, const bf16* qkv, const float* qg, const float* kg, bf16* OG, float* LSE) {
    const int tid = F.tid, lane = F.lane, w = F.wave, i15 = lane & 15, quad = lane >> 4, q4 = i15 >> 2, p4 = lane & 3;
    LAS unsigned char* lds = F.lds;
    int lk[4];
#pragma unroll
    for (int ks = 0; ks < 4; ++ks) lk[ks] = i15 * 256 + (((4 * ks + quad) ^ i15) << 4);
    int lv[8];
    { const int rl = 4 * quad + q4, sw = (rl & 7) << 1, ps = ((p4 & 1) << 1) | (p4 >> 1);
#pragma unroll
      for (int dt = 0; dt < 8; ++dt) lv[dt] = rl * 256 + (((2 * dt + (ps >> 1)) ^ sw) << 4) + 8 * (ps & 1); }
#define AT_NIT(it_) ((F.vcu + F.G * ((it_) / 12)) < 256)
#define AT_DECODE(it_) const int grp_ = F.vcu + F.G * ((it_) / 12), k_ = (it_) % 12, b_ = grp_ >> 7, h_ = (grp_ >> 3) & 15, o_ = grp_ & 7; \
        const int g_ = k_ >> 2, dil_ = (g_ == 0) ? 1 : (g_ == 1) ? 4 : 16; \
        const int res_ = (g_ == 0) ? 0 : (g_ == 1) ? (o_ >> 1) : (2 * o_ + ((k_ - 8) >> 1)), n_ = (g_ == 0) ? (4 * o_ + k_) : (g_ == 1) ? (4 * (o_ & 1) + (k_ - 4)) : (k_ & 1); \
        const bool first_ = (g_ == 2) ? ((k_ & 1) == 0) : ((k_ & 3) == 0); const size_t brow_ = (size_t)b_ * SEQ;
    v4u pkc[4], pvc[4], pkp[4], pvp[4], pq_[4];
#define AT_PRELOAD(it_) do { AT_DECODE(it_) \
        _Pragma("unroll") for (int i = 0; i < 4; ++i) { const int id = tid + 512 * i, j = id >> 4, ch = id & 15; \
            const bf16* src = qkv + (brow_ + (size_t)(128 * n_ + j) * dil_ + res_) * NQKV + DM + h_ * AHD + ch * 8; pkc[i] = *(const v4u*)src; pvc[i] = *(const v4u*)(src + DM); } \
        if (first_ && n_ > 0) { _Pragma("unroll") for (int i = 0; i < 4; ++i) { const int id = tid + 512 * i, j = id >> 4, ch = id & 15; \
            const bf16* src = qkv + (brow_ + (size_t)(128 * (n_ - 1) + j) * dil_ + res_) * NQKV + DM + h_ * AHD + ch * 8; pkp[i] = *(const v4u*)src; pvp[i] = *(const v4u*)(src + DM); } } \
        { const size_t qrow_ = brow_ + (size_t)(128 * n_ + 16 * w + i15) * dil_ + res_; \
          _Pragma("unroll") for (int ks = 0; ks < 4; ++ks) pq_[ks] = *(const v4u*)(qkv + qrow_ * NQKV + h_ * AHD + 32 * ks + 8 * quad); } } while (0)
    if (AT_NIT(0)) AT_PRELOAD(0);
    for (int it = 0; AT_NIT(it); ++it) {
        AT_DECODE(it)
        const int g = g_, h = h_, n = n_, dil = dil_, res = res_; const size_t brow = brow_;
        const int hcur = (n & 1) * 32768, hprev = 32768 - hcur;
        asm volatile("s_waitcnt lgkmcnt(0)" ::: "memory"); __builtin_amdgcn_s_barrier(); asm volatile("" ::: "memory");
#pragma unroll
        for (int i = 0; i < 4; ++i) { const int id = tid + 512 * i, j = id >> 4, ch = id & 15;
            *(LAS v4u*)(lds + AT_K + hcur + j * 256 + ((ch ^ (j & 15)) << 4)) = pkc[i];
            *(LAS v4u*)(lds + AT_V + hcur + j * 256 + ((ch ^ ((j & 7) << 1)) << 4)) = pvc[i]; }
        if (first_) {
#pragma unroll
            for (int i = 0; i < 4; ++i) { const int id = tid + 512 * i, j = id >> 4, ch = id & 15;
                v4u kv = pkp[i], vvv = pvp[i]; if (n == 0) { kv = (v4u){0u, 0u, 0u, 0u}; vvv = kv; }
                *(LAS v4u*)(lds + AT_K + hprev + j * 256 + ((ch ^ (j & 15)) << 4)) = kv;
                *(LAS v4u*)(lds + AT_V + hprev + j * 256 + ((ch ^ ((j & 7) << 1)) << 4)) = vvv; } }
        const size_t qrow = brow + (size_t)(128 * n + 16 * w + i15) * dil + res;
        bf16x8 qf[4];
#pragma unroll
        for (int ks = 0; ks < 4; ++ks) qf[ks] = __builtin_bit_cast(bf16x8, pq_[ks]);
        asm volatile("s_waitcnt lgkmcnt(0)" ::: "memory"); __builtin_amdgcn_s_barrier(); asm volatile("" ::: "memory");
        if (AT_NIT(it + 1)) AT_PRELOAD(it + 1);
#define AT_TOFF(T) ((((T) < 8) ? hprev : hcur) + ((T) & 7) * 4096)
        pg8::f32x4 st[9];
        { bf16x8 ka[3][4];
#pragma unroll
          for (int ks = 0; ks < 4; ++ks) { ka[0][ks] = *(const LAS bf16x8*)(lds + AT_K + AT_TOFF(w) + lk[ks]); ka[1][ks] = *(const LAS bf16x8*)(lds + AT_K + AT_TOFF(w + 1) + lk[ks]); }
#pragma unroll
          for (int jt = 0; jt < 9; ++jt) { st[jt] = (pg8::f32x4){0.f, 0.f, 0.f, 0.f};
              if (jt < 7) {
#pragma unroll
                  for (int ks = 0; ks < 4; ++ks) ka[(jt + 2) % 3][ks] = *(const LAS bf16x8*)(lds + AT_K + AT_TOFF(w + jt + 2) + lk[ks]); }
              if (n > 0 || w + jt >= 8) {
#pragma unroll
              for (int ks = 0; ks < 4; ++ks) st[jt] = __builtin_amdgcn_mfma_f32_16x16x32_bf16(ka[jt % 3][ks], qf[ks], st[jt], 0, 0, 0); }
              __builtin_amdgcn_sched_barrier(0); } }
        float mx = -INFINITY;
#pragma unroll
        for (int jt = 0; jt < 9; ++jt) { const bool tile_ok = (n > 0) || (w + jt >= 8);
#pragma unroll
            for (int e = 0; e < 4; ++e) { const int dj = 16 * jt + 4 * quad + e - i15;
                const bool ok = tile_ok && (jt != 0 || dj >= 0) && (jt != 8 || dj <= 128);
                const float s = ok ? st[jt][e] : -INFINITY; st[jt][e] = s; mx = fmaxf(mx, s); } }
        mx = fmaxf(mx, __shfl_xor(mx, 16)); mx = fmaxf(mx, __shfl_xor(mx, 32));
        float l = 0.f;
#pragma unroll
        for (int jt = 0; jt < 9; ++jt)
#pragma unroll
            for (int e = 0; e < 4; ++e) { const float p = __builtin_amdgcn_exp2f(st[jt][e] - mx); st[jt][e] = p; l += p; }
        l += __shfl_xor(l, 16); l += __shfl_xor(l, 32);
        pg8::f32x4 ot[8];
#pragma unroll
        for (int dt = 0; dt < 8; ++dt) ot[dt] = (pg8::f32x4){0.f, 0.f, 0.f, 0.f};
        { bf16x8 pb[5];
#pragma unroll
          for (int kk = 0; kk < 5; ++kk) { v4u pw; pw.x = pk2(st[2 * kk][0], st[2 * kk][1]); pw.y = pk2(st[2 * kk][2], st[2 * kk][3]);
              if (kk < 4) { pw.z = pk2(st[2 * kk + 1][0], st[2 * kk + 1][1]); pw.w = pk2(st[2 * kk + 1][2], st[2 * kk + 1][3]); } else { pw.z = 0u; pw.w = 0u; }
              pb[kk] = __builtin_bit_cast(bf16x8, pw); }
          s16x4 vf[3][4][2];
          const int t1last = (w == 7) ? 8 : 9;
#define AT_VLOAD(bt, buf) do { const int kk_ = (bt) >> 1, hf_ = (bt) & 1; const int t0_ = w + 2 * kk_, t1_ = w + ((kk_ < 4) ? (2 * kk_ + 1) : t1last); const int o0_ = AT_TOFF(t0_), o1_ = AT_TOFF(t1_); \
          _Pragma("unroll") for (int d_ = 0; d_ < 4; ++d_) { vf[buf][d_][0] = vtr((lds_cptr)(lds + AT_V + o0_ + lv[4 * hf_ + d_])); vf[buf][d_][1] = vtr((lds_cptr)(lds + AT_V + o1_ + lv[4 * hf_ + d_])); } } while (0)
          AT_VLOAD(0, 0); AT_VLOAD(1, 1);
#pragma unroll
          for (int bt = 0; bt < 10; ++bt) {
              if (bt < 8) AT_VLOAD(bt + 2, (bt + 2) % 3);
              if (n > 0 || w + 2 * (bt >> 1) + 1 >= 8) {
#pragma unroll
              for (int d = 0; d < 4; ++d) ot[4 * (bt & 1) + d] = __builtin_amdgcn_mfma_f32_16x16x32_bf16(cat8(vf[bt % 3][d][0], vf[bt % 3][d][1]), pb[bt >> 1], ot[4 * (bt & 1) + d], 0, 0, 0); }
              __builtin_amdgcn_sched_barrier(0); }
#undef AT_VLOAD
        }
#undef AT_TOFF
        { const float il = 1.f / l; const int hi32 = quad >> 1, ql = quad & 1; bf16* op = OG + ((size_t)g * MROWS + qrow) * DM + h * AHD + 16 * hi32 + 8 * ql;
#pragma unroll
          for (int dp = 0; dp < 4; ++dp) { const unsigned x0 = pk2(ot[2 * dp][0] * il, ot[2 * dp][1] * il), x1 = pk2(ot[2 * dp][2] * il, ot[2 * dp][3] * il);
              const unsigned y0 = pk2(ot[2 * dp + 1][0] * il, ot[2 * dp + 1][1] * il), y1 = pk2(ot[2 * dp + 1][2] * il, ot[2 * dp + 1][3] * il);
              const auto r0 = __builtin_amdgcn_permlane32_swap(x0, y0, false, false), r1 = __builtin_amdgcn_permlane32_swap(x1, y1, false, false);
              v4u o; o.x = r0[0]; o.y = r1[0]; o.z = r0[1]; o.w = r1[1]; *(v4u*)(op + 32 * dp) = o; }
          if (quad == 0) LSE[(qrow * AH + h) * 4 + g] = (mx + __log2f(l)) * 0.6931471805599453f; }
    }
#undef AT_NIT
#undef AT_DECODE
#undef AT_PRELOAD
    __syncthreads();
}
__device__ __forceinline__ void p_attn_combine(const Frame& F, const bf16* OG, const float* LSE, bf16* O) {
    const size_t total = (size_t)MROWS * (DM / 8), stride = (size_t)F.G * NTHREADS;
    for (size_t idx = (size_t)F.vcu * NTHREADS + F.tid; idx < total; idx += stride) {
        const int c8 = (int)(idx & 255), row = (int)(idx >> 8), h = c8 >> 4;
        const f32x4 lv = *(const f32x4*)(LSE + ((size_t)row * AH + h) * 4); const float l0 = lv[0], l1 = lv[1], l2 = lv[2];
        const float m = fmaxf(l0, fmaxf(l1, l2)); float w0 = __expf(l0 - m), w1 = __expf(l1 - m), w2 = __expf(l2 - m); const float inv = 1.f / (w0 + w1 + w2); w0 *= inv; w1 *= inv; w2 *= inv;
        const v4u a = *(const v4u*)(OG + ((size_t)0 * MROWS + row) * DM + c8 * 8), bq = *(const v4u*)(OG + ((size_t)1 * MROWS + row) * DM + c8 * 8), cq = *(const v4u*)(OG + ((size_t)2 * MROWS + row) * DM + c8 * 8);
        v4u o;
        o.x = pk2(w0 * bflo(a.x) + w1 * bflo(bq.x) + w2 * bflo(cq.x), w0 * bfhi(a.x) + w1 * bfhi(bq.x) + w2 * bfhi(cq.x));
        o.y = pk2(w0 * bflo(a.y) + w1 * bflo(bq.y) + w2 * bflo(cq.y), w0 * bfhi(a.y) + w1 * bfhi(bq.y) + w2 * bfhi(cq.y));
        o.z = pk2(w0 * bflo(a.z) + w1 * bflo(bq.z) + w2 * bflo(cq.z), w0 * bfhi(a.z) + w1 * bfhi(bq.z) + w2 * bfhi(cq.z));
        o.w = pk2(w0 * bflo(a.w) + w1 * bflo(bq.w) + w2 * bflo(cq.w), w0 * bfhi(a.w) + w1 * bfhi(bq.w) + w2 * bfhi(cq.w));
        *(v4u*)(O + (size_t)row * DM + c8 * 8) = o;
    }
}

__device__ __forceinline__ void p_gemm_bf16(const Frame& F, const bf16* A, const bf16* Bt, int N, int K, bf16* O) {
    pg8::Gemm g{A, Bt, MROWS, N, K}; pg8::EpiBf16<0> E{O, N, nullptr, 0, 0, 1.f};
    pg8::StaticOrder S; S.init(MROWS, N, F.G, (int)blockIdx.x);
    pg8::gemm_phase<pg8::EpiBf16<0>, pg8::StaticOrder, true, true>(F.lds, g, S, E);
}
template <bool RB_IN, bool RB_OUT, bool WITH_SSQ> __device__ __forceinline__ void p_gemm_res(const Frame& F, const bf16* A, const bf16* Bt, int N, int K, const void* base, void* out, float* ssq = nullptr) {
    pg8::Gemm g{A, Bt, MROWS, N, K}; pg8::EpiRes<RB_IN, RB_OUT, WITH_SSQ> E{base, out, N, ssq};
    pg8::StaticOrder S; S.init(MROWS, N, F.G, (int)blockIdx.x);
    pg8::gemm_phase<pg8::EpiRes<RB_IN, RB_OUT, WITH_SSQ>, pg8::StaticOrder, true, true>(F.lds, g, S, E);
}
__device__ __forceinline__ void p_gemm_convgate(const Frame& F, const bf16* X, const bf16* Wt, const float* cw, const float* cb, bf16* Gout, const float* ssq) {
    pg8::Gemm g{Wt, X, FFN2, MROWS, DM}; pg8::EpiConvGateT E{Gout, cw, cb, (PG8_LAS float*)(F.lds + RING_BYTES)};
    pg8::StaticOrder S; S.init_tiles(FFN2 / 256, 2 * pg8::EpiConvGateT::TPS, F.G, (int)blockIdx.x);
    { LAS float* rsl = (LAS float*)(F.lds + RING_BYTES) + 5120; const int rl = F.tid >> 1, hf = F.tid & 1;
      __syncthreads();
#pragma unroll 2
      for (int i = 0; i < 7; ++i) { pg8::Unit u; if (!S.next(i, u)) break;
          int grow = pg8::EpiConvGateT::b_row0(u.pn) + rl; grow = grow < 0 ? 0 : (grow > MROWS - 1 ? MROWS - 1 : grow);
          const float* sp = ssq + (size_t)grow * 32 + 16 * hf; const f32x4 a0 = *(const f32x4*)sp, a1 = *(const f32x4*)(sp + 4), a2 = *(const f32x4*)(sp + 8), a3 = *(const f32x4*)(sp + 12);
          float t = ((a0[0] + a0[1]) + (a0[2] + a0[3])) + ((a1[0] + a1[1]) + (a1[2] + a1[3])) + ((a2[0] + a2[1]) + (a2[2] + a2[3])) + ((a3[0] + a3[1]) + (a3[2] + a3[3]));
          t += __shfl_xor(t, 1); if (hf == 0) rsl[256 * i + rl] = __builtin_amdgcn_rsqf(t * (1.f / DM) + NORM_EPS); }
      __syncthreads(); }
    pg8::gemm_phase<pg8::EpiConvGateT, pg8::StaticOrder, true, true>(F.lds, g, S, E);
}

__device__ __forceinline__ void p_gemm_qkv(const Frame& F, const bf16* A, const bf16* Bt, const float* qg, const float* kg, bf16* O) {
    pg8::Gemm g{A, Bt, MROWS, NQKV, DM}; pg8::EpiQKV E{O, NQKV, qg, kg, (PG8_LAS float*)(F.lds + RING_BYTES), 0.08838834764831845f * 1.4426950408889634f};
    pg8::StaticOrder S; S.init(MROWS, NQKV, F.G, (int)blockIdx.x);
    pg8::gemm_phase<pg8::EpiQKV, pg8::StaticOrder, true, true>(F.lds, g, S, E);
}

constexpr int N_PHASES = 15;
__global__ void __launch_bounds__(NTHREADS, 2) mega(Args args) {
    extern __shared__ __attribute__((aligned(16))) unsigned char lds_raw[];
    Frame F; F.lds = (LAS unsigned char*)lds_raw;
    F.tid = threadIdx.x; F.lane = F.tid & 63; F.wave = __builtin_amdgcn_readfirstlane(F.tid >> 6);
    F.G = gridDim.x; { const int bx = blockIdx.x; F.vcu = (F.G % 8 == 0) ? (bx % 8) * (F.G / 8) + bx / 8 : bx; }
    volatile LAS unsigned* MISC = (volatile LAS unsigned*)(F.lds + MISC_OFF);
    static_assert(L3_END <= MISC_OFF, "LDS map");
    for (int u = F.tid; u < (LDS_BYTES - MISC_OFF) / 4; u += NTHREADS) ((LAS unsigned*)(F.lds + MISC_OFF))[u] = 0u;
    __syncthreads();
    unsigned char* ws = args.ws;
    unsigned* ctl = (unsigned*)(ws + WS_CTL);
    XcdBarrier bar = xcd_barrier_post(ctl + CW_BAR, MISC);

    const float* x = args.in[0];
    const float *attn_norm = args.in[1], *w_qkv = args.in[2], *q_gain = args.in[3], *k_gain = args.in[4], *w_o = args.in[5];
    const float *lstm_norm = args.in[6], *w_in = args.in[7], *gate_bias = args.in[8], *lconv_w = args.in[9], *lconv_b = args.in[10], *head_gain = args.in[11], *w_out = args.in[12];
    const float *ffn_norm = args.in[13], *w_up = args.in[14], *fconv_w = args.in[15], *fconv_b = args.in[16], *w_down = args.in[17];
    float* out = args.out;
    bf16 *Wqkv = (bf16*)(ws + WS_WQKV), *Wo = (bf16*)(ws + WS_WO), *Win = (bf16*)(ws + WS_WIN), *Wout = (bf16*)(ws + WS_WOUT), *Wup = (bf16*)(ws + WS_WUP), *Wdn = (bf16*)(ws + WS_WDN);
    bf16 *HN = (bf16*)(ws + WS_HN), *G = (bf16*)(ws + WS_G), *QKV = (bf16*)(ws + WS_QKV), *O = (bf16*)(ws + WS_O), *QKC = (bf16*)(ws + WS_QKC), *U = (bf16*)(ws + WS_U);
    bf16* OG = (bf16*)(ws + WS_QKC); float* LSE = (float*)(ws + WS_G);
    float* SSQ = (float*)(ws + WS_SSQ); float* GWT = (float*)(ws + WS_GWT); bf16* XR = (bf16*)(ws + WS_XR);
    float *GATES = (float*)(ws + WS_GATES), *SU = (float*)(ws + WS_SU), *SM = (float*)(ws + WS_SM), *SE = (float*)(ws + WS_SE);

    const int lo = args.ph_lo, hi = args.ph_hi;
#define IN(k) (lo <= (k) && (k) < hi)

    int ph = 0;
#ifndef PROBE_MASK
#define PROBE_MASK 0u
#endif
#define PHASE(body) do { if (IN(ph)) { body; if ((PROBE_MASK >> ph) & 1u) { body; } } if (IN(ph) && IN(ph + 1)) xcd_barrier(bar); ++ph; } while (0)
    PHASE(
        p_convert(F, w_qkv, Wqkv, DM, NQKV, NQKV);
        p_convert(F, w_o, Wo, DM, DM, DM);
        p_convert(F, w_up, Wup, DM, FFN2, FFN2, true, 0, 0, ffn_norm);
        p_convert(F, w_down, Wdn, FFN, DM, DM);
        p_pack_gates(F, w_in, GWT);
        p_rmsnorm<false>(F, x, attn_norm, HN, nullptr, nullptr, nullptr));
    PHASE(p_gemm_qkv(F, HN, Wqkv, q_gain, k_gain, QKV));
    PHASE(p_attn(F, QKV, q_gain, k_gain, OG, LSE));
    PHASE(p_attn_combine(F, OG, LSE, O));
    PHASE((p_gemm_res<false, true, true>(F, O, Wo, DM, DM, x, XR, SSQ)));
    int up_rank, up_n;
    { const int nu = (FFN2 / 256) * 2 * pg8::EpiConvGateT::TPS, rounds = (nu + F.G - 1) / F.G, nfull = nu - (rounds - 1) * F.G;
      if (nfull < F.G) { up_rank = (int)blockIdx.x - nfull; up_n = F.G - nfull; } else { up_rank = F.vcu; up_n = F.G; } }
    PHASE(p_gemm_convgate(F, XR, Wup, fconv_w, fconv_b, G, SSQ); p_convert(F, w_in, Win, DM, INW, INW_MAIN, false, up_rank, up_n));
    PHASE((p_gemm_res<true, true, false>(F, G, Wdn, DM, FFN, XR, XR)));
    PHASE(p_rmsnorm<true>(F, XR, lstm_norm, HN, GWT, gate_bias, GATES));
    PHASE(p_gemm_bf16(F, HN, Win, INW_MAIN, DM, QKV));
    PHASE(p_lstm_scan2(F, GATES, SU, SM, SE); p_lstm_conv(F, QKV, lconv_w, lconv_b, QKC));
    PHASE(p_lstm_state(F, QKC, QKV, SU, SM, ws + WS_CST, (float*)(ws + WS_NST));
          p_convert(F, w_up + (size_t)DM * FFN2, Wup + (size_t)FFN2 * DM, DM, FFN2, FFN2, true, F.vcu - S2_NWG, F.G - S2_NWG, ffn_norm + DM);
          p_convert(F, w_down + (size_t)FFN * DM, Wdn + (size_t)DM * FFN, FFN, DM, DM, false, F.vcu - S2_NWG, F.G - S2_NWG);
          p_convert(F, w_out, Wout, DM, DM, DM, false, F.vcu - S2_NWG, F.G - S2_NWG));
    PHASE(p_lstm_out(F, QKC, QKV, SU, SM, SE, ws + WS_CST, (const float*)(ws + WS_NST), head_gain, O));
    PHASE((p_gemm_res<true, true, true>(F, O, Wout, DM, DM, XR, XR, SSQ)));
    PHASE(p_gemm_convgate(F, XR, Wup + (size_t)FFN2 * DM, fconv_w + 3 * FFN2, fconv_b + FFN2, G, SSQ));
    PHASE((p_gemm_res<true, false, false>(F, G, Wdn + (size_t)DM * FFN, DM, FFN, XR, out)));
#undef PHASE
#undef IN
}

extern "C" void kernel_launch(void* const* d_in, const int* in_sizes, int n_in, void* d_out, int out_size, void* d_ws, size_t ws_size, hipStream_t stream) {
    static int grid = 0;
    if (grid == 0) {
        if (n_in != 18 || in_sizes[0] != MROWS * DM || out_size != MROWS * DM || ws_size < WS_END) { fprintf(stderr, "kernel_launch: unexpected problem (n_in %d, ws %zu < %zu)\n", n_in, ws_size, (size_t)WS_END); grid = -1; return; }
        int dev = 0, cus = 0, per_cu = 0;
        if (hipGetDevice(&dev) != hipSuccess || hipDeviceGetAttribute(&cus, hipDeviceAttributeMultiprocessorCount, dev) != hipSuccess) { grid = -1; return; }
        if (hipFuncSetAttribute((const void*)mega, hipFuncAttributeMaxDynamicSharedMemorySize, LDS_BYTES) != hipSuccess) { fprintf(stderr, "kernel_launch: hipFuncSetAttribute failed\n"); grid = -1; return; }
        if (hipOccupancyMaxActiveBlocksPerMultiprocessor(&per_cu, (const void*)mega, NTHREADS, LDS_BYTES) != hipSuccess || per_cu < 1) { fprintf(stderr, "kernel_launch: occupancy query says %d\n", per_cu); per_cu = 1; }
        (void)hipGetLastError();
        grid = cus;
    }
    if (grid < 0) return;
    if (hipMemsetAsync((char*)d_ws + WS_CTL, 0, CTL_ZERO_BYTES, stream) != hipSuccess) return;
    Args a; memset(&a, 0, sizeof(a));
    for (int i = 0; i < 18; ++i) a.in[i] = (const float*)d_in[i];
    a.out = (float*)d_out; a.ws = (unsigned char*)d_ws; a.ph_lo = 0; a.ph_hi = N_PHASES;
    void* kargs[] = {&a};
    hipError_t e = hipLaunchCooperativeKernel((const void*)mega, dim3(grid), dim3(NTHREADS), kargs, LDS_BYTES, stream);
    if (e != hipSuccess) { fprintf(stderr, "kernel_launch: cooperative launch failed: %s; plain launch instead\n", hipGetErrorString(e)); (void)hipGetLastError();
        hipLaunchKernelGGL(mega, dim3(grid), dim3(NTHREADS), LDS_BYTES, stream, a); }
}
```

```cpp
#include <hip/hip_runtime.h>
#include <cstdio>
#include <cstdint>
#include <cstring>

namespace pg8 {
#define PG8_LAS __attribute__((address_space(3)))
typedef unsigned short bf16_t;
typedef short bf16x8 __attribute__((ext_vector_type(8)));
typedef float f32x4 __attribute__((ext_vector_type(4)));
typedef unsigned u32x4 __attribute__((ext_vector_type(4)));
constexpr int BM = 256, BK = 64, HALF = 128, HTB = HALF * BK * 2  , STAGE_BYTES = 8 * HTB, NXCD = 8, WGM = 8;

__host__ __device__ __forceinline__ int lds_byte(int r, int c) { const int st = (r >> 4) * 2 + (c >> 5), rr = r & 15, cc = c & 31, ob = rr * 64 + cc * 2; return st * 1024 + (ob ^ (((ob >> 9) & 1) << 5)); }
__host__ __device__ __forceinline__ void stage_rc(int b, int& R, int& C) { const int st = b / 1024, sb = b % 1024, swz = sb ^ (((sb >> 9) & 1) << 5); R = (st >> 1) * 16 + swz / 64; C = (st & 1) * 32 + (swz % 64) / 2; }
__host__ __device__ __forceinline__ int perm32(int rho) { const int n = rho >> 4, i = rho & 15; return 8 * (i >> 2) + 4 * n + (i & 3); }

struct Unit { int pm, pn; };
struct Gemm { const bf16_t* A; const bf16_t* Bt; int M, N, K; };

struct StaticOrder {
    int nM, nN, nwg, G, c;
    __host__ __device__ void init(int M, int N, int G_, int c_) { nM = M / BM; nN = N / BM; nwg = nM * nN; G = G_; c = c_; }
    __host__ __device__ void init_tiles(int nM_, int nN_, int G_, int c_) { nM = nM_; nN = nN_; nwg = nM * nN; G = G_; c = c_; }
    __host__ __device__ bool next(int i, Unit& u) const {
        const long L = (long)i * G + c; if (L >= nwg) return false;
        int wgid = (int)L; { const int q = nwg / NXCD, r = nwg % NXCD, xcd = wgid % NXCD, off = wgid / NXCD; wgid = (xcd < r ? xcd * (q + 1) : r * (q + 1) + (xcd - r) * q) + off; }
        const int nig = WGM * nN, gid = wgid / nig, fm = gid * WGM, gsz = (nM - fm) < WGM ? (nM - fm) : WGM;
        u.pm = fm + ((wgid % nig) % gsz); u.pn = (wgid % nig) / gsz; return true;
    }
    __device__ __forceinline__ void a_ready(const Unit&) const {}
    __device__ __forceinline__ void done(const Unit&) const {}
};
__device__ __forceinline__ unsigned cvt_pk_bf16(float lo, float hi) { unsigned r; asm volatile("v_cvt_pk_bf16_f32 %0, %1, %2" : "=v"(r) : "v"(lo), "v"(hi)); return r; }
typedef float f32x2 __attribute__((ext_vector_type(2)));
__device__ __forceinline__ f32x2 gelu_pk(f32x2 v) {
    const f32x2 av = __builtin_elementwise_abs(v), d = av * 0.2316418882f + 1.0f;
    f32x2 t; t.x = __builtin_amdgcn_rcpf(d.x); t.y = __builtin_amdgcn_rcpf(d.y);
    f32x2 q = t * 0.5307027145f + (-0.7265760135f); q = q * t + 0.7107068705f; q = q * t + (-0.142248368f); q = q * t + 0.127414796f; q = q * t;
    const f32x2 s = (v * v) * (-0.72134752044f);
    f32x2 e; e.x = __builtin_amdgcn_exp2f(s.x); e.y = __builtin_amdgcn_exp2f(s.y);
    const f32x2 m = v * (q * e), r = v - m;
    f32x2 o; o.x = v.x < 0.f ? m.x : r.x; o.y = v.y < 0.f ? m.y : r.y; return o;
}

template <int ACT  > struct EpiBf16 {
    static constexpr bool PERM = true, AFTER_DRAIN = false, ACC_INIT = false; static_assert(ACT == 0 || ACT == 1, "EpiBf16: ACT is 0 (none) or 1 (gelu_pk)");
    static __host__ __device__ __forceinline__ int a_row0(int pm) { return pm * BM; }
    static __host__ __device__ __forceinline__ int b_row0(int pn) { return pn * BM; }
    bf16_t* O; int ldc; const float* bias; int split_cols; size_t split_stride; float scale0;
    __device__ __forceinline__ void operator()(const f32x4 (&acc)[2][2][4][2], const Unit& u, int wr, int wc, int fr, int fq, int ui) const {
        const int row0 = u.pm * BM + wr * 64 + fr; int colt = u.pn * BM; bf16_t* base = O;
        float sc = 1.f; if (split_cols) { const int t = colt / split_cols; base += (size_t)t * split_stride; colt -= t * split_cols; if (t == 0) sc = scale0; }
        const int col0 = colt + wc * 32 + 8 * fq, bcol0 = u.pn * BM + wc * 32 + 8 * fq;
        f32x4 bv[2][2];
#pragma unroll
        for (int bj = 0; bj < 2; ++bj)
#pragma unroll
            for (int n = 0; n < 2; ++n) bv[bj][n] = bias ? *(const f32x4*)(bias + bcol0 + bj * HALF + 4 * n) : (f32x4){0.f, 0.f, 0.f, 0.f};
#pragma unroll
        for (int ai = 0; ai < 2; ++ai)
#pragma unroll
            for (int m = 0; m < 4; ++m) { bf16_t* rowp = base + (size_t)(row0 + ai * HALF + m * 16) * ldc + col0;
#pragma unroll
                for (int bj = 0; bj < 2; ++bj) { f32x4 v0 = acc[ai][bj][m][0] + bv[bj][0], v1 = acc[ai][bj][m][1] + bv[bj][1];
                    if (ACT == 1) { f32x2 a = gelu_pk((f32x2){v0[0], v0[1]}), b = gelu_pk((f32x2){v0[2], v0[3]}), c = gelu_pk((f32x2){v1[0], v1[1]}), d = gelu_pk((f32x2){v1[2], v1[3]});
                        v0 = (f32x4){a.x, a.y, b.x, b.y}; v1 = (f32x4){c.x, c.y, d.x, d.y}; }
                    v0 = v0 * sc; v1 = v1 * sc; u32x4 w; w.x = cvt_pk_bf16(v0[0], v0[1]); w.y = cvt_pk_bf16(v0[2], v0[3]); w.z = cvt_pk_bf16(v1[0], v1[1]); w.w = cvt_pk_bf16(v1[2], v1[3]);
                    *(u32x4*)(rowp + bj * HALF) = w; } }
    }
};
template <bool RB_IN, bool RB_OUT, bool WITH_SSQ> struct EpiRes {
    static constexpr bool PERM = true, AFTER_DRAIN = false, ACC_INIT = true;
    static __host__ __device__ __forceinline__ int a_row0(int pm) { return pm * BM; }
    static __host__ __device__ __forceinline__ int b_row0(int pn) { return pn * BM; }
    const void* base; void* out; int ldc; float* ssq;
    static __device__ __forceinline__ f32x4 up2(unsigned lo, unsigned hi) { return (f32x4){__builtin_bit_cast(float, lo << 16), __builtin_bit_cast(float, lo & 0xffff0000u), __builtin_bit_cast(float, hi << 16), __builtin_bit_cast(float, hi & 0xffff0000u)}; }
    __device__ __forceinline__ void init(f32x4 (&acc)[2][2][4][2], const Unit& u, int wr, int wc, int fr, int fq) const {
        const int row0 = u.pm * BM + wr * 64 + fr, col0 = u.pn * BM + wc * 32 + 8 * fq;
#pragma unroll
        for (int ai = 0; ai < 2; ++ai)
#pragma unroll
            for (int m = 0; m < 4; ++m) { const size_t ro = (size_t)(row0 + ai * HALF + m * 16) * ldc + col0;
#pragma unroll
                for (int bj = 0; bj < 2; ++bj) { const size_t o = ro + bj * HALF;
                    if constexpr (RB_IN) { const u32x4 w = *(const u32x4*)((const bf16_t*)base + o); acc[ai][bj][m][0] = up2(w.x, w.y); acc[ai][bj][m][1] = up2(w.z, w.w); }
                    else { acc[ai][bj][m][0] = *(const f32x4*)((const float*)base + o); acc[ai][bj][m][1] = *(const f32x4*)((const float*)base + o + 4); } } }
    }
    __device__ __forceinline__ void operator()(const f32x4 (&acc)[2][2][4][2], const Unit& u, int wr, int wc, int fr, int fq, int ui) const {
        const int row0 = u.pm * BM + wr * 64 + fr, col0 = u.pn * BM + wc * 32 + 8 * fq;
#pragma unroll
        for (int ai = 0; ai < 2; ++ai)
#pragma unroll
            for (int m = 0; m < 4; ++m) { const size_t ro = (size_t)(row0 + ai * HALF + m * 16) * ldc + col0; float q = 0.f;
#pragma unroll
                for (int bj = 0; bj < 2; ++bj) { const size_t o = ro + bj * HALF; const f32x4 v0 = acc[ai][bj][m][0], v1 = acc[ai][bj][m][1];
                    if constexpr (RB_OUT) { u32x4 w; w.x = cvt_pk_bf16(v0[0], v0[1]); w.y = cvt_pk_bf16(v0[2], v0[3]); w.z = cvt_pk_bf16(v1[0], v1[1]); w.w = cvt_pk_bf16(v1[2], v1[3]); *(u32x4*)((bf16_t*)out + o) = w; }
                    else { *(f32x4*)((float*)out + o) = v0; *(f32x4*)((float*)out + o + 4) = v1; }
                    if constexpr (WITH_SSQ) q += ((v0[0] * v0[0] + v0[1] * v0[1]) + (v0[2] * v0[2] + v0[3] * v0[3])) + ((v1[0] * v1[0] + v1[1] * v1[1]) + (v1[2] * v1[2] + v1[3] * v1[3])); }
                if constexpr (WITH_SSQ) { q += __shfl_xor(q, 16); q += __shfl_xor(q, 32); if (fq == 0) ssq[(size_t)(row0 + ai * HALF + m * 16) * 32 + 4 * u.pn + wc] = q; } }
    }
};
struct EpiQKV {
    static constexpr bool PERM = true, AFTER_DRAIN = false, ACC_INIT = false;
    static __host__ __device__ __forceinline__ int a_row0(int pm) { return pm * BM; }
    static __host__ __device__ __forceinline__ int b_row0(int pn) { return pn * BM; }
    bf16_t* O; int ldc; const float* qg; const float* kg; PG8_LAS float* part; float qscale;
    __device__ __forceinline__ void operator()(const f32x4 (&acc)[2][2][4][2], const Unit& u, int wr, int wc, int fr, int fq, int ui) const {
        const int kind = u.pn >> 3;
        const int row0 = u.pm * BM + wr * 64 + fr, col0 = u.pn * BM + wc * 32 + 8 * fq;
        if (kind < 2) {
#pragma unroll
            for (int ai = 0; ai < 2; ++ai)
#pragma unroll
                for (int m = 0; m < 4; ++m)
#pragma unroll
                    for (int bj = 0; bj < 2; ++bj) { const f32x4 a = acc[ai][bj][m][0], b = acc[ai][bj][m][1];
                        float q = ((a[0] * a[0] + a[1] * a[1]) + (a[2] * a[2] + a[3] * a[3])) + ((b[0] * b[0] + b[1] * b[1]) + (b[2] * b[2] + b[3] * b[3]));
                        q += __shfl_xor(q, 16); q += __shfl_xor(q, 32);
                        if (fq == 0) part[((ai * HALF + wr * 64 + m * 16 + fr) * 2 + bj) * 4 + wc] = q; }
        }
        asm volatile("s_waitcnt lgkmcnt(0)" ::: "memory"); __builtin_amdgcn_s_barrier(); asm volatile("" ::: "memory");
        f32x4 g0 = (f32x4){1.f, 1.f, 1.f, 1.f}, g1 = g0;
        if (kind < 2) { const float* gp = (kind == 0 ? qg : kg) + wc * 32 + 8 * fq; g0 = *(const f32x4*)gp; g1 = *(const f32x4*)(gp + 4); }
        const float sc = (kind == 0) ? qscale : 1.f;
#pragma unroll
        for (int ai = 0; ai < 2; ++ai)
#pragma unroll
            for (int m = 0; m < 4; ++m) { bf16_t* rowp = O + (size_t)(row0 + ai * HALF + m * 16) * ldc + col0;
#pragma unroll
                for (int bj = 0; bj < 2; ++bj) { float rs = 1.f;
                    if (kind < 2) { const f32x4 pp = *(const PG8_LAS f32x4*)(part + ((ai * HALF + wr * 64 + m * 16 + fr) * 2 + bj) * 4); rs = sc * __builtin_amdgcn_rsqf(((pp[0] + pp[1]) + (pp[2] + pp[3])) * (1.f / 128.f) + 1e-6f); }
                    const f32x4 v0 = acc[ai][bj][m][0] * g0 * rs, v1 = acc[ai][bj][m][1] * g1 * rs;
                    u32x4 w; w.x = cvt_pk_bf16(v0[0], v0[1]); w.y = cvt_pk_bf16(v0[2], v0[3]); w.z = cvt_pk_bf16(v1[0], v1[1]); w.w = cvt_pk_bf16(v1[2], v1[3]);
                    *(u32x4*)(rowp + bj * HALF) = w; } }
    }
};
__device__ __forceinline__ float dpp_ror1(float v) { return __builtin_bit_cast(float, __builtin_amdgcn_mov_dpp(__builtin_bit_cast(int, v), 0x121, 0xf, 0xf, true)); }
__device__ __forceinline__ float dpp_ror2(float v) { return __builtin_bit_cast(float, __builtin_amdgcn_mov_dpp(__builtin_bit_cast(int, v), 0x122, 0xf, 0xf, true)); }
struct EpiConvGate {
    static constexpr bool PERM = true, AFTER_DRAIN = false, ACC_INIT = false;
    static constexpr int TPS = 17, TSTRIDE = 241, SEQL = 4096, FF = 5632;
    static __host__ __device__ __forceinline__ int a_row0(int pm) { return (pm / TPS) * SEQL + (pm % TPS) * TSTRIDE - 2; }
    static __host__ __device__ __forceinline__ int b_row0(int pn) { return pn * BM; }
    bf16_t* G; const float* cw; const float* cb; PG8_LAS float* tails; const float* ssq;
    __device__ __forceinline__ void operator()(const f32x4 (&acc)[2][2][4][2], const Unit& u, int wr, int wc, int fr, int fq, int ui) const {
        const int wid = wr * 4 + wc, seq = u.pm / TPS, tbase = (u.pm % TPS) * TSTRIDE - 2;
        const int ch0 = 128 * u.pn + 32 * wc + 8 * fq;
        if (fr >= 14) {
#pragma unroll
            for (int ai = 0; ai < 2; ++ai)
#pragma unroll
                for (int bj = 0; bj < 2; ++bj)
#pragma unroll
                    for (int n = 0; n < 2; ++n) *(PG8_LAS f32x4*)(tails + (((wid * 2 + ai) * 2 + (fr - 14)) * 2 + bj) * 32 + fq * 8 + n * 4) = acc[ai][bj][3][n];
        }
        const PG8_LAS float* rsl = tails + 2048 + 256 * ui;
        PG8_LAS float* coef = tails + 2048 + 12 * 256;
        { const int tid_ = threadIdx.x; if (tid_ < 256) { const int a_ = tid_ >> 5, c_ = tid_ & 31;
            const float* src = (a_ < 6 ? cw + (a_ >> 1) * 2 * FF : cb) + (a_ & 1) * FF + 128 * u.pn + 4 * c_;
            *(PG8_LAS f32x4*)(coef + a_ * 128 + 4 * c_) = *(const f32x4*)src; } }
        asm volatile("s_waitcnt lgkmcnt(0)" ::: "memory"); __builtin_amdgcn_s_barrier(); asm volatile("" ::: "memory");
        const bool is15 = (fr == 15), ge14 = (fr >= 14);
#pragma unroll
        for (int ai = 0; ai < 2; ++ai) {
            const bool has_src = !(ai == 0 && wr == 0);
            const int swid = (wr ^ 1) * 4 + wc, sai = (wr == 1) ? ai : ai - 1;
#pragma unroll
            for (int n = 0; n < 2; ++n) {
                f32x4 gv[4];
#pragma unroll
                for (int bj = 0; bj < 2; ++bj) {
                    const PG8_LAS float* cfp = coef + bj * 128 + 32 * wc + 8 * fq + 4 * n;
                    const f32x4 w0 = *(const PG8_LAS f32x4*)cfp, w1 = *(const PG8_LAS f32x4*)(cfp + 256), w2 = *(const PG8_LAS f32x4*)(cfp + 512), bb = *(const PG8_LAS f32x4*)(cfp + 768);
                    f32x4 prev = (f32x4){0.f, 0.f, 0.f, 0.f};
                    if (ge14 && has_src) { prev = *(const PG8_LAS f32x4*)(tails + (((swid * 2 + sai) * 2 + (fr - 14)) * 2 + bj) * 32 + fq * 8 + n * 4);
                        if (ssq) prev = prev * rsl[128 * ai + 64 * wr - 16 + fr]; }
#pragma unroll
                    for (int m = 0; m < 4; ++m) {
                        f32x4 cur = acc[ai][bj][m][n]; if (ssq) cur = cur * rsl[128 * ai + 64 * wr + 16 * m + fr];
                        const int t = tbase + 128 * ai + 64 * wr + 16 * m + fr;
                        f32x4 cv;
#pragma unroll
                        for (int e = 0; e < 4; ++e) {
                            float p1 = dpp_ror1(is15 ? prev[e] : cur[e]), p2 = dpp_ror2(ge14 ? prev[e] : cur[e]);
                            if (ai == 0 && m == 0) { p1 = (t >= 1) ? p1 : 0.f; p2 = (t >= 2) ? p2 : 0.f; }
                            cv[e] = bb[e] + w0[e] * p2 + w1[e] * p1 + w2[e] * cur[e]; }
                        if (bj == 0) {
#pragma unroll
                            for (int e = 0; e < 4; ++e) gv[m][e] = cv[e] * __builtin_amdgcn_rcpf(1.f + __expf(-cv[e]));
                        } else { const f32x4 o = gv[m] * cv; const int rl = 128 * ai + 64 * wr + 16 * m + fr;
                            if (rl >= 2 && rl < 2 + TSTRIDE && t < SEQL) { typedef unsigned u32x2 __attribute__((ext_vector_type(2))); u32x2 w; w.x = cvt_pk_bf16(o[0], o[1]); w.y = cvt_pk_bf16(o[2], o[3]);
                                *(u32x2*)(G + (size_t)(seq * SEQL + t) * FF + ch0 + 4 * n) = w; } }
                        prev = cur;
                    }
                }
            }
        }
    }
};
struct EpiConvGateT {
    static constexpr bool PERM = true, AFTER_DRAIN = false, ACC_INIT = false;
    static constexpr int TPS = 17, TSTRIDE = 241, SEQL = 4096, FF = 5632;
    static __host__ __device__ __forceinline__ int a_row0(int pm) { return pm * BM; }
    static __host__ __device__ __forceinline__ int b_row0(int pn) { return (pn / TPS) * SEQL + (pn % TPS) * TSTRIDE - 2; }
    bf16_t* G; const float* cw; const float* cb; PG8_LAS float* xl;
    __device__ __forceinline__ void operator()(f32x4 (&acc)[2][2][4][2], const Unit& u, int wr, int wc, int fr, int fq, int ui) const {
        const int wid = wr * 4 + wc, lane = fq * 16 + fr, seq = u.pn / TPS, tbase = (u.pn % TPS) * TSTRIDE - 2;
        PG8_LAS unsigned* tails = (PG8_LAS unsigned*)xl; PG8_LAS unsigned short* ob = (PG8_LAS unsigned short*)(xl + 2048) + wid * 512; PG8_LAS float* coef = xl + 4096; const PG8_LAS float* rsl = xl + 5120 + 256 * ui;
#pragma unroll
        for (int bj = 0; bj < 2; ++bj) { const f32x4 r0 = *(const PG8_LAS f32x4*)(rsl + 128 * bj + 32 * wc + 8 * fq), r1 = *(const PG8_LAS f32x4*)(rsl + 128 * bj + 32 * wc + 8 * fq + 4);
#pragma unroll
            for (int ai = 0; ai < 2; ++ai)
#pragma unroll
                for (int m = 0; m < 4; ++m) { acc[ai][bj][m][0] = acc[ai][bj][m][0] * r0; acc[ai][bj][m][1] = acc[ai][bj][m][1] * r1; } }
        if (fq == 3) {
#pragma unroll
            for (int bj = 0; bj < 2; ++bj)
#pragma unroll
                for (int ai = 0; ai < 2; ++ai)
#pragma unroll
                    for (int m = 0; m < 4; ++m) tails[((wid * 2 + bj) * 8 + ai * 4 + m) * 16 + fr] = cvt_pk_bf16(acc[ai][bj][m][1][2], acc[ai][bj][m][1][3]);
        }
        { const int tid_ = threadIdx.x; if (tid_ < 256) { const int a_ = tid_ >> 5, c_ = tid_ & 31, up_ = a_ >> 2, j_ = a_ & 3;
            const float* src = (j_ < 3 ? cw + j_ * 2 * FF : cb) + up_ * FF + 128 * u.pm + 4 * c_;
            *(PG8_LAS f32x4*)(coef + a_ * 128 + 4 * c_) = *(const f32x4*)src; } }
        asm volatile("s_waitcnt lgkmcnt(0)" ::: "memory"); __builtin_amdgcn_s_barrier(); asm volatile("" ::: "memory");
#pragma unroll
        for (int bj = 0; bj < 2; ++bj) {
            const bool has_src = (wc > 0) || (bj == 1);
            const int swid = (wc > 0) ? wid - 1 : wr * 4 + 3, sbj = (wc > 0) ? bj : 0;
            const bool firstgrp = (tbase < 0) && (bj == 0) && (wc == 0) && (fq == 0);
#pragma unroll
            for (int mp = 0; mp < 2; ++mp) {
                unsigned pk[2][2][2];
#pragma unroll
                for (int mq = 0; mq < 2; ++mq) { const int m = 2 * mp + mq;
                    float cv[2][8];
#pragma unroll
                    for (int ai = 0; ai < 2; ++ai) {
                        float sq[8];
#pragma unroll
                        for (int j = 0; j < 8; ++j) sq[j] = acc[ai][bj][m][j >> 2][j & 3];
                        float p6 = __shfl_up(sq[6], 16), p7 = __shfl_up(sq[7], 16);
                        if (fq == 0) { unsigned tv = 0u; if (has_src) tv = tails[((swid * 2 + sbj) * 8 + ai * 4 + m) * 16 + fr];
                            p6 = __builtin_bit_cast(float, tv << 16); p7 = __builtin_bit_cast(float, tv & 0xffff0000u); }
                        if (firstgrp) { sq[0] = 0.f; sq[1] = 0.f; }
                        const PG8_LAS float* cf = coef + ai * 512 + 64 * wr + 16 * m + fr; const float w0 = cf[0], w1 = cf[128], w2 = cf[256], bb = cf[384];
                        cv[ai][0] = bb + w0 * p6 + w1 * p7 + w2 * sq[0];
                        cv[ai][1] = bb + w0 * p7 + w1 * sq[0] + w2 * sq[1];
#pragma unroll
                        for (int j = 2; j < 8; ++j) cv[ai][j] = bb + w0 * sq[j - 2] + w1 * sq[j - 1] + w2 * sq[j];
                    }
                    float o[8];
#pragma unroll
                    for (int j = 0; j < 8; ++j) o[j] = cv[0][j] * __builtin_amdgcn_rcpf(1.f + __expf(-cv[0][j])) * cv[1][j];
#pragma unroll
                    for (int n = 0; n < 2; ++n) { pk[mq][n][0] = cvt_pk_bf16(o[4 * n], o[4 * n + 1]); pk[mq][n][1] = cvt_pk_bf16(o[4 * n + 2], o[4 * n + 3]); }
                }
#pragma unroll
                for (int n = 0; n < 2; ++n) {
#pragma unroll
                    for (int mq = 0; mq < 2; ++mq) {
                        ob[(4 * fq + 0) * 32 + 16 * mq + fr] = (unsigned short)(pk[mq][n][0] & 0xffffu); ob[(4 * fq + 1) * 32 + 16 * mq + fr] = (unsigned short)(pk[mq][n][0] >> 16);
                        ob[(4 * fq + 2) * 32 + 16 * mq + fr] = (unsigned short)(pk[mq][n][1] & 0xffffu); ob[(4 * fq + 3) * 32 + 16 * mq + fr] = (unsigned short)(pk[mq][n][1] >> 16); }
                    asm volatile("s_waitcnt lgkmcnt(0)" ::: "memory");
                    { const int trow = lane >> 2, chunk = lane & 3; const u32x4 v = *(const PG8_LAS u32x4*)(ob + trow * 32 + chunk * 8);
                      const int tl = 128 * bj + 32 * wc + 8 * (trow >> 2) + 4 * n + (trow & 3), t = tbase + tl;
                      asm volatile("s_waitcnt lgkmcnt(0)" ::: "memory");
                      if (tl >= 2 && tl < 2 + TSTRIDE && t < SEQL) *(u32x4*)(G + (size_t)(seq * SEQL + t) * FF + 128 * u.pm + 64 * wr + 32 * mp + 8 * chunk) = v; }
                }
            }
        }
    }
};
template <class Epi, class Sched, bool ALIGN_EPI = false, bool SP2 = false>
__device__ __forceinline__ void gemm_phase(PG8_LAS unsigned char* lds, const Gemm g, const Sched& S, const Epi& E) {
    const int tid = threadIdx.x, wid = __builtin_amdgcn_readfirstlane(tid >> 6), lane = tid & 63, wr = wid >> 2, wc = wid & 3, fr = lane & 15, fq = lane >> 4;
    const int K = g.K, nt = K / BK;
    unsigned voffA[2], voffB[2];
#pragma unroll
    for (int i = 0; i < 2; ++i) { int R, C; stage_rc(tid * 16 + i * 8192, R, C); const int Rb = Epi::PERM ? ((R & ~31) + perm32(R & 31)) : R;
        voffA[i] = (unsigned)(R * K + C) * 2u; voffB[i] = (unsigned)(Rb * K + C) * 2u; }
    const size_t kstep = (size_t)(BK * 2);
    const size_t hstep = (size_t)HALF * K * 2;
    const size_t tstep = 2 * hstep;
    const unsigned ldsw = (unsigned)wid * 1024u;
    const int aoff = lds_byte(wr * 64 + fr, fq * 8), boff = lds_byte(wc * 32 + fr, fq * 8);
#define PG8_SA(b, h) (((b) * 2 + (h)) * HTB)
#define PG8_SB(b, h) ((4 + (b) * 2 + (h)) * HTB)
#define PG8_STAGE(bufoff, gbase, voff) do { _Pragma("unroll") for (int _i = 0; _i < 2; ++_i) \
        __builtin_amdgcn_global_load_lds((const unsigned*)((const char*)(gbase) + (voff)[_i]), (PG8_LAS unsigned*)(lds + (bufoff) + ldsw + _i * 8192), 16, 0, 0); } while (0)
#define PG8_LDA(dst, b, h) do { _Pragma("unroll") for (int m = 0; m < 4; ++m) _Pragma("unroll") for (int k = 0; k < 2; ++k) dst[m][k] = *(const PG8_LAS bf16x8*)(lds + PG8_SA(b, h) + aoff + m * 2048 + k * 1024); } while (0)
#define PG8_LDB(dst, b, h) do { _Pragma("unroll") for (int n = 0; n < 2; ++n) _Pragma("unroll") for (int k = 0; k < 2; ++k) dst[n][k] = *(const PG8_LAS bf16x8*)(lds + PG8_SB(b, h) + boff + n * 2048 + k * 1024); } while (0)
#define PG8_MMA(ai, bj, At, Bt) do { __builtin_amdgcn_s_setprio(1); _Pragma("unroll") for (int m = 0; m < 4; ++m) _Pragma("unroll") for (int n = 0; n < 2; ++n) _Pragma("unroll") for (int k = 0; k < 2; ++k) \
        acc[ai][bj][m][n] = __builtin_amdgcn_mfma_f32_16x16x32_bf16(Bt[n][k], At[m][k], acc[ai][bj][m][n], 0, 0, 0); __builtin_amdgcn_s_setprio(0); } while (0)
#define PG8_WAIT_V(n) asm volatile("s_waitcnt vmcnt(" #n ")" ::: "memory")
#define PG8_WAIT_L(n) asm volatile("s_waitcnt lgkmcnt(" #n ")" ::: "memory")
#define PG8_BAR __builtin_amdgcn_s_barrier()
#define PG8_SCHED __builtin_amdgcn_sched_barrier(0)
    Unit cur, nxt; int ui = 0;
    if (!S.next(0, cur)) return;
    f32x4 acc[2][2][4][2];
    if constexpr (Epi::ACC_INIT) E.init(acc, cur, wr, wc, fr, fq); else {
#pragma unroll
    for (int a = 0; a < 2; ++a)
#pragma unroll
        for (int b = 0; b < 2; ++b)
#pragma unroll
            for (int m = 0; m < 4; ++m)
#pragma unroll
                for (int n = 0; n < 2; ++n) acc[a][b][m][n] = (f32x4){0.f, 0.f, 0.f, 0.f}; }
    bf16x8 At[4][2], B0[2][2], B1[2][2];
    const char* cA = (const char*)g.A + (long)Epi::a_row0(cur.pm) * (long)(K * 2); const char* cB = (const char*)g.Bt + (long)Epi::b_row0(cur.pn) * (long)(K * 2);
    S.a_ready(cur);
    if constexpr (SP2) {
        PG8_STAGE(PG8_SB(0, 0), cB, voffB); PG8_STAGE(PG8_SB(0, 1), cB + hstep, voffB); PG8_STAGE(PG8_SA(0, 0), cA, voffA); PG8_STAGE(PG8_SA(0, 1), cA + hstep, voffA);
        if (wr == 1) PG8_BAR;
        PG8_WAIT_V(2); PG8_BAR;
        PG8_STAGE(PG8_SB(1, 0), cB + kstep, voffB); PG8_STAGE(PG8_SA(1, 0), cA + kstep, voffA); PG8_STAGE(PG8_SB(1, 1), cB + hstep + kstep, voffB);
        PG8_WAIT_V(6); PG8_BAR;
    } else {
        PG8_STAGE(PG8_SB(0, 0), cB, voffB); PG8_STAGE(PG8_SA(0, 0), cA, voffA); PG8_STAGE(PG8_SB(0, 1), cB + hstep, voffB); PG8_STAGE(PG8_SA(0, 1), cA + hstep, voffA);
        if (wr == 1) PG8_BAR;
        PG8_WAIT_V(4); PG8_BAR;
        PG8_STAGE(PG8_SB(1, 0), cB + kstep, voffB); PG8_STAGE(PG8_SA(1, 0), cA + kstep, voffA); PG8_STAGE(PG8_SB(1, 1), cB + hstep + kstep, voffB);
        PG8_WAIT_V(6); PG8_BAR;
    }
    for (;;) {
        const bool has_next = S.next(ui + 1, nxt);
        const char* nA = has_next ? (const char*)g.A + (long)Epi::a_row0(nxt.pm) * (long)(K * 2) : cA; const char* nB = has_next ? (const char*)g.Bt + (long)Epi::b_row0(nxt.pn) * (long)(K * 2) : cB;
        for (int t = 0; t < nt; t += 2) {
            const bool last = (t == nt - 2);
            const char* a1 = cA + (size_t)(t + 1) * kstep;
            const char* a2 = last ? nA : cA + (size_t)(t + 2) * kstep; const char* b2 = last ? nB : cB + (size_t)(t + 2) * kstep;
            const char* a3 = a2 + kstep; const char* b3 = b2 + kstep;
            if (last && has_next) S.a_ready(nxt);
            if constexpr (SP2) {
            PG8_LDB(B0, 0, 0); PG8_LDB(B1, 0, 1); PG8_SCHED; PG8_LDA(At, 0, 0); PG8_STAGE(PG8_SA(1, 1), a1 + hstep, voffA);
            PG8_WAIT_V(8); PG8_WAIT_L(0); PG8_BAR; PG8_MMA(0, 0, At, B0); PG8_MMA(0, 1, At, B1); PG8_BAR; PG8_SCHED;
            PG8_LDA(At, 0, 1); PG8_STAGE(PG8_SB(0, 0), b2, voffB); PG8_STAGE(PG8_SB(0, 1), b2 + hstep, voffB); PG8_STAGE(PG8_SA(0, 0), a2, voffA);
            PG8_WAIT_V(8); PG8_WAIT_L(0); PG8_BAR; PG8_MMA(1, 0, At, B0); PG8_MMA(1, 1, At, B1); PG8_BAR; PG8_SCHED;
            PG8_LDB(B0, 1, 0); PG8_LDB(B1, 1, 1); PG8_SCHED; PG8_LDA(At, 1, 0); PG8_STAGE(PG8_SA(0, 1), a2 + hstep, voffA);
            PG8_WAIT_V(8); PG8_WAIT_L(0); PG8_BAR; PG8_MMA(0, 0, At, B0); PG8_MMA(0, 1, At, B1); PG8_BAR; PG8_SCHED;
            PG8_LDA(At, 1, 1); PG8_STAGE(PG8_SB(1, 0), b3, voffB); PG8_STAGE(PG8_SB(1, 1), b3 + hstep, voffB); PG8_STAGE(PG8_SA(1, 0), a3, voffA);
            PG8_WAIT_V(8); PG8_WAIT_L(0); PG8_BAR; PG8_MMA(1, 0, At, B0); PG8_MMA(1, 1, At, B1); PG8_BAR; PG8_SCHED;
            } else {
            PG8_LDB(B0, 0, 0); PG8_SCHED; PG8_LDA(At, 0, 0); PG8_STAGE(PG8_SA(1, 1), a1 + hstep, voffA);
            PG8_WAIT_L(8); PG8_BAR; PG8_WAIT_L(0); PG8_MMA(0, 0, At, B0); PG8_BAR; PG8_SCHED;
            PG8_LDB(B1, 0, 1); PG8_STAGE(PG8_SB(0, 0), b2, voffB);
            PG8_BAR; PG8_WAIT_L(0); PG8_MMA(0, 1, At, B1); PG8_BAR;
            PG8_LDA(At, 0, 1); PG8_STAGE(PG8_SA(0, 0), a2, voffA);
            PG8_BAR; PG8_WAIT_L(0); PG8_MMA(1, 0, At, B0); PG8_BAR; PG8_SCHED;
            PG8_STAGE(PG8_SB(0, 1), b2 + hstep, voffB);
            PG8_WAIT_V(6); PG8_BAR; PG8_MMA(1, 1, At, B1); PG8_BAR;
            PG8_LDB(B0, 1, 0); PG8_SCHED; PG8_LDA(At, 1, 0); PG8_STAGE(PG8_SA(0, 1), a2 + hstep, voffA);
            PG8_WAIT_L(8); PG8_BAR; PG8_WAIT_L(0); PG8_MMA(0, 0, At, B0); PG8_BAR; PG8_SCHED;
            PG8_LDB(B1, 1, 1); PG8_STAGE(PG8_SB(1, 0), b3, voffB);
            PG8_BAR; PG8_WAIT_L(0); PG8_MMA(0, 1, At, B1); PG8_BAR;
            PG8_LDA(At, 1, 1); PG8_STAGE(PG8_SA(1, 0), a3, voffA);
            PG8_BAR; PG8_WAIT_L(0); PG8_MMA(1, 0, At, B0); PG8_BAR; PG8_SCHED;
            PG8_STAGE(PG8_SB(1, 1), b3 + hstep, voffB);
            PG8_WAIT_V(6); PG8_BAR; PG8_MMA(1, 1, At, B1); PG8_BAR;
            }
        }
        if constexpr (ALIGN_EPI) { if (wr == 0) PG8_BAR; }
        if constexpr (!Epi::AFTER_DRAIN) { E(acc, cur, wr, wc, fr, fq, ui); S.done(cur); }
        if (!has_next) break;
        if constexpr (Epi::ACC_INIT) E.init(acc, nxt, wr, wc, fr, fq); else {
#pragma unroll
        for (int a = 0; a < 2; ++a)
#pragma unroll
            for (int b = 0; b < 2; ++b)
#pragma unroll
                for (int m = 0; m < 4; ++m)
#pragma unroll
                    for (int n = 0; n < 2; ++n) acc[a][b][m][n] = (f32x4){0.f, 0.f, 0.f, 0.f}; }
        cur = nxt; cA = nA; cB = nB; ++ui;
        if constexpr (ALIGN_EPI) { if (wr == 1) PG8_BAR; }
    }
    PG8_WAIT_V(0);
    if constexpr (!ALIGN_EPI) { if (wr == 0) PG8_BAR; }
    PG8_BAR;
    if constexpr (Epi::AFTER_DRAIN) { E.fused(acc, cur, wr, wc, fr, fq, lds, wid, lane); S.done(cur); }
#undef PG8_SA
#undef PG8_SB
#undef PG8_STAGE
#undef PG8_LDA
#undef PG8_LDB
#undef PG8_MMA
#undef PG8_WAIT_V
#undef PG8_WAIT_L
#undef PG8_BAR
#undef PG8_SCHED
}
}

constexpr int BATCH = 2, SEQ = 4096, DM = 2048, MROWS = BATCH * SEQ;
constexpr int AH = 16, AHD = 128, NQKV = 3 * DM;
constexpr int LH = 4, LDV = 512, LDK = 256, QKW = 1024, INW = 6152, INW_MAIN = 6144;
constexpr int FFN = 5632, FFN2 = 2 * FFN;
constexpr float NORM_EPS = 1e-6f;

typedef unsigned short bf16;
typedef unsigned v4u __attribute__((ext_vector_type(4)));
typedef unsigned v2u __attribute__((ext_vector_type(2)));
typedef float f32x4 __attribute__((ext_vector_type(4)));
typedef float f32x2 __attribute__((ext_vector_type(2)));
#define LAS __attribute__((address_space(3)))

__device__ __forceinline__ unsigned f2bf(float f) { unsigned u = __builtin_bit_cast(unsigned, f); return (u + 0x7fffu + ((u >> 16) & 1u)) >> 16; }
__device__ __forceinline__ unsigned pk2(float lo, float hi) { unsigned r; asm("v_cvt_pk_bf16_f32 %0, %1, %2" : "=v"(r) : "v"(lo), "v"(hi)); return r; }
template <int N> __device__ __forceinline__ float dpp_ror(float v) { return __builtin_bit_cast(float, __builtin_amdgcn_mov_dpp(__builtin_bit_cast(int, v), 0x120 + N, 0xf, 0xf, true)); }
__device__ __forceinline__ float row16_sum(float v) { v += dpp_ror<1>(v); v += dpp_ror<2>(v); v += dpp_ror<4>(v); v += dpp_ror<8>(v); return v; }
__device__ __forceinline__ float bf2f(unsigned short b) { return __builtin_bit_cast(float, (unsigned)b << 16); }
__device__ __forceinline__ float bflo(unsigned w) { return __builtin_bit_cast(float, w << 16); }
__device__ __forceinline__ float bfhi(unsigned w) { return __builtin_bit_cast(float, w & 0xffff0000u); }
__device__ __forceinline__ float wave_sum(float v) {
#pragma unroll
    for (int o = 1; o < 64; o <<= 1) v += __shfl_xor(v, o);
    return v;
}
__device__ __forceinline__ float sigmoidf_(float x) { return __builtin_amdgcn_rcpf(1.f + __expf(-x)); }
__device__ __forceinline__ float siluf_(float x) { return x * __builtin_amdgcn_rcpf(1.f + __expf(-x)); }

constexpr size_t MiB = 1u << 20;
constexpr size_t WS_CTL = 0;
constexpr size_t WS_WQKV = 1 * MiB;
constexpr size_t WS_WO   = WS_WQKV + (size_t)NQKV * DM * 2;
constexpr size_t WS_WIN  = WS_WO + (size_t)DM * DM * 2;
constexpr size_t WS_WOUT = WS_WIN + (size_t)INW_MAIN * DM * 2;
constexpr size_t WS_WUP  = WS_WOUT + (size_t)DM * DM * 2;
constexpr size_t WS_WDN  = WS_WUP + 2 * (size_t)FFN2 * DM * 2;
constexpr size_t WS_HN   = WS_WDN + 2 * (size_t)DM * FFN * 2;
constexpr size_t WS_G    = WS_HN + (size_t)MROWS * DM * 2;
constexpr size_t WS_R    = WS_G + (size_t)MROWS * FFN * 2;
constexpr size_t WS_QKV  = WS_R;
constexpr size_t WS_O    = WS_QKV + (size_t)MROWS * NQKV * 2;
constexpr size_t WS_QKC  = WS_O + (size_t)MROWS * DM * 2;
constexpr size_t WS_HS   = WS_QKC + (size_t)MROWS * DM * 2;
constexpr size_t WS_U    = WS_R;
constexpr size_t WS_REND = WS_HS + (size_t)MROWS * DM * 4;
static_assert(WS_U + (size_t)MROWS * FFN2 * 2 <= WS_REND, "U overlay");
constexpr size_t WS_GATES = WS_REND;
constexpr size_t WS_SU   = WS_GATES + (size_t)MROWS * 8 * 4;
constexpr size_t WS_SM   = WS_SU + 8 * SEQ * 4;
constexpr size_t WS_SE   = WS_SM + 8 * SEQ * 4;
constexpr size_t WS_NST  = WS_SE + 8 * SEQ * 4;
constexpr size_t WS_CST  = WS_NST + 8 * 64 * 256 * 4;
constexpr size_t WS_SSQ  = WS_CST + (size_t)8 * 64 * 17 * 16384;
constexpr size_t WS_GWT  = WS_SSQ + (size_t)MROWS * 32 * 4;
constexpr size_t WS_XR   = WS_HS;
constexpr size_t WS_END  = WS_GWT + (size_t)DM * 8 * 4;
static_assert(WS_END <= 738000000, "workspace");

__device__ __forceinline__ void transpose_load(const float* W, int ldn, int nblk, int item, int lane, f32x4 (&v)[8]) {
    const int kb = item / nblk, nb = item % nblk, k0 = 64 * kb, n0 = 32 * nb;
#pragma unroll
    for (int i = 0; i < 8; ++i) v[i] = *(const f32x4*)(W + (size_t)(k0 + 8 * i + (lane >> 3)) * ldn + n0 + 4 * (lane & 7));
}
__device__ __forceinline__ void transpose_store(const f32x4 (&v)[8], int K, int nblk, bf16* WT, LAS float* scr, int item, int lane, bool gate_perm, const LAS float* kgain) {
    const int kb = item / nblk, nb = item % nblk, k0 = 64 * kb, n0 = 32 * nb;
    const int r0 = !gate_perm ? n0 : (n0 < FFN ? (n0 / 128) * 256 + (n0 % 128) : ((n0 - FFN) / 128) * 256 + 128 + ((n0 - FFN) % 128));
#pragma unroll
    for (int i = 0; i < 8; ++i) { LAS float* d = scr + (8 * i + (lane >> 3)) * 33 + 4 * (lane & 7); d[0] = v[i][0]; d[1] = v[i][1]; d[2] = v[i][2]; d[3] = v[i][3]; }
    asm volatile("s_waitcnt lgkmcnt(0)" ::: "memory");
    const int c = lane & 7;
    f32x4 ga = (f32x4){1.f, 1.f, 1.f, 1.f}, gb = ga;
    if (kgain) { ga = *(const LAS f32x4*)(kgain + k0 + 8 * c); gb = *(const LAS f32x4*)(kgain + k0 + 8 * c + 4); }
#pragma unroll
    for (int j = 0; j < 4; ++j) { const int n = (lane >> 3) + 8 * j; const LAS float* s = scr + (8 * c) * 33 + n;
        v4u o; o.x = pk2(s[0 * 33] * ga[0], s[1 * 33] * ga[1]); o.y = pk2(s[2 * 33] * ga[2], s[3 * 33] * ga[3]); o.z = pk2(s[4 * 33] * gb[0], s[5 * 33] * gb[1]); o.w = pk2(s[6 * 33] * gb[2], s[7 * 33] * gb[3]);
        *(v4u*)(WT + (size_t)(r0 + n) * K + k0 + 8 * c) = o; }
    asm volatile("s_waitcnt lgkmcnt(0)" ::: "memory");
}

#define XB_TMO      128
#define XB_XCNT(j)  (256  + 64 * (j))
#define XB_XSUB(j)  (1280 + 64 * (j))
#define XB_XGEN(j)  (2304 + 64 * (j))
#define XB_TOP      3328
#define XB_TOPGEN   3392
#define XCD_BAR_WORDS 3456
#define XB_SPIN_CAP (1u << 18)

__device__ __forceinline__ unsigned xb_ld(unsigned* p)              { return __hip_atomic_load(p, __ATOMIC_RELAXED, __HIP_MEMORY_SCOPE_AGENT); }
__device__ __forceinline__ unsigned xb_add(unsigned* p, unsigned v) { return __hip_atomic_fetch_add(p, v, __ATOMIC_RELAXED, __HIP_MEMORY_SCOPE_AGENT); }
__device__ __forceinline__ unsigned xb_xcc_id() { return (unsigned)__builtin_amdgcn_s_getreg((3 << 11) | 20) & 0xFu; }
#define XB_SPIN(cond, bar) do { unsigned _sp = 0; while (cond) { __builtin_amdgcn_s_sleep(1); \
    if ((++_sp & 255u) == 0u) { if (xb_ld(&(bar)[XB_TMO])) break; if (_sp > XB_SPIN_CAP) { atomicAdd(&(bar)[XB_TMO], 1u); break; } } } } while (0)

struct XcdBarrier {
    unsigned* bar; unsigned x;
    volatile LAS unsigned* st;
};

__device__ __forceinline__ XcdBarrier xcd_barrier_post(unsigned* bar, volatile LAS unsigned* st) {
    XcdBarrier b; b.bar = bar; b.x = xb_xcc_id(); b.st = st;
    if (threadIdx.x == 0) (void)xb_add(&bar[XB_XCNT(b.x)], 1u);
    return b;
}
__device__ __forceinline__ void xcd_barrier_complete(unsigned* bar, unsigned x, unsigned& nloc, unsigned& nx) {
    const unsigned G = gridDim.x * gridDim.y * gridDim.z;
    unsigned sum, cnt, mine, sp = 0u;
    for (;;) {
        sum = 0u; cnt = 0u; mine = 0u;
#pragma unroll
        for (unsigned j = 0; j < 16; ++j) { const unsigned c = xb_ld(&bar[XB_XCNT(j)]); sum += c; cnt += (c > 0u) ? 1u : 0u; mine = (j == x) ? c : mine; }
        if (sum == G) break;
        __builtin_amdgcn_s_sleep(1);
        if ((++sp & 255u) == 0u) { if (xb_ld(&bar[XB_TMO])) break; if (sp > XB_SPIN_CAP) { atomicAdd(&bar[XB_TMO], 1u); break; } }
    }
    nloc = mine > 0u ? mine : 1u; nx = cnt > 0u ? cnt : 1u;
}

__device__ __forceinline__ void xcd_barrier(const XcdBarrier& b) {
    asm volatile("s_waitcnt vmcnt(0)" ::: "memory");
    __syncthreads();
    if (threadIdx.x == 0) {
        unsigned* bar = b.bar;
        __builtin_amdgcn_s_waitcnt(0);
        unsigned nloc = b.st[0], nx = b.st[1];
        if (nloc == 0u) { xcd_barrier_complete(bar, b.x, nloc, nx); b.st[0] = nloc; b.st[1] = nx; }
        const unsigned old = xb_add(&bar[XB_XSUB(b.x)], 1u);
        const unsigned gen = old / nloc;
        if (old + 1u == (gen + 1u) * nloc) {
            __builtin_amdgcn_fence(__ATOMIC_RELEASE, "agent");
            asm volatile("s_waitcnt vmcnt(0)" ::: "memory");
            const unsigned og = xb_add(&bar[XB_TOP], 1u);
            const unsigned tg = og / nx;
            if (og + 1u == (tg + 1u) * nx) xb_add(&bar[XB_TOPGEN], 1u);
            else XB_SPIN(xb_ld(&bar[XB_TOPGEN]) == tg, bar);
            __builtin_amdgcn_fence(__ATOMIC_ACQUIRE, "agent");
            xb_add(&bar[XB_XGEN(b.x)], 1u);
            asm volatile("s_waitcnt vmcnt(0)" ::: "memory");
        } else {
            XB_SPIN(xb_ld(&bar[XB_XGEN(b.x)]) == gen, bar);
            __builtin_amdgcn_fence(__ATOMIC_ACQUIRE, "agent");
            asm volatile("s_waitcnt vmcnt(0)" ::: "memory");
        }
    }
    __syncthreads();
}


constexpr int NWAVES = 8, NTHREADS = 512;
constexpr int RING_BYTES = 131072;
constexpr int MISC_OFF = 163840 - 256;
constexpr int LDS_BYTES = 163840;
constexpr int CW_BAR = 4096;
constexpr size_t CTL_ZERO_BYTES = 64 * 1024;

struct Args { const float* in[18]; float* out; unsigned char* ws; int ph_lo, ph_hi; };

struct Frame {
    LAS unsigned char* lds; int tid, lane, wave, vcu, G;
};

__device__ __forceinline__ void p_convert(const Frame& F, const float* W, bf16* WT, int K, int ldn, int N, bool gate_perm = false, int rank = 0, int nranks = 0, const float* kgain = nullptr) {
    LAS float* scr = (LAS float*)(F.lds + F.wave * 16384);
    if (nranks == 0) { nranks = F.G; rank = F.vcu; }
    if (rank < 0 || rank >= nranks) return;
    const int gw = rank * NWAVES + F.wave, NGW = nranks * NWAVES;
    const int nblk = N / 32, items = (K / 64) * nblk;
    const LAS float* kgl = nullptr;
    if (kgain) { LAS float* gl = (LAS float*)(F.lds + NWAVES * 16384); __syncthreads();
        for (int i = F.tid; i < K / 4; i += NTHREADS) *(LAS f32x4*)(gl + 4 * i) = *(const f32x4*)(kgain + 4 * i);
        __syncthreads(); kgl = gl; }
    f32x4 cur[8], nxt[8];
    if (gw < items) transpose_load(W, ldn, nblk, gw, F.lane, nxt);
    for (int it = gw; it < items; it += NGW) {
#pragma unroll
        for (int i = 0; i < 8; ++i) cur[i] = nxt[i];
        if (it + NGW < items) transpose_load(W, ldn, nblk, it + NGW, F.lane, nxt);
        transpose_store(cur, K, nblk, WT, scr, it, F.lane, gate_perm, kgl);
    }
}

__device__ __forceinline__ void p_pack_gates(const Frame& F, const float* w_in, float* gwt) {
    for (int id = F.vcu * NTHREADS + F.tid; id < DM * 2; id += F.G * NTHREADS) { const int k = id >> 1, hf = id & 1; *(f32x4*)(gwt + k * 8 + hf * 4) = *(const f32x4*)(w_in + (size_t)k * INW + INW_MAIN + hf * 4); }
}
template <bool XBF> __device__ __forceinline__ int nrm_idx(int q, int lane) { return XBF ? 2 * (64 * (q >> 1) + lane) + (q & 1) : 64 * q + lane; }
template <bool XBF> __device__ __forceinline__ f32x4 nrm_ld(const void* x, size_t row, int q, int lane) {
    if constexpr (XBF) { const v2u w = ((const v2u*)((const bf16*)x + row * DM))[nrm_idx<XBF>(q, lane)]; return (f32x4){bflo(w.x), bfhi(w.x), bflo(w.y), bfhi(w.y)}; }
    else return ((const f32x4*)((const float*)x + row * DM))[nrm_idx<XBF>(q, lane)];
}
template <bool XBF> __device__ __forceinline__ void p_rmsnorm(const Frame& F, const void* x, const float* g, bf16* hn, const float* w_in, const float* gate_bias, float* gates) {
    const int gw = F.vcu * NWAVES + F.wave, NGW = F.G * NWAVES, lane = F.lane;
    LAS float* gwl = (LAS float*)F.lds;
    if (w_in) { __syncthreads();
#pragma unroll
        for (int i = 0; i < 8; ++i) { const int id = F.tid + NTHREADS * i, k = id >> 1; *(LAS f32x4*)(gwl + (k >> 3) * 68 + (k & 7) * 8 + (id & 1) * 4) = *(const f32x4*)(w_in + id * 4); }
        __syncthreads(); }
    f32x4 gg[8], nx[8];
#pragma unroll
    for (int j = 0; j < 8; ++j) gg[j] = ((const f32x4*)g)[nrm_idx<XBF>(j, lane)];
    if (gw < MROWS) {
#pragma unroll
        for (int j = 0; j < 8; ++j) nx[j] = nrm_ld<XBF>(x, (size_t)gw, j, lane); }
    for (int row = gw; row < MROWS; row += NGW) {
        f32x4 v[8]; float s = 0.f;
#pragma unroll
        for (int j = 0; j < 8; ++j) { v[j] = nx[j]; s += (v[j].x * v[j].x + v[j].y * v[j].y) + (v[j].z * v[j].z + v[j].w * v[j].w); }
        if (row + NGW < MROWS) {
#pragma unroll
            for (int j = 0; j < 8; ++j) nx[j] = nrm_ld<XBF>(x, (size_t)(row + NGW), j, lane); }
        const float rstd = 1.f / sqrtf(wave_sum(s) * (1.f / DM) + NORM_EPS);
#pragma unroll
        for (int j = 0; j < 8; ++j) v[j] = v[j] * rstd * gg[j];
        if constexpr (XBF) { v4u* o16 = (v4u*)(hn + (size_t)row * DM) + lane;
#pragma unroll
            for (int jj = 0; jj < 4; ++jj) { v4u w; w.x = pk2(v[2 * jj].x, v[2 * jj].y); w.y = pk2(v[2 * jj].z, v[2 * jj].w); w.z = pk2(v[2 * jj + 1].x, v[2 * jj + 1].y); w.w = pk2(v[2 * jj + 1].z, v[2 * jj + 1].w); o16[64 * jj] = w; } }
        else {
            const bool odd = lane & 1; bf16* ob_ = hn + (size_t)row * DM;
#pragma unroll
            for (int jj = 0; jj < 4; ++jj) { const unsigned a0 = pk2(v[2 * jj].x, v[2 * jj].y), a1 = pk2(v[2 * jj].z, v[2 * jj].w), b0 = pk2(v[2 * jj + 1].x, v[2 * jj + 1].y), b1 = pk2(v[2 * jj + 1].z, v[2 * jj + 1].w);
                const unsigned s0 = odd ? a0 : b0, s1 = odd ? a1 : b1;
                const unsigned r0 = (unsigned)__builtin_amdgcn_mov_dpp((int)s0, 0xB1, 0xf, 0xf, true), r1 = (unsigned)__builtin_amdgcn_mov_dpp((int)s1, 0xB1, 0xf, 0xf, true);
                v4u w; if (odd) { w.x = r0; w.y = r1; w.z = b0; w.w = b1; } else { w.x = a0; w.y = a1; w.z = r0; w.w = r1; }
                *(v4u*)(ob_ + 4 * (64 * (2 * jj + (odd ? 1 : 0)) + (lane & ~1))) = w; } }
        if (w_in) {
            float acc[8];
#pragma unroll
            for (int q = 0; q < 8; ++q) acc[q] = 0.f;
#pragma unroll
            for (int j = 0; j < 8; ++j) { asm volatile("" ::: "memory");
#pragma unroll
                for (int e = 0; e < 4; ++e) { const int k = 4 * nrm_idx<XBF>(j, lane) + e; const LAS float* wp = gwl + (k >> 3) * 68 + (k & 7) * 8; const f32x4 a = *(const LAS f32x4*)wp, b = *(const LAS f32x4*)(wp + 4); const float hv = v[j][e];
                    acc[0] += hv * a.x; acc[1] += hv * a.y; acc[2] += hv * a.z; acc[3] += hv * a.w; acc[4] += hv * b.x; acc[5] += hv * b.y; acc[6] += hv * b.z; acc[7] += hv * b.w; } }
#pragma unroll
            for (int q = 0; q < 8; ++q) acc[q] = wave_sum(acc[q]);
            if (lane < 8) { float r = acc[0];
#pragma unroll
                for (int q = 1; q < 8; ++q) r = (lane == q) ? acc[q] : r;
                gates[(size_t)row * 8 + lane] = r + gate_bias[lane]; }
        }
    }
}

__device__ __forceinline__ void unpack8(const v4u v, float (&f)[8]) { f[0] = bflo(v.x); f[1] = bfhi(v.x); f[2] = bflo(v.y); f[3] = bfhi(v.y); f[4] = bflo(v.z); f[5] = bfhi(v.z); f[6] = bflo(v.w); f[7] = bfhi(v.w); }
__device__ __forceinline__ void p_lstm_conv(const Frame& F, const bf16* z, const float* cw, const float* cb, bf16* qk) {
    constexpr int NCH = DM / 8, SEGR = 16, NSEG = MROWS / SEGR;
    const int total = NCH * NSEG, stride = F.G * NTHREADS;
    for (int item = F.vcu * NTHREADS + F.tid; item < total; item += stride) {
        const int cc = item % NCH, seg = item / NCH, c = 8 * cc, r0 = seg * SEGR, t0 = r0 & (SEQ - 1);
        float w[4][8], bb[8];
        { const f32x4 b0 = *(const f32x4*)(cb + c), b1 = *(const f32x4*)(cb + c + 4);
#pragma unroll
          for (int e = 0; e < 4; ++e) { bb[e] = b0[e]; bb[4 + e] = b1[e]; }
#pragma unroll
          for (int j = 0; j < 4; ++j) { const f32x4 w0 = *(const f32x4*)(cw + j * DM + c), w1 = *(const f32x4*)(cw + j * DM + c + 4);
#pragma unroll
              for (int e = 0; e < 4; ++e) { w[j][e] = w0[e]; w[j][4 + e] = w1[e]; } } }
        const float sc = (c >= QKW) ? 0.0625f : 1.f;
        float x3[8], x2[8], x1[8];
#pragma unroll
        for (int e = 0; e < 8; ++e) { x3[e] = 0.f; x2[e] = 0.f; x1[e] = 0.f; }
        if (t0 > 0) { unpack8(*(const v4u*)(z + (size_t)(r0 - 3) * INW_MAIN + c), x3); unpack8(*(const v4u*)(z + (size_t)(r0 - 2) * INW_MAIN + c), x2); unpack8(*(const v4u*)(z + (size_t)(r0 - 1) * INW_MAIN + c), x1); }
#pragma unroll 4
        for (int r = 0; r < SEGR; ++r) {
            float x0[8]; unpack8(*(const v4u*)(z + (size_t)(r0 + r) * INW_MAIN + c), x0);
            float o[8];
#pragma unroll
            for (int e = 0; e < 8; ++e) { const float a = bb[e] + w[0][e] * x3[e] + w[1][e] * x2[e] + w[2][e] * x1[e] + w[3][e] * x0[e]; o[e] = siluf_(a) * sc; x3[e] = x2[e]; x2[e] = x1[e]; x1[e] = x0[e]; }
            v4u ow; ow.x = pk2(o[0], o[1]); ow.y = pk2(o[2], o[3]); ow.z = pk2(o[4], o[5]); ow.w = pk2(o[6], o[7]);
            *(v4u*)(qk + (size_t)(r0 + r) * DM + c) = ow;
        }
    }
}

typedef short bf16x8 __attribute__((ext_vector_type(8)));
typedef short s16x4 __attribute__((ext_vector_type(4)));
typedef float f32x16 __attribute__((ext_vector_type(16)));
typedef __attribute__((address_space(3))) const unsigned char* lds_cptr;
__device__ __forceinline__ s16x4 vtr(lds_cptr p) { return __builtin_bit_cast(s16x4, __builtin_amdgcn_ds_read_tr16_b64_v4i16((__attribute__((address_space(3))) s16x4*)p)); }
__device__ __forceinline__ bf16x8 cat8(s16x4 lo, s16x4 hi) { return (bf16x8){lo[0], lo[1], lo[2], lo[3], hi[0], hi[1], hi[2], hi[3]}; }

constexpr int NSL = 17;
constexpr size_t CST_SLICE = 16384;
constexpr int L2_KSTR = 576, L2_KBUF = 64 * L2_KSTR;
constexpr int L2_VBUF = 64 * 64;

__device__ __forceinline__ float log_sigmoidf_(float x) { return (x >= 0.f) ? -log1pf(__expf(-x)) : x - log1pf(__expf(x)); }
__device__ __forceinline__ void p_lstm_scan2(const Frame& F, const float* gates, float* U, float* Mx, float* E) {
    if (F.vcu >= 8) return;
    const int bh = F.vcu, b = bh >> 2, h = bh & 3, tid = F.tid, lane = F.lane, w = F.wave, t0 = tid * 8;
    LAS float* wsum = (LAS float*)F.lds; LAS float* wmax = wsum + 8;
    const float* gb = gates + (size_t)(b * SEQ + t0) * 8;
    float lf[8], li[8];
#pragma unroll
    for (int i = 0; i < 8; ++i) { lf[i] = gb[i * 8 + 4 + h]; li[i] = gb[i * 8 + h]; }
    float s = 0.f;
#pragma unroll
    for (int i = 0; i < 8; ++i) { lf[i] = log_sigmoidf_(lf[i]); s += lf[i]; }
    float inc = s;
#pragma unroll
    for (int o = 1; o < 64; o <<= 1) { const float y = __shfl_up(inc, o); if (lane >= o) inc += y; }
    __syncthreads();
    if (lane == 63) wsum[w] = inc;
    __syncthreads();
    float base = 0.f;
#pragma unroll
    for (int q = 0; q < 8; ++q) base += (q < w) ? wsum[q] : 0.f;
    float Fc = base + inc - s, lm = -INFINITY; float u[8], Fv[8];
#pragma unroll
    for (int i = 0; i < 8; ++i) { Fc += lf[i]; Fv[i] = Fc; u[i] = li[i] - Fc; lm = fmaxf(lm, u[i]); }
    float pm = lm;
#pragma unroll
    for (int o = 1; o < 64; o <<= 1) { const float y = __shfl_up(pm, o); if (lane >= o) pm = fmaxf(pm, y); }
    if (lane == 63) wmax[w] = pm;
    __syncthreads();
    float mm = __shfl_up(pm, 1); if (lane == 0) mm = 0.f;
#pragma unroll
    for (int q = 0; q < 8; ++q) mm = fmaxf(mm, (q < w) ? wmax[q] : 0.f);
    mm = fmaxf(mm, 0.f);
#pragma unroll
    for (int i = 0; i < 8; ++i) { mm = fmaxf(mm, u[i]); U[bh * SEQ + t0 + i] = u[i]; Mx[bh * SEQ + t0 + i] = mm; E[bh * SEQ + t0 + i] = __expf(-(Fv[i] + mm)); }
    __syncthreads();
}

constexpr int S2_KSTR = 320, S2_KBUF = 64 * S2_KSTR;
constexpr int S2_VSTR = 192, S2_VBUF = 64 * S2_VSTR;
constexpr int S2_NWG = 128;
__device__ __forceinline__ void p_lstm_state(const Frame& F, const bf16* qk, const bf16* z, const float* U, const float* Mx, unsigned char* cst, float* nst) {
    const int item = F.vcu; if (item >= S2_NWG) return;
    const int bh = item >> 4, dkh = (item >> 3) & 1, dvp = item & 7, b = bh >> 2, h = bh & 3;
    const int tid = F.tid, lane = F.lane, w = F.wave, hi = lane >> 5, g1 = (lane >> 4) & 1, q4 = (lane & 15) >> 2, p4 = lane & 3, kbk = w & 3, vbk = w >> 2;
    LAS unsigned char* kb0 = F.lds; LAS unsigned char* vb0 = F.lds + 2 * S2_KBUF;
    const size_t rbase = (size_t)b * SEQ;
    const bf16* kg = qk + rbase * DM + QKW + h * LDK + 128 * dkh;
    const bf16* vg = z + rbase * INW_MAIN + 2 * QKW + h * LDV + 64 * dvp;
    const float* Ub = U + bh * SEQ; const float* Mb = Mx + bh * SEQ;
    const bool donorm = (dvp == 0);
    f32x16 acc;
#pragma unroll
    for (int r = 0; r < 16; ++r) acc[r] = 0.f;
    v4u kreg[4][2]; v4u vreg[4];
    LAS float* wtl = (LAS float*)(F.lds + 2 * S2_KBUF + 2 * S2_VBUF); LAS float* decl = wtl + SEQ; LAS float* nl = decl + 64;
    __syncthreads();
#pragma unroll
    for (int i = 0; i < 8; ++i) { const int t = tid + 512 * i; wtl[t] = __expf(Ub[t] - Mb[(t & ~63) + 63]); }
    if (tid < 64) decl[tid] = __expf((tid > 0 ? Mb[tid * 64 - 1] : 0.f) - Mb[tid * 64 + 63]);
    const int krow = tid >> 4, kch = tid & 15, vrow = tid >> 3, vch = tid & 7, nd = tid & 127, ntq = tid >> 7;
    float nacc = 0.f;
#define L2_LOAD(c, sl) do { const int t0_ = (c) * 64; \
        _Pragma("unroll") for (int i_ = 0; i_ < 2; ++i_) kreg[sl][i_] = *(const v4u*)(kg + (size_t)(t0_ + krow + 32 * i_) * DM + kch * 8); \
        vreg[sl] = *(const v4u*)(vg + (size_t)(t0_ + vrow) * INW_MAIN + vch * 8); } while (0)
#define L2_STORE(sl, buf, c_) do { \
        _Pragma("unroll") for (int i_ = 0; i_ < 2; ++i_) *(LAS v4u*)(kb0 + (buf) * S2_KBUF + (krow + 32 * i_) * S2_KSTR + kch * 16) = kreg[sl][i_]; \
        { const float wt_ = wtl[(c_) * 64 + vrow]; v4u o_; const v4u vr_ = vreg[sl]; \
            o_.x = pk2(bflo(vr_.x) * wt_, bfhi(vr_.x) * wt_); o_.y = pk2(bflo(vr_.y) * wt_, bfhi(vr_.y) * wt_); o_.z = pk2(bflo(vr_.z) * wt_, bfhi(vr_.z) * wt_); o_.w = pk2(bflo(vr_.w) * wt_, bfhi(vr_.w) * wt_); \
            *(LAS v4u*)(vb0 + (buf) * S2_VBUF + vrow * S2_VSTR + vch * 16) = o_; } } while (0)
    const int koff = (8 * hi + q4) * S2_KSTR + (32 * kbk + 16 * g1 + 4 * p4) * 2;
    const int voff = (8 * hi + q4) * S2_VSTR + (32 * vbk + 16 * g1 + 4 * p4) * 2;
    unsigned char* cdst = cst + ((size_t)(bh * 64) * NSL + (2 * dvp + vbk)) * CST_SLICE + ((size_t)((4 * dkh + kbk) * 2) * 64 + lane) * 16;
    float* ndst = nst + (size_t)(bh * 64) * LDK + 128 * dkh + nd;
    __syncthreads();
    L2_LOAD(0, 0); L2_LOAD(1, 1); L2_LOAD(2, 2); L2_LOAD(3, 3);
    L2_STORE(0, 0, 0);
    __syncthreads();
#define L2_CSTORE(c_) do { unsigned char* d = cdst + (size_t)(c_) * NSL * CST_SLICE; \
          _Pragma("unroll") for (int s_ = 0; s_ < 2; ++s_) { v4u o; o.x = pk2(acc[8 * s_ + 0], acc[8 * s_ + 1]); o.y = pk2(acc[8 * s_ + 2], acc[8 * s_ + 3]); o.z = pk2(acc[8 * s_ + 4], acc[8 * s_ + 5]); o.w = pk2(acc[8 * s_ + 6], acc[8 * s_ + 7]); \
              *(v4u*)(d + s_ * 1024) = o; } } while (0)
#define L2_ITER(c, sl, sln) do { \
        const float decay = decl[c]; \
        if (donorm) { nl[(((c) & 1) * 4 + ntq) * 128 + nd] = nacc; \
            if ((c) > 0 && tid < 128) { const LAS float* np_ = nl + ((((c) - 1) & 1) * 4) * 128 + tid; ndst[(size_t)((c) - 1) * LDK] = (np_[0] + np_[128]) + (np_[256] + np_[384]); } \
            float np = 0.f; const LAS unsigned char* kr_ = kb0 + ((c) & 1) * S2_KBUF + (16 * ntq) * S2_KSTR + nd * 2; const LAS float* wr_ = wtl + (c) * 64 + 16 * ntq; \
            _Pragma("unroll") for (int t_ = 0; t_ < 16; ++t_) np += wr_[t_] * bf2f(*(const LAS unsigned short*)(kr_ + t_ * S2_KSTR)); \
            nacc = nacc * decay + np; } \
        _Pragma("unroll") for (int r = 0; r < 16; ++r) acc[r] *= decay; \
        { lds_cptr kp = (lds_cptr)(kb0 + ((c) & 1) * S2_KBUF + koff); lds_cptr vp = (lds_cptr)(vb0 + ((c) & 1) * S2_VBUF + voff); \
          _Pragma("unroll") for (int ks = 0; ks < 4; ++ks) { \
              const bf16x8 a = cat8(vtr(kp + ks * 16 * S2_KSTR), vtr(kp + ks * 16 * S2_KSTR + 4 * S2_KSTR)); \
              const bf16x8 bb = cat8(vtr(vp + ks * 16 * S2_VSTR), vtr(vp + ks * 16 * S2_VSTR + 4 * S2_VSTR)); \
              acc = __builtin_amdgcn_mfma_f32_32x32x16_bf16(a, bb, acc, 0, 0, 0); } } \
        if ((c) + 1 < 64) { L2_STORE(sln, ((c) + 1) & 1, (c) + 1); } \
        if ((c) + 4 < 64) L2_LOAD((c) + 4, sl); \
        if ((c) + 1 < 64) L2_CSTORE((c) + 1);            \
        asm volatile("s_waitcnt lgkmcnt(0)" ::: "memory"); __builtin_amdgcn_s_barrier(); asm volatile("" ::: "memory"); } while (0)
    L2_CSTORE(0);
    for (int c4 = 0; c4 < 64; c4 += 4) { L2_ITER(c4, 0, 1); L2_ITER(c4 + 1, 1, 2); L2_ITER(c4 + 2, 2, 3); L2_ITER(c4 + 3, 3, 0); }
    if (donorm && tid < 128) { const LAS float* np_ = nl + 4 * 128 + tid; ndst[(size_t)63 * LDK] = (np_[0] + np_[128]) + (np_[256] + np_[384]); }
#undef L2_ITER
#undef L2_CSTORE
#undef L2_LOAD
#undef L2_STORE
}

constexpr int L3_QSTR = 528, L3_VSTR = 1088, L3_WSTR = 144;
constexpr int L3_Q = 0, L3_K = L3_Q + 64 * L3_QSTR, L3_V = L3_K + 64 * L3_QSTR, L3_W = L3_V + 64 * L3_VSTR, L3_SC = L3_W + 64 * L3_WSTR, L3_END = L3_SC + 8192;
__device__ __forceinline__ void p_lstm_out(const Frame& F, const bf16* qk, const bf16* z, const float* U, const float* Mx, const float* E, const unsigned char* cst, const float* nst, const float* hgain, bf16* O) {
    const int tid = F.tid, lane = F.lane, w = F.wave, hi = lane >> 5, g1 = (lane >> 4) & 1, q4 = (lane & 15) >> 2, p4 = lane & 3, l31 = lane & 31;
    LAS unsigned char* lds = F.lds;
    LAS float* sc = (LAS float*)(lds + L3_SC);
    LAS float* uS = sc, *Mrow = sc + 64, *inter = sc + 128, *Erow = sc + 192, *dinv = sc + 256, *nvec = sc + 320, *ssq = sc + 576, *rstdv = sc + 1088;
    for (int item = F.vcu; item < 8 * 64; item += F.G) {
        const int bh = item >> 6, c = item & 63, b = bh >> 2, h = bh & 3, t0 = c * 64;
        const size_t row0 = (size_t)b * SEQ + t0;
        __syncthreads();
        { v4u rq[4], rk[4], rv[8];
#pragma unroll
          for (int i = 0; i < 4; ++i) { const int id = tid + 512 * i, r = id >> 5, ch = id & 31;
              rq[i] = *(const v4u*)(qk + (row0 + r) * DM + h * LDK + ch * 8); rk[i] = *(const v4u*)(qk + (row0 + r) * DM + QKW + h * LDK + ch * 8); }
#pragma unroll
          for (int i = 0; i < 8; ++i) { const int id = tid + 512 * i, r = id >> 6, ch = id & 63; rv[i] = *(const v4u*)(z + (row0 + r) * INW_MAIN + 2 * QKW + h * LDV + ch * 8); }
#pragma unroll
          for (int i = 0; i < 4; ++i) { const int id = tid + 512 * i, r = id >> 5, ch = id & 31;
              *(LAS v4u*)(lds + L3_Q + r * L3_QSTR + ch * 16) = rq[i]; *(LAS v4u*)(lds + L3_K + r * L3_QSTR + ch * 16) = rk[i]; }
#pragma unroll
          for (int i = 0; i < 8; ++i) { const int id = tid + 512 * i, r = id >> 6, ch = id & 63; *(LAS v4u*)(lds + L3_V + r * L3_VSTR + ch * 16) = rv[i]; } }
        if (tid < 64) { const float mr = Mx[bh * SEQ + t0 + tid]; const float mp = (c > 0) ? Mx[bh * SEQ + t0 - 1] : 0.f;
            uS[tid] = U[bh * SEQ + t0 + tid]; Mrow[tid] = mr; inter[tid] = __expf(mp - mr); Erow[tid] = E[bh * SEQ + t0 + tid]; }
        else if (tid < 128) { const int i4 = tid - 64; *(LAS f32x4*)(nvec + 4 * i4) = *(const f32x4*)(nst + (size_t)(bh * 64 + c) * LDK + 4 * i4); }
        __syncthreads();
        { const int rt = w >> 1, i15 = lane & 15, quad = lane >> 4;
#pragma unroll
          for (int cc = 0; cc < 2; ++cc) { const int ct = 2 * (w & 1) + cc;
              pg8::f32x4 sacc = (pg8::f32x4){0.f, 0.f, 0.f, 0.f};
              if (ct <= rt) {
                  const LAS unsigned char* qa = lds + L3_Q + (16 * rt + i15) * L3_QSTR + quad * 16; const LAS unsigned char* ka = lds + L3_K + (16 * ct + i15) * L3_QSTR + quad * 16;
#pragma unroll
                  for (int ks = 0; ks < 8; ++ks) { const bf16x8 a = *(const LAS bf16x8*)(qa + ks * 64), bb = *(const LAS bf16x8*)(ka + ks * 64);
                      sacc = __builtin_amdgcn_mfma_f32_16x16x32_bf16(a, bb, sacc, 0, 0, 0); } }
              const int s_ = 16 * ct + i15; const float us = uS[s_];
#pragma unroll
              for (int e = 0; e < 4; ++e) { const int l_ = 16 * rt + 4 * quad + e; const float wv = (s_ <= l_) ? sacc[e] * __expf(us - Mrow[l_]) : 0.f;
                  *(LAS unsigned short*)(lds + L3_W + l_ * L3_WSTR + s_ * 2) = (unsigned short)f2bf(wv); } } }
        __syncthreads();
        { const int r = tid >> 3, part = tid & 7; const v4u wv = *(const LAS v4u*)(lds + L3_W + r * L3_WSTR + part * 16);
          float rs = (bflo(wv.x) + bfhi(wv.x)) + (bflo(wv.y) + bfhi(wv.y)) + (bflo(wv.z) + bfhi(wv.z)) + (bflo(wv.w) + bfhi(wv.w)); float qn = 0.f;
#pragma unroll
          for (int i = 0; i < 4; ++i) { const v4u qv = *(const LAS v4u*)(lds + L3_Q + r * L3_QSTR + part * 64 + i * 16); const LAS float* np = nvec + part * 32 + i * 8;
              qn += bflo(qv.x) * np[0] + bfhi(qv.x) * np[1] + bflo(qv.y) * np[2] + bfhi(qv.y) * np[3] + bflo(qv.z) * np[4] + bfhi(qv.z) * np[5] + bflo(qv.w) * np[6] + bfhi(qv.w) * np[7]; }
          float den = inter[r] * qn + rs; den += __shfl_xor(den, 1); den += __shfl_xor(den, 2); den += __shfl_xor(den, 4);
          if (part == 0) dinv[r] = 1.f / fmaxf(fabsf(den), Erow[r]); }
        f32x16 acc[2][2];
#pragma unroll
        for (int a = 0; a < 2; ++a)
#pragma unroll
            for (int bq = 0; bq < 2; ++bq)
#pragma unroll
                for (int r = 0; r < 16; ++r) acc[a][bq][r] = 0.f;
        { const unsigned char* cb = cst + ((size_t)(bh * 64 + c) * NSL + 2 * w) * CST_SLICE + (size_t)lane * 16;
          const LAS unsigned char* qa = lds + L3_Q + l31 * L3_QSTR + hi * 8;
          bf16x8 bfr[2][8];
#pragma unroll
          for (int q = 0; q < 4; ++q) { bfr[0][2 * q] = *(const bf16x8*)(cb + q * 1024); bfr[0][2 * q + 1] = *(const bf16x8*)(cb + CST_SLICE + q * 1024); }
#pragma unroll
          for (int gq = 0; gq < 4; ++gq) {
              if (gq < 3) {
#pragma unroll
                  for (int q = 0; q < 4; ++q) { bfr[(gq + 1) & 1][2 * q] = *(const bf16x8*)(cb + (4 * (gq + 1) + q) * 1024); bfr[(gq + 1) & 1][2 * q + 1] = *(const bf16x8*)(cb + CST_SLICE + (4 * (gq + 1) + q) * 1024); } }
#pragma unroll
              for (int q = 0; q < 4; ++q) { const int kk = 4 * gq + q; const bf16x8 b0 = bfr[gq & 1][2 * q], b1 = bfr[gq & 1][2 * q + 1];
                  bf16x8 a[2];
#pragma unroll
                  for (int rt = 0; rt < 2; ++rt) { const s16x4 lo = *(const LAS s16x4*)(qa + rt * 32 * L3_QSTR + kk * 32), hh = *(const LAS s16x4*)(qa + rt * 32 * L3_QSTR + kk * 32 + 16); a[rt] = cat8(lo, hh); }
                  acc[0][0] = __builtin_amdgcn_mfma_f32_32x32x16_bf16(a[0], b0, acc[0][0], 0, 0, 0);
                  acc[0][1] = __builtin_amdgcn_mfma_f32_32x32x16_bf16(a[0], b1, acc[0][1], 0, 0, 0);
                  acc[1][0] = __builtin_amdgcn_mfma_f32_32x32x16_bf16(a[1], b0, acc[1][0], 0, 0, 0);
                  acc[1][1] = __builtin_amdgcn_mfma_f32_32x32x16_bf16(a[1], b1, acc[1][1], 0, 0, 0); }
              __builtin_amdgcn_sched_barrier(0); } }
#pragma unroll
        for (int rt = 0; rt < 2; ++rt)
#pragma unroll
            for (int r = 0; r < 16; ++r) { const float f = inter[32 * rt + (r & 3) + 8 * (r >> 2) + 4 * hi]; acc[rt][0][r] *= f; acc[rt][1][r] *= f; }
        { const LAS unsigned char* wa = lds + L3_W + l31 * L3_WSTR + hi * 16;
          lds_cptr vp = (lds_cptr)(lds + L3_V + (8 * hi + q4) * L3_VSTR + (64 * w + 16 * g1 + 4 * p4) * 2);
#pragma unroll
          for (int ks = 0; ks < 4; ++ks) {
              const bf16x8 a0 = *(const LAS bf16x8*)(wa + ks * 32), a1 = *(const LAS bf16x8*)(wa + 32 * L3_WSTR + ks * 32);
              const bf16x8 b0 = cat8(vtr(vp + ks * 16 * L3_VSTR), vtr(vp + ks * 16 * L3_VSTR + 4 * L3_VSTR));
              const bf16x8 b1 = cat8(vtr(vp + ks * 16 * L3_VSTR + 64), vtr(vp + ks * 16 * L3_VSTR + 4 * L3_VSTR + 64));
              acc[0][0] = __builtin_amdgcn_mfma_f32_32x32x16_bf16(a0, b0, acc[0][0], 0, 0, 0);
              acc[0][1] = __builtin_amdgcn_mfma_f32_32x32x16_bf16(a0, b1, acc[0][1], 0, 0, 0);
              acc[1][0] = __builtin_amdgcn_mfma_f32_32x32x16_bf16(a1, b0, acc[1][0], 0, 0, 0);
              acc[1][1] = __builtin_amdgcn_mfma_f32_32x32x16_bf16(a1, b1, acc[1][1], 0, 0, 0); } }
        __syncthreads();
        { LAS unsigned short* hb = (LAS unsigned short*)(lds + L3_V);
#pragma unroll
          for (int rt = 0; rt < 2; ++rt)
#pragma unroll
              for (int r = 0; r < 16; ++r) { const int l_ = 32 * rt + (r & 3) + 8 * (r >> 2) + 4 * hi; const float dn = dinv[l_];
                  const float x0 = acc[rt][0][r] * dn, x1 = acc[rt][1][r] * dn;
                  const unsigned pw = pk2(x0, x1);
                  hb[l_ * (L3_VSTR / 2) + 64 * w + l31] = (unsigned short)(pw & 0xffffu); hb[l_ * (L3_VSTR / 2) + 64 * w + 32 + l31] = (unsigned short)(pw >> 16);
                  float q2 = x0 * x0 + x1 * x1; q2 += __shfl_xor(q2, 1); q2 += __shfl_xor(q2, 2); q2 += __shfl_xor(q2, 4); q2 += __shfl_xor(q2, 8); q2 += __shfl_xor(q2, 16);
                  if (l31 == 0) ssq[w * 64 + l_] = q2; } }
        __syncthreads();
        if (tid < 64) { float tot = 0.f;
#pragma unroll
            for (int ww = 0; ww < 8; ++ww) tot += ssq[ww * 64 + tid];
            rstdv[tid] = 1.f / sqrtf(tot * (1.f / LDV) + NORM_EPS); }
        __syncthreads();
        { const int ch = tid & 63; const f32x4 ga = *(const f32x4*)(hgain + h * LDV + ch * 8), gb = *(const f32x4*)(hgain + h * LDV + ch * 8 + 4);
#pragma unroll 2
          for (int i = 0; i < 8; ++i) { const int r = (tid >> 6) + 8 * i;
              const v4u ogv = *(const v4u*)(z + (row0 + r) * INW_MAIN + 2 * QKW + DM + h * LDV + ch * 8);
              const v4u hv = *(const LAS v4u*)(lds + L3_V + r * L3_VSTR + ch * 16);
              float hf[8], gf[8]; unpack8(hv, hf); unpack8(ogv, gf);
              const float rstd = rstdv[r];
#pragma unroll
              for (int e = 0; e < 8; ++e) gf[e] = rstd * __builtin_amdgcn_rcpf(1.f + __expf(-gf[e]));
              v4u o; o.x = pk2(hf[0] * ga[0] * gf[0], hf[1] * ga[1] * gf[1]); o.y = pk2(hf[2] * ga[2] * gf[2], hf[3] * ga[3] * gf[3]);
              o.z = pk2(hf[4] * gb[0] * gf[4], hf[5] * gb[1] * gf[5]); o.w = pk2(hf[6] * gb[2] * gf[6], hf[7] * gb[3] * gf[7]);
              *(v4u*)(O + (row0 + r) * DM + h * LDV + ch * 8) = o; } }
    }
    __syncthreads();
}


constexpr int AT_K = 0, AT_V = 65536;
__device__ __forceinline__ void p_attn(const Frame& F, const bf16* qkv, const float* qg, const float* kg, bf16* OG, float* LSE) {
    const int tid = F.tid, lane = F.lane, w = F.wave, i15 = lane & 15, quad = lane >> 4, q4 = i15 >> 2, p4 = lane & 3;
    LAS unsigned char* lds = F.lds;
    int lk[4];
#pragma unroll
    for (int ks = 0; ks < 4; ++ks) lk[ks] = i15 * 256 + (((4 * ks + quad) ^ i15) << 4);
    int lv[8];
    { const int rl = 4 * quad + q4, sw = (rl & 7) << 1, ps = ((p4 & 1) << 1) | (p4 >> 1);
#pragma unroll
      for (int dt = 0; dt < 8; ++dt) lv[dt] = rl * 256 + (((2 * dt + (ps >> 1)) ^ sw) << 4) + 8 * (ps & 1); }
#define AT_NIT(it_) ((F.vcu + F.G * ((it_) / 12)) < 256)
#define AT_DECODE(it_) const int grp_ = F.vcu + F.G * ((it_) / 12), k_ = (it_) % 12, b_ = grp_ >> 7, h_ = (grp_ >> 3) & 15, o_ = grp_ & 7; \
        const int g_ = k_ >> 2, dil_ = (g_ == 0) ? 1 : (g_ == 1) ? 4 : 16; \
        const int res_ = (g_ == 0) ? 0 : (g_ == 1) ? (o_ >> 1) : (2 * o_ + ((k_ - 8) >> 1)), n_ = (g_ == 0) ? (4 * o_ + k_) : (g_ == 1) ? (4 * (o_ & 1) + (k_ - 4)) : (k_ & 1); \
        const bool first_ = (g_ == 2) ? ((k_ & 1) == 0) : ((k_ & 3) == 0); const size_t brow_ = (size_t)b_ * SEQ;
    v4u pkc[4], pvc[4], pkp[4], pvp[4], pq_[4];
#define AT_PRELOAD(it_) do { AT_DECODE(it_) \
        _Pragma("unroll") for (int i = 0; i < 4; ++i) { const int id = tid + 512 * i, j = id >> 4, ch = id & 15; \
            const bf16* src = qkv + (brow_ + (size_t)(128 * n_ + j) * dil_ + res_) * NQKV + DM + h_ * AHD + ch * 8; pkc[i] = *(const v4u*)src; pvc[i] = *(const v4u*)(src + DM); } \
        if (first_ && n_ > 0) { _Pragma("unroll") for (int i = 0; i < 4; ++i) { const int id = tid + 512 * i, j = id >> 4, ch = id & 15; \
            const bf16* src = qkv + (brow_ + (size_t)(128 * (n_ - 1) + j) * dil_ + res_) * NQKV + DM + h_ * AHD + ch * 8; pkp[i] = *(const v4u*)src; pvp[i] = *(const v4u*)(src + DM); } } \
        { const size_t qrow_ = brow_ + (size_t)(128 * n_ + 16 * w + i15) * dil_ + res_; \
          _Pragma("unroll") for (int ks = 0; ks < 4; ++ks) pq_[ks] = *(const v4u*)(qkv + qrow_ * NQKV + h_ * AHD + 32 * ks + 8 * quad); } } while (0)
    if (AT_NIT(0)) AT_PRELOAD(0);
    for (int it = 0; AT_NIT(it); ++it) {
        AT_DECODE(it)
        const int g = g_, h = h_, n = n_, dil = dil_, res = res_; const size_t brow = brow_;
        const int hcur = (n & 1) * 32768, hprev = 32768 - hcur;
        asm volatile("s_waitcnt lgkmcnt(0)" ::: "memory"); __builtin_amdgcn_s_barrier(); asm volatile("" ::: "memory");
#pragma unroll
        for (int i = 0; i < 4; ++i) { const int id = tid + 512 * i, j = id >> 4, ch = id & 15;
            *(LAS v4u*)(lds + AT_K + hcur + j * 256 + ((ch ^ (j & 15)) << 4)) = pkc[i];
            *(LAS v4u*)(lds + AT_V + hcur + j * 256 + ((ch ^ ((j & 7) << 1)) << 4)) = pvc[i]; }
        if (first_) {
#pragma unroll
            for (int i = 0; i < 4; ++i) { const int id = tid + 512 * i, j = id >> 4, ch = id & 15;
                v4u kv = pkp[i], vvv = pvp[i]; if (n == 0) { kv = (v4u){0u, 0u, 0u, 0u}; vvv = kv; }
                *(LAS v4u*)(lds + AT_K + hprev + j * 256 + ((ch ^ (j & 15)) << 4)) = kv;
                *(LAS v4u*)(lds + AT_V + hprev + j * 256 + ((ch ^ ((j & 7) << 1)) << 4)) = vvv; } }
        const size_t qrow = brow + (size_t)(128 * n + 16 * w + i15) * dil + res;
        bf16x8 qf[4];
#pragma unroll
        for (int ks = 0; ks < 4; ++ks) qf[ks] = __builtin_bit_cast(bf16x8, pq_[ks]);
        asm volatile("s_waitcnt lgkmcnt(0)" ::: "memory"); __builtin_amdgcn_s_barrier(); asm volatile("" ::: "memory");
        if (AT_NIT(it + 1)) AT_PRELOAD(it + 1);
#define AT_TOFF(T) ((((T) < 8) ? hprev : hcur) + ((T) & 7) * 4096)
        pg8::f32x4 st[9];
        { bf16x8 ka[3][4];
#pragma unroll
          for (int ks = 0; ks < 4; ++ks) { ka[0][ks] = *(const LAS bf16x8*)(lds + AT_K + AT_TOFF(w) + lk[ks]); ka[1][ks] = *(const LAS bf16x8*)(lds + AT_K + AT_TOFF(w + 1) + lk[ks]); }
#pragma unroll
          for (int jt = 0; jt < 9; ++jt) { st[jt] = (pg8::f32x4){0.f, 0.f, 0.f, 0.f};
              if (jt < 7) {
#pragma unroll
                  for (int ks = 0; ks < 4; ++ks) ka[(jt + 2) % 3][ks] = *(const LAS bf16x8*)(lds + AT_K + AT_TOFF(w + jt + 2) + lk[ks]); }
              if (n > 0 || w + jt >= 8) {
#pragma unroll
              for (int ks = 0; ks < 4; ++ks) st[jt] = __builtin_amdgcn_mfma_f32_16x16x32_bf16(ka[jt % 3][ks], qf[ks], st[jt], 0, 0, 0); }
              __builtin_amdgcn_sched_barrier(0); } }
        float mx = -INFINITY;
#pragma unroll
        for (int jt = 0; jt < 9; ++jt) { const bool tile_ok = (n > 0) || (w + jt >= 8);
#pragma unroll
            for (int e = 0; e < 4; ++e) { const int dj = 16 * jt + 4 * quad + e - i15;
                const bool ok = tile_ok && (jt != 0 || dj >= 0) && (jt != 8 || dj <= 128);
                const float s = ok ? st[jt][e] : -INFINITY; st[jt][e] = s; mx = fmaxf(mx, s); } }
        mx = fmaxf(mx, __shfl_xor(mx, 16)); mx = fmaxf(mx, __shfl_xor(mx, 32));
        float l = 0.f;
#pragma unroll
        for (int jt = 0; jt < 9; ++jt)
#pragma unroll
            for (int e = 0; e < 4; ++e) { const float p = __builtin_amdgcn_exp2f(st[jt][e] - mx); st[jt][e] = p; l += p; }
        l += __shfl_xor(l, 16); l += __shfl_xor(l, 32);
        pg8::f32x4 ot[8];
#pragma unroll
        for (int dt = 0; dt < 8; ++dt) ot[dt] = (pg8::f32x4){0.f, 0.f, 0.f, 0.f};
        { bf16x8 pb[5];
#pragma unroll
          for (int kk = 0; kk < 5; ++kk) { v4u pw; pw.x = pk2(st[2 * kk][0], st[2 * kk][1]); pw.y = pk2(st[2 * kk][2], st[2 * kk][3]);
              if (kk < 4) { pw.z = pk2(st[2 * kk + 1][0], st[2 * kk + 1][1]); pw.w = pk2(st[2 * kk + 1][2], st[2 * kk + 1][3]); } else { pw.z = 0u; pw.w = 0u; }
              pb[kk] = __builtin_bit_cast(bf16x8, pw); }
          s16x4 vf[3][4][2];
          const int t1last = (w == 7) ? 8 : 9;
#define AT_VLOAD(bt, buf) do { const int kk_ = (bt) >> 1, hf_ = (bt) & 1; const int t0_ = w + 2 * kk_, t1_ = w + ((kk_ < 4) ? (2 * kk_ + 1) : t1last); const int o0_ = AT_TOFF(t0_), o1_ = AT_TOFF(t1_); \
          _Pragma("unroll") for (int d_ = 0; d_ < 4; ++d_) { vf[buf][d_][0] = vtr((lds_cptr)(lds + AT_V + o0_ + lv[4 * hf_ + d_])); vf[buf][d_][1] = vtr((lds_cptr)(lds + AT_V + o1_ + lv[4 * hf_ + d_])); } } while (0)
          AT_VLOAD(0, 0); AT_VLOAD(1, 1);
#pragma unroll
          for (int bt = 0; bt < 10; ++bt) {
              if (bt < 8) AT_VLOAD(bt + 2, (bt + 2) % 3);
              if (n > 0 || w + 2 * (bt >> 1) + 1 >= 8) {
#pragma unroll
              for (int d = 0; d < 4; ++d) ot[4 * (bt & 1) + d] = __builtin_amdgcn_mfma_f32_16x16x32_bf16(cat8(vf[bt % 3][d][0], vf[bt % 3][d][1]), pb[bt >> 1], ot[4 * (bt & 1) + d], 0, 0, 0); }
              __builtin_amdgcn_sched_barrier(0); }
#undef AT_VLOAD
        }
#undef AT_TOFF
        { const float il = 1.f / l; const int hi32 = quad >> 1, ql = quad & 1; bf16* op = OG + ((size_t)g * MROWS + qrow) * DM + h * AHD + 16 * hi32 + 8 * ql;
#pragma unroll
          for (int dp = 0; dp < 4; ++dp) { const unsigned x0 = pk2(ot[2 * dp][0] * il, ot[2 * dp][1] * il), x1 = pk2(ot[2 * dp][2] * il, ot[2 * dp][3] * il);
              const unsigned y0 = pk2(ot[2 * dp + 1][0] * il, ot[2 * dp + 1][1] * il), y1 = pk2(ot[2 * dp + 1][2] * il, ot[2 * dp + 1][3] * il);
              const auto r0 = __builtin_amdgcn_permlane32_swap(x0, y0, false, false), r1 = __builtin_amdgcn_permlane32_swap(x1, y1, false, false);
              v4u o; o.x = r0[0]; o.y = r1[0]; o.z = r0[1]; o.w = r1[1]; *(v4u*)(op + 32 * dp) = o; }
          if (quad == 0) LSE[(qrow * AH + h) * 4 + g] = (mx + __log2f(l)) * 0.6931471805599453f; }
    }
#undef AT_NIT
#undef AT_DECODE
#undef AT_PRELOAD
    __syncthreads();
}
__device__ __forceinline__ void p_attn_combine(const Frame& F, const bf16* OG, const float* LSE, bf16* O) {
    const size_t total = (size_t)MROWS * (DM / 8), stride = (size_t)F.G * NTHREADS;
    for (size_t idx = (size_t)F.vcu * NTHREADS + F.tid; idx < total; idx += stride) {
        const int c8 = (int)(idx & 255), row = (int)(idx >> 8), h = c8 >> 4;
        const f32x4 lv = *(const f32x4*)(LSE + ((size_t)row * AH + h) * 4); const float l0 = lv[0], l1 = lv[1], l2 = lv[2];
        const float m = fmaxf(l0, fmaxf(l1, l2)); float w0 = __expf(l0 - m), w1 = __expf(l1 - m), w2 = __expf(l2 - m); const float inv = 1.f / (w0 + w1 + w2); w0 *= inv; w1 *= inv; w2 *= inv;
        const v4u a = *(const v4u*)(OG + ((size_t)0 * MROWS + row) * DM + c8 * 8), bq = *(const v4u*)(OG + ((size_t)1 * MROWS + row) * DM + c8 * 8), cq = *(const v4u*)(OG + ((size_t)2 * MROWS + row) * DM + c8 * 8);
        v4u o;
        o.x = pk2(w0 * bflo(a.x) + w1 * bflo(bq.x) + w2 * bflo(cq.x), w0 * bfhi(a.x) + w1 * bfhi(bq.x) + w2 * bfhi(cq.x));
        o.y = pk2(w0 * bflo(a.y) + w1 * bflo(bq.y) + w2 * bflo(cq.y), w0 * bfhi(a.y) + w1 * bfhi(bq.y) + w2 * bfhi(cq.y));
        o.z = pk2(w0 * bflo(a.z) + w1 * bflo(bq.z) + w2 * bflo(cq.z), w0 * bfhi(a.z) + w1 * bfhi(bq.z) + w2 * bfhi(cq.z));
        o.w = pk2(w0 * bflo(a.w) + w1 * bflo(bq.w) + w2 * bflo(cq.w), w0 * bfhi(a.w) + w1 * bfhi(bq.w) + w2 * bfhi(cq.w));
        *(v4u*)(O + (size_t)row * DM + c8 * 8) = o;
    }
}

__device__ __forceinline__ void p_gemm_bf16(const Frame& F, const bf16* A, const bf16* Bt, int N, int K, bf16* O) {
    pg8::Gemm g{A, Bt, MROWS, N, K}; pg8::EpiBf16<0> E{O, N, nullptr, 0, 0, 1.f};
    pg8::StaticOrder S; S.init(MROWS, N, F.G, (int)blockIdx.x);
    pg8::gemm_phase<pg8::EpiBf16<0>, pg8::StaticOrder, true, true>(F.lds, g, S, E);
}
template <bool RB_IN, bool RB_OUT, bool WITH_SSQ> __device__ __forceinline__ void p_gemm_res(const Frame& F, const bf16* A, const bf16* Bt, int N, int K, const void* base, void* out, float* ssq = nullptr) {
    pg8::Gemm g{A, Bt, MROWS, N, K}; pg8::EpiRes<RB_IN, RB_OUT, WITH_SSQ> E{base, out, N, ssq};
    pg8::StaticOrder S; S.init(MROWS, N, F.G, (int)blockIdx.x);
    pg8::gemm_phase<pg8::EpiRes<RB_IN, RB_OUT, WITH_SSQ>, pg8::StaticOrder, true, true>(F.lds, g, S, E);
}
__device__ __forceinline__ void p_gemm_convgate(const Frame& F, const bf16* X, const bf16* Wt, const float* cw, const float* cb, bf16* Gout, const float* ssq) {
    pg8::Gemm g{Wt, X, FFN2, MROWS, DM}; pg8::EpiConvGateT E{Gout, cw, cb, (PG8_LAS float*)(F.lds + RING_BYTES)};
    pg8::StaticOrder S; S.init_tiles(FFN2 / 256, 2 * pg8::EpiConvGateT::TPS, F.G, (int)blockIdx.x);
    { LAS float* rsl = (LAS float*)(F.lds + RING_BYTES) + 5120; const int rl = F.tid >> 1, hf = F.tid & 1;
      __syncthreads();
#pragma unroll 2
      for (int i = 0; i < 7; ++i) { pg8::Unit u; if (!S.next(i, u)) break;
          int grow = pg8::EpiConvGateT::b_row0(u.pn) + rl; grow = grow < 0 ? 0 : (grow > MROWS - 1 ? MROWS - 1 : grow);
          const float* sp = ssq + (size_t)grow * 32 + 16 * hf; const f32x4 a0 = *(const f32x4*)sp, a1 = *(const f32x4*)(sp + 4), a2 = *(const f32x4*)(sp + 8), a3 = *(const f32x4*)(sp + 12);
          float t = ((a0[0] + a0[1]) + (a0[2] + a0[3])) + ((a1[0] + a1[1]) + (a1[2] + a1[3])) + ((a2[0] + a2[1]) + (a2[2] + a2[3])) + ((a3[0] + a3[1]) + (a3[2] + a3[3]));
          t += __shfl_xor(t, 1); if (hf == 0) rsl[256 * i + rl] = __builtin_amdgcn_rsqf(t * (1.f / DM) + NORM_EPS); }
      __syncthreads(); }
    pg8::gemm_phase<pg8::EpiConvGateT, pg8::StaticOrder, true, true>(F.lds, g, S, E);
}

__device__ __forceinline__ void p_gemm_qkv(const Frame& F, const bf16* A, const bf16* Bt, const float* qg, const float* kg, bf16* O) {
    pg8::Gemm g{A, Bt, MROWS, NQKV, DM}; pg8::EpiQKV E{O, NQKV, qg, kg, (PG8_LAS float*)(F.lds + RING_BYTES), 0.08838834764831845f * 1.4426950408889634f};
    pg8::StaticOrder S; S.init(MROWS, NQKV, F.G, (int)blockIdx.x);
    pg8::gemm_phase<pg8::EpiQKV, pg8::StaticOrder, true, true>(F.lds, g, S, E);
}

constexpr int N_PHASES = 15;
__global__ void __launch_bounds__(NTHREADS, 2) mega(Args args) {
    extern __shared__ __attribute__((aligned(16))) unsigned char lds_raw[];
    Frame F; F.lds = (LAS unsigned char*)lds_raw;
    F.tid = threadIdx.x; F.lane = F.tid & 63; F.wave = __builtin_amdgcn_readfirstlane(F.tid >> 6);
    F.G = gridDim.x; { const int bx = blockIdx.x; F.vcu = (F.G % 8 == 0) ? (bx % 8) * (F.G / 8) + bx / 8 : bx; }
    volatile LAS unsigned* MISC = (volatile LAS unsigned*)(F.lds + MISC_OFF);
    static_assert(L3_END <= MISC_OFF, "LDS map");
    for (int u = F.tid; u < (LDS_BYTES - MISC_OFF) / 4; u += NTHREADS) ((LAS unsigned*)(F.lds + MISC_OFF))[u] = 0u;
    __syncthreads();
    unsigned char* ws = args.ws;
    unsigned* ctl = (unsigned*)(ws + WS_CTL);
    XcdBarrier bar = xcd_barrier_post(ctl + CW_BAR, MISC);

    const float* x = args.in[0];
    const float *attn_norm = args.in[1], *w_qkv = args.in[2], *q_gain = args.in[3], *k_gain = args.in[4], *w_o = args.in[5];
    const float *lstm_norm = args.in[6], *w_in = args.in[7], *gate_bias = args.in[8], *lconv_w = args.in[9], *lconv_b = args.in[10], *head_gain = args.in[11], *w_out = args.in[12];
    const float *ffn_norm = args.in[13], *w_up = args.in[14], *fconv_w = args.in[15], *fconv_b = args.in[16], *w_down = args.in[17];
    float* out = args.out;
    bf16 *Wqkv = (bf16*)(ws + WS_WQKV), *Wo = (bf16*)(ws + WS_WO), *Win = (bf16*)(ws + WS_WIN), *Wout = (bf16*)(ws + WS_WOUT), *Wup = (bf16*)(ws + WS_WUP), *Wdn = (bf16*)(ws + WS_WDN);
    bf16 *HN = (bf16*)(ws + WS_HN), *G = (bf16*)(ws + WS_G), *QKV = (bf16*)(ws + WS_QKV), *O = (bf16*)(ws + WS_O), *QKC = (bf16*)(ws + WS_QKC), *U = (bf16*)(ws + WS_U);
    bf16* OG = (bf16*)(ws + WS_QKC); float* LSE = (float*)(ws + WS_G);
    float* SSQ = (float*)(ws + WS_SSQ); float* GWT = (float*)(ws + WS_GWT); bf16* XR = (bf16*)(ws + WS_XR);
    float *GATES = (float*)(ws + WS_GATES), *SU = (float*)(ws + WS_SU), *SM = (float*)(ws + WS_SM), *SE = (float*)(ws + WS_SE);

    const int lo = args.ph_lo, hi = args.ph_hi;
#define IN(k) (lo <= (k) && (k) < hi)

    int ph = 0;
#ifndef PROBE_MASK
#define PROBE_MASK 0u
#endif
#define PHASE(body) do { if (IN(ph)) { body; if ((PROBE_MASK >> ph) & 1u) { body; } } if (IN(ph) && IN(ph + 1)) xcd_barrier(bar); ++ph; } while (0)
    PHASE(
        p_convert(F, w_qkv, Wqkv, DM, NQKV, NQKV);
        p_convert(F, w_o, Wo, DM, DM, DM);
        p_convert(F, w_in, Win, DM, INW, INW_MAIN);
        p_convert(F, w_up, Wup, DM, FFN2, FFN2, true, 0, 0, ffn_norm);
        p_convert(F, w_down, Wdn, FFN, DM, DM);
        p_pack_gates(F, w_in, GWT);
        p_rmsnorm<false>(F, x, attn_norm, HN, nullptr, nullptr, nullptr));
    PHASE(p_gemm_qkv(F, HN, Wqkv, q_gain, k_gain, QKV));
    PHASE(p_attn(F, QKV, q_gain, k_gain, OG, LSE));
    PHASE(p_attn_combine(F, OG, LSE, O));
    PHASE((p_gemm_res<false, true, true>(F, O, Wo, DM, DM, x, XR, SSQ)));
    PHASE(p_gemm_convgate(F, XR, Wup, fconv_w, fconv_b, G, SSQ));
    PHASE((p_gemm_res<true, true, false>(F, G, Wdn, DM, FFN, XR, XR)));
    PHASE(p_rmsnorm<true>(F, XR, lstm_norm, HN, GWT, gate_bias, GATES));
    PHASE(p_gemm_bf16(F, HN, Win, INW_MAIN, DM, QKV));
    PHASE(p_lstm_scan2(F, GATES, SU, SM, SE); p_lstm_conv(F, QKV, lconv_w, lconv_b, QKC));
    PHASE(p_lstm_state(F, QKC, QKV, SU, SM, ws + WS_CST, (float*)(ws + WS_NST));
          p_convert(F, w_up + (size_t)DM * FFN2, Wup + (size_t)FFN2 * DM, DM, FFN2, FFN2, true, F.vcu - S2_NWG, F.G - S2_NWG, ffn_norm + DM);
          p_convert(F, w_down + (size_t)FFN * DM, Wdn + (size_t)DM * FFN, FFN, DM, DM, false, F.vcu - S2_NWG, F.G - S2_NWG);
          p_convert(F, w_out, Wout, DM, DM, DM, false, F.vcu - S2_NWG, F.G - S2_NWG));
    PHASE(p_lstm_out(F, QKC, QKV, SU, SM, SE, ws + WS_CST, (const float*)(ws + WS_NST), head_gain, O));
    PHASE((p_gemm_res<true, true, true>(F, O, Wout, DM, DM, XR, XR, SSQ)));
    PHASE(p_gemm_convgate(F, XR, Wup + (size_t)FFN2 * DM, fconv_w + 3 * FFN2, fconv_b + FFN2, G, SSQ));
    PHASE((p_gemm_res<true, false, false>(F, G, Wdn + (size_t)DM * FFN, DM, FFN, XR, out)));
#undef PHASE
#undef IN
}

extern "C" void kernel_launch(void* const* d_in, const int* in_sizes, int n_in, void* d_out, int out_size, void* d_ws, size_t ws_size, hipStream_t stream) {
    static int grid = 0;
    if (grid == 0) {
        if (n_in != 18 || in_sizes[0] != MROWS * DM || out_size != MROWS * DM || ws_size < WS_END) { fprintf(stderr, "kernel_launch: unexpected problem (n_in %d, ws %zu < %zu)\n", n_in, ws_size, (size_t)WS_END); grid = -1; return; }
        int dev = 0, cus = 0, per_cu = 0;
        if (hipGetDevice(&dev) != hipSuccess || hipDeviceGetAttribute(&cus, hipDeviceAttributeMultiprocessorCount, dev) != hipSuccess) { grid = -1; return; }
        if (hipFuncSetAttribute((const void*)mega, hipFuncAttributeMaxDynamicSharedMemorySize, LDS_BYTES) != hipSuccess) { fprintf(stderr, "kernel_launch: hipFuncSetAttribute failed\n"); grid = -1; return; }
        if (hipOccupancyMaxActiveBlocksPerMultiprocessor(&per_cu, (const void*)mega, NTHREADS, LDS_BYTES) != hipSuccess || per_cu < 1) { fprintf(stderr, "kernel_launch: occupancy query says %d\n", per_cu); per_cu = 1; }
        (void)hipGetLastError();
        grid = cus;
    }
    if (grid < 0) return;
    if (hipMemsetAsync((char*)d_ws + WS_CTL, 0, CTL_ZERO_BYTES, stream) != hipSuccess) return;
    Args a; memset(&a, 0, sizeof(a));
    for (int i = 0; i < 18; ++i) a.in[i] = (const float*)d_in[i];
    a.out = (float*)d_out; a.ws = (unsigned char*)d_ws; a.ph_lo = 0; a.ph_hi = N_PHASES;
    void* kargs[] = {&a};
    hipError_t e = hipLaunchCooperativeKernel((const void*)mega, dim3(grid), dim3(NTHREADS), kargs, LDS_BYTES, stream);
    if (e != hipSuccess) { fprintf(stderr, "kernel_launch: cooperative launch failed: %s; plain launch instead\n", hipGetErrorString(e)); (void)hipGetLastError();
        hipLaunchKernelGGL(mega, dim3(grid), dim3(NTHREADS), LDS_BYTES, stream, a); }
}
```

```cpp
#include <hip/hip_runtime.h>
#include <cstdio>
#include <cstdint>
#include <cstring>

namespace pg8 {
#define PG8_LAS __attribute__((address_space(3)))
typedef unsigned short bf16_t;
typedef short bf16x8 __attribute__((ext_vector_type(8)));
typedef float f32x4 __attribute__((ext_vector_type(4)));
typedef unsigned u32x4 __attribute__((ext_vector_type(4)));
constexpr int BM = 256, BK = 64, HALF = 128, HTB = HALF * BK * 2  , STAGE_BYTES = 8 * HTB, NXCD = 8, WGM = 8;

__host__ __device__ __forceinline__ int lds_byte(int r, int c) { const int st = (r >> 4) * 2 + (c >> 5), rr = r & 15, cc = c & 31, ob = rr * 64 + cc * 2; return st * 1024 + (ob ^ (((ob >> 9) & 1) << 5)); }
__host__ __device__ __forceinline__ void stage_rc(int b, int& R, int& C) { const int st = b / 1024, sb = b % 1024, swz = sb ^ (((sb >> 9) & 1) << 5); R = (st >> 1) * 16 + swz / 64; C = (st & 1) * 32 + (swz % 64) / 2; }
__host__ __device__ __forceinline__ int perm32(int rho) { const int n = rho >> 4, i = rho & 15; return 8 * (i >> 2) + 4 * n + (i & 3); }

struct Unit { int pm, pn; };
struct Gemm { const bf16_t* A; const bf16_t* Bt; int M, N, K; };

struct StaticOrder {
    int nM, nN, nwg, G, c;
    __host__ __device__ void init(int M, int N, int G_, int c_) { nM = M / BM; nN = N / BM; nwg = nM * nN; G = G_; c = c_; }
    __host__ __device__ void init_tiles(int nM_, int nN_, int G_, int c_) { nM = nM_; nN = nN_; nwg = nM * nN; G = G_; c = c_; }
    __host__ __device__ bool next(int i, Unit& u) const {
        const long L = (long)i * G + c; if (L >= nwg) return false;
        int wgid = (int)L; { const int q = nwg / NXCD, r = nwg % NXCD, xcd = wgid % NXCD, off = wgid / NXCD; wgid = (xcd < r ? xcd * (q + 1) : r * (q + 1) + (xcd - r) * q) + off; }
        const int nig = WGM * nN, gid = wgid / nig, fm = gid * WGM, gsz = (nM - fm) < WGM ? (nM - fm) : WGM;
        u.pm = fm + ((wgid % nig) % gsz); u.pn = (wgid % nig) / gsz; return true;
    }
    __device__ __forceinline__ void a_ready(const Unit&) const {}
    __device__ __forceinline__ void done(const Unit&) const {}
};
__device__ __forceinline__ unsigned cvt_pk_bf16(float lo, float hi) { unsigned r; asm volatile("v_cvt_pk_bf16_f32 %0, %1, %2" : "=v"(r) : "v"(lo), "v"(hi)); return r; }
typedef float f32x2 __attribute__((ext_vector_type(2)));
__device__ __forceinline__ f32x2 gelu_pk(f32x2 v) {
    const f32x2 av = __builtin_elementwise_abs(v), d = av * 0.2316418882f + 1.0f;
    f32x2 t; t.x = __builtin_amdgcn_rcpf(d.x); t.y = __builtin_amdgcn_rcpf(d.y);
    f32x2 q = t * 0.5307027145f + (-0.7265760135f); q = q * t + 0.7107068705f; q = q * t + (-0.142248368f); q = q * t + 0.127414796f; q = q * t;
    const f32x2 s = (v * v) * (-0.72134752044f);
    f32x2 e; e.x = __builtin_amdgcn_exp2f(s.x); e.y = __builtin_amdgcn_exp2f(s.y);
    const f32x2 m = v * (q * e), r = v - m;
    f32x2 o; o.x = v.x < 0.f ? m.x : r.x; o.y = v.y < 0.f ? m.y : r.y; return o;
}

template <int ACT  > struct EpiBf16 {
    static constexpr bool PERM = true, AFTER_DRAIN = false, ACC_INIT = false; static_assert(ACT == 0 || ACT == 1, "EpiBf16: ACT is 0 (none) or 1 (gelu_pk)");
    static __host__ __device__ __forceinline__ int a_row0(int pm) { return pm * BM; }
    static __host__ __device__ __forceinline__ int b_row0(int pn) { return pn * BM; }
    bf16_t* O; int ldc; const float* bias; int split_cols; size_t split_stride; float scale0;
    __device__ __forceinline__ void operator()(const f32x4 (&acc)[2][2][4][2], const Unit& u, int wr, int wc, int fr, int fq, int ui) const {
        const int row0 = u.pm * BM + wr * 64 + fr; int colt = u.pn * BM; bf16_t* base = O;
        float sc = 1.f; if (split_cols) { const int t = colt / split_cols; base += (size_t)t * split_stride; colt -= t * split_cols; if (t == 0) sc = scale0; }
        const int col0 = colt + wc * 32 + 8 * fq, bcol0 = u.pn * BM + wc * 32 + 8 * fq;
        f32x4 bv[2][2];
#pragma unroll
        for (int bj = 0; bj < 2; ++bj)
#pragma unroll
            for (int n = 0; n < 2; ++n) bv[bj][n] = bias ? *(const f32x4*)(bias + bcol0 + bj * HALF + 4 * n) : (f32x4){0.f, 0.f, 0.f, 0.f};
#pragma unroll
        for (int ai = 0; ai < 2; ++ai)
#pragma unroll
            for (int m = 0; m < 4; ++m) { bf16_t* rowp = base + (size_t)(row0 + ai * HALF + m * 16) * ldc + col0;
#pragma unroll
                for (int bj = 0; bj < 2; ++bj) { f32x4 v0 = acc[ai][bj][m][0] + bv[bj][0], v1 = acc[ai][bj][m][1] + bv[bj][1];
                    if (ACT == 1) { f32x2 a = gelu_pk((f32x2){v0[0], v0[1]}), b = gelu_pk((f32x2){v0[2], v0[3]}), c = gelu_pk((f32x2){v1[0], v1[1]}), d = gelu_pk((f32x2){v1[2], v1[3]});
                        v0 = (f32x4){a.x, a.y, b.x, b.y}; v1 = (f32x4){c.x, c.y, d.x, d.y}; }
                    v0 = v0 * sc; v1 = v1 * sc; u32x4 w; w.x = cvt_pk_bf16(v0[0], v0[1]); w.y = cvt_pk_bf16(v0[2], v0[3]); w.z = cvt_pk_bf16(v1[0], v1[1]); w.w = cvt_pk_bf16(v1[2], v1[3]);
                    *(u32x4*)(rowp + bj * HALF) = w; } }
    }
};
template <bool RB_IN, bool RB_OUT, bool WITH_SSQ> struct EpiRes {
    static constexpr bool PERM = true, AFTER_DRAIN = false, ACC_INIT = true;
    static __host__ __device__ __forceinline__ int a_row0(int pm) { return pm * BM; }
    static __host__ __device__ __forceinline__ int b_row0(int pn) { return pn * BM; }
    const void* base; void* out; int ldc; float* ssq;
    static __device__ __forceinline__ f32x4 up2(unsigned lo, unsigned hi) { return (f32x4){__builtin_bit_cast(float, lo << 16), __builtin_bit_cast(float, lo & 0xffff0000u), __builtin_bit_cast(float, hi << 16), __builtin_bit_cast(float, hi & 0xffff0000u)}; }
    __device__ __forceinline__ void init(f32x4 (&acc)[2][2][4][2], const Unit& u, int wr, int wc, int fr, int fq) const {
        const int row0 = u.pm * BM + wr * 64 + fr, col0 = u.pn * BM + wc * 32 + 8 * fq;
#pragma unroll
        for (int ai = 0; ai < 2; ++ai)
#pragma unroll
            for (int m = 0; m < 4; ++m) { const size_t ro = (size_t)(row0 + ai * HALF + m * 16) * ldc + col0;
#pragma unroll
                for (int bj = 0; bj < 2; ++bj) { const size_t o = ro + bj * HALF;
                    if constexpr (RB_IN) { const u32x4 w = *(const u32x4*)((const bf16_t*)base + o); acc[ai][bj][m][0] = up2(w.x, w.y); acc[ai][bj][m][1] = up2(w.z, w.w); }
                    else { acc[ai][bj][m][0] = *(const f32x4*)((const float*)base + o); acc[ai][bj][m][1] = *(const f32x4*)((const float*)base + o + 4); } } }
    }
    __device__ __forceinline__ void operator()(const f32x4 (&acc)[2][2][4][2], const Unit& u, int wr, int wc, int fr, int fq, int ui) const {
        const int row0 = u.pm * BM + wr * 64 + fr, col0 = u.pn * BM + wc * 32 + 8 * fq;
#pragma unroll
        for (int ai = 0; ai < 2; ++ai)
#pragma unroll
            for (int m = 0; m < 4; ++m) { const size_t ro = (size_t)(row0 + ai * HALF + m * 16) * ldc + col0; float q = 0.f;
#pragma unroll
                for (int bj = 0; bj < 2; ++bj) { const size_t o = ro + bj * HALF; const f32x4 v0 = acc[ai][bj][m][0], v1 = acc[ai][bj][m][1];
                    if constexpr (RB_OUT) { u32x4 w; w.x = cvt_pk_bf16(v0[0], v0[1]); w.y = cvt_pk_bf16(v0[2], v0[3]); w.z = cvt_pk_bf16(v1[0], v1[1]); w.w = cvt_pk_bf16(v1[2], v1[3]); *(u32x4*)((bf16_t*)out + o) = w; }
                    else { *(f32x4*)((float*)out + o) = v0; *(f32x4*)((float*)out + o + 4) = v1; }
                    if constexpr (WITH_SSQ) q += ((v0[0] * v0[0] + v0[1] * v0[1]) + (v0[2] * v0[2] + v0[3] * v0[3])) + ((v1[0] * v1[0] + v1[1] * v1[1]) + (v1[2] * v1[2] + v1[3] * v1[3])); }
                if constexpr (WITH_SSQ) { q += __shfl_xor(q, 16); q += __shfl_xor(q, 32); if (fq == 0) ssq[(size_t)(row0 + ai * HALF + m * 16) * 32 + 4 * u.pn + wc] = q; } }
    }
};
struct EpiQKV {
    static constexpr bool PERM = true, AFTER_DRAIN = false, ACC_INIT = false;
    static __host__ __device__ __forceinline__ int a_row0(int pm) { return pm * BM; }
    static __host__ __device__ __forceinline__ int b_row0(int pn) { return pn * BM; }
    bf16_t* O; int ldc; const float* qg; const float* kg; PG8_LAS float* part; float qscale;
    __device__ __forceinline__ void operator()(const f32x4 (&acc)[2][2][4][2], const Unit& u, int wr, int wc, int fr, int fq, int ui) const {
        const int kind = u.pn >> 3;
        const int row0 = u.pm * BM + wr * 64 + fr, col0 = u.pn * BM + wc * 32 + 8 * fq;
        if (kind < 2) {
#pragma unroll
            for (int ai = 0; ai < 2; ++ai)
#pragma unroll
                for (int m = 0; m < 4; ++m)
#pragma unroll
                    for (int bj = 0; bj < 2; ++bj) { const f32x4 a = acc[ai][bj][m][0], b = acc[ai][bj][m][1];
                        float q = ((a[0] * a[0] + a[1] * a[1]) + (a[2] * a[2] + a[3] * a[3])) + ((b[0] * b[0] + b[1] * b[1]) + (b[2] * b[2] + b[3] * b[3]));
                        q += __shfl_xor(q, 16); q += __shfl_xor(q, 32);
                        if (fq == 0) part[((ai * HALF + wr * 64 + m * 16 + fr) * 2 + bj) * 4 + wc] = q; }
        }
        asm volatile("s_waitcnt lgkmcnt(0)" ::: "memory"); __builtin_amdgcn_s_barrier(); asm volatile("" ::: "memory");
        f32x4 g0 = (f32x4){1.f, 1.f, 1.f, 1.f}, g1 = g0;
        if (kind < 2) { const float* gp = (kind == 0 ? qg : kg) + wc * 32 + 8 * fq; g0 = *(const f32x4*)gp; g1 = *(const f32x4*)(gp + 4); }
        const float sc = (kind == 0) ? qscale : 1.f;
#pragma unroll
        for (int ai = 0; ai < 2; ++ai)
#pragma unroll
            for (int m = 0; m < 4; ++m) { bf16_t* rowp = O + (size_t)(row0 + ai * HALF + m * 16) * ldc + col0;
#pragma unroll
                for (int bj = 0; bj < 2; ++bj) { float rs = 1.f;
                    if (kind < 2) { const f32x4 pp = *(const PG8_LAS f32x4*)(part + ((ai * HALF + wr * 64 + m * 16 + fr) * 2 + bj) * 4); rs = sc * __builtin_amdgcn_rsqf(((pp[0] + pp[1]) + (pp[2] + pp[3])) * (1.f / 128.f) + 1e-6f); }
                    const f32x4 v0 = acc[ai][bj][m][0] * g0 * rs, v1 = acc[ai][bj][m][1] * g1 * rs;
                    u32x4 w; w.x = cvt_pk_bf16(v0[0], v0[1]); w.y = cvt_pk_bf16(v0[2], v0[3]); w.z = cvt_pk_bf16(v1[0], v1[1]); w.w = cvt_pk_bf16(v1[2], v1[3]);
                    *(u32x4*)(rowp + bj * HALF) = w; } }
    }
};
__device__ __forceinline__ float dpp_ror1(float v) { return __builtin_bit_cast(float, __builtin_amdgcn_mov_dpp(__builtin_bit_cast(int, v), 0x121, 0xf, 0xf, true)); }
__device__ __forceinline__ float dpp_ror2(float v) { return __builtin_bit_cast(float, __builtin_amdgcn_mov_dpp(__builtin_bit_cast(int, v), 0x122, 0xf, 0xf, true)); }
struct EpiConvGate {
    static constexpr bool PERM = true, AFTER_DRAIN = false, ACC_INIT = false;
    static constexpr int TPS = 17, TSTRIDE = 241, SEQL = 4096, FF = 5632;
    static __host__ __device__ __forceinline__ int a_row0(int pm) { return (pm / TPS) * SEQL + (pm % TPS) * TSTRIDE - 2; }
    static __host__ __device__ __forceinline__ int b_row0(int pn) { return pn * BM; }
    bf16_t* G; const float* cw; const float* cb; PG8_LAS float* tails; const float* ssq;
    __device__ __forceinline__ void operator()(const f32x4 (&acc)[2][2][4][2], const Unit& u, int wr, int wc, int fr, int fq, int ui) const {
        const int wid = wr * 4 + wc, seq = u.pm / TPS, tbase = (u.pm % TPS) * TSTRIDE - 2;
        const int ch0 = 128 * u.pn + 32 * wc + 8 * fq;
        if (fr >= 14) {
#pragma unroll
            for (int ai = 0; ai < 2; ++ai)
#pragma unroll
                for (int bj = 0; bj < 2; ++bj)
#pragma unroll
                    for (int n = 0; n < 2; ++n) *(PG8_LAS f32x4*)(tails + (((wid * 2 + ai) * 2 + (fr - 14)) * 2 + bj) * 32 + fq * 8 + n * 4) = acc[ai][bj][3][n];
        }
        const PG8_LAS float* rsl = tails + 2048 + 256 * ui;
        PG8_LAS float* coef = tails + 2048 + 12 * 256;
        { const int tid_ = threadIdx.x; if (tid_ < 256) { const int a_ = tid_ >> 5, c_ = tid_ & 31;
            const float* src = (a_ < 6 ? cw + (a_ >> 1) * 2 * FF : cb) + (a_ & 1) * FF + 128 * u.pn + 4 * c_;
            *(PG8_LAS f32x4*)(coef + a_ * 128 + 4 * c_) = *(const f32x4*)src; } }
        asm volatile("s_waitcnt lgkmcnt(0)" ::: "memory"); __builtin_amdgcn_s_barrier(); asm volatile("" ::: "memory");
        const bool is15 = (fr == 15), ge14 = (fr >= 14);
#pragma unroll
        for (int ai = 0; ai < 2; ++ai) {
            const bool has_src = !(ai == 0 && wr == 0);
            const int swid = (wr ^ 1) * 4 + wc, sai = (wr == 1) ? ai : ai - 1;
#pragma unroll
            for (int n = 0; n < 2; ++n) {
                f32x4 gv[4];
#pragma unroll
                for (int bj = 0; bj < 2; ++bj) {
                    const PG8_LAS float* cfp = coef + bj * 128 + 32 * wc + 8 * fq + 4 * n;
                    const f32x4 w0 = *(const PG8_LAS f32x4*)cfp, w1 = *(const PG8_LAS f32x4*)(cfp + 256), w2 = *(const PG8_LAS f32x4*)(cfp + 512), bb = *(const PG8_LAS f32x4*)(cfp + 768);
                    f32x4 prev = (f32x4){0.f, 0.f, 0.f, 0.f};
                    if (ge14 && has_src) { prev = *(const PG8_LAS f32x4*)(tails + (((swid * 2 + sai) * 2 + (fr - 14)) * 2 + bj) * 32 + fq * 8 + n * 4);
                        if (ssq) prev = prev * rsl[128 * ai + 64 * wr - 16 + fr]; }
#pragma unroll
                    for (int m = 0; m < 4; ++m) {
                        f32x4 cur = acc[ai][bj][m][n]; if (ssq) cur = cur * rsl[128 * ai + 64 * wr + 16 * m + fr];
                        const int t = tbase + 128 * ai + 64 * wr + 16 * m + fr;
                        f32x4 cv;
#pragma unroll
                        for (int e = 0; e < 4; ++e) {
                            float p1 = dpp_ror1(is15 ? prev[e] : cur[e]), p2 = dpp_ror2(ge14 ? prev[e] : cur[e]);
                            if (ai == 0 && m == 0) { p1 = (t >= 1) ? p1 : 0.f; p2 = (t >= 2) ? p2 : 0.f; }
                            cv[e] = bb[e] + w0[e] * p2 + w1[e] * p1 + w2[e] * cur[e]; }
                        if (bj == 0) {
#pragma unroll
                            for (int e = 0; e < 4; ++e) gv[m][e] = cv[e] * __builtin_amdgcn_rcpf(1.f + __expf(-cv[e]));
                        } else { const f32x4 o = gv[m] * cv; const int rl = 128 * ai + 64 * wr + 16 * m + fr;
                            if (rl >= 2 && rl < 2 + TSTRIDE && t < SEQL) { typedef unsigned u32x2 __attribute__((ext_vector_type(2))); u32x2 w; w.x = cvt_pk_bf16(o[0], o[1]); w.y = cvt_pk_bf16(o[2], o[3]);
                                *(u32x2*)(G + (size_t)(seq * SEQL + t) * FF + ch0 + 4 * n) = w; } }
                        prev = cur;
                    }
                }
            }
        }
    }
};
struct EpiConvGateT {
    static constexpr bool PERM = true, AFTER_DRAIN = false, ACC_INIT = false;
    static constexpr int TPS = 17, TSTRIDE = 241, SEQL = 4096, FF = 5632;
    static __host__ __device__ __forceinline__ int a_row0(int pm) { return pm * BM; }
    static __host__ __device__ __forceinline__ int b_row0(int pn) { return (pn / TPS) * SEQL + (pn % TPS) * TSTRIDE - 2; }
    bf16_t* G; const float* cw; const float* cb; PG8_LAS float* xl;
    __device__ __forceinline__ void operator()(f32x4 (&acc)[2][2][4][2], const Unit& u, int wr, int wc, int fr, int fq, int ui) const {
        const int wid = wr * 4 + wc, lane = fq * 16 + fr, seq = u.pn / TPS, tbase = (u.pn % TPS) * TSTRIDE - 2;
        PG8_LAS unsigned* tails = (PG8_LAS unsigned*)xl; PG8_LAS unsigned short* ob = (PG8_LAS unsigned short*)(xl + 2048) + wid * 512; PG8_LAS float* coef = xl + 4096; const PG8_LAS float* rsl = xl + 5120 + 256 * ui;
#pragma unroll
        for (int bj = 0; bj < 2; ++bj) { const f32x4 r0 = *(const PG8_LAS f32x4*)(rsl + 128 * bj + 32 * wc + 8 * fq), r1 = *(const PG8_LAS f32x4*)(rsl + 128 * bj + 32 * wc + 8 * fq + 4);
#pragma unroll
            for (int ai = 0; ai < 2; ++ai)
#pragma unroll
                for (int m = 0; m < 4; ++m) { acc[ai][bj][m][0] = acc[ai][bj][m][0] * r0; acc[ai][bj][m][1] = acc[ai][bj][m][1] * r1; } }
        if (fq == 3) {
#pragma unroll
            for (int bj = 0; bj < 2; ++bj)
#pragma unroll
                for (int ai = 0; ai < 2; ++ai)
#pragma unroll
                    for (int m = 0; m < 4; ++m) tails[((wid * 2 + bj) * 8 + ai * 4 + m) * 16 + fr] = cvt_pk_bf16(acc[ai][bj][m][1][2], acc[ai][bj][m][1][3]);
        }
        { const int tid_ = threadIdx.x; if (tid_ < 256) { const int a_ = tid_ >> 5, c_ = tid_ & 31, up_ = a_ >> 2, j_ = a_ & 3;
            const float* src = (j_ < 3 ? cw + j_ * 2 * FF : cb) + up_ * FF + 128 * u.pm + 4 * c_;
            *(PG8_LAS f32x4*)(coef + a_ * 128 + 4 * c_) = *(const f32x4*)src; } }
        asm volatile("s_waitcnt lgkmcnt(0)" ::: "memory"); __builtin_amdgcn_s_barrier(); asm volatile("" ::: "memory");
#pragma unroll
        for (int bj = 0; bj < 2; ++bj) {
            const bool has_src = (wc > 0) || (bj == 1);
            const int swid = (wc > 0) ? wid - 1 : wr * 4 + 3, sbj = (wc > 0) ? bj : 0;
            const bool firstgrp = (tbase < 0) && (bj == 0) && (wc == 0) && (fq == 0);
#pragma unroll
            for (int mp = 0; mp < 2; ++mp) {
                unsigned pk[2][2][2];
#pragma unroll
                for (int mq = 0; mq < 2; ++mq) { const int m = 2 * mp + mq;
                    f32x2 cv[2][4];
#pragma unroll
                    for (int ai = 0; ai < 2; ++ai) {
                        f32x2 P[5];
#pragma unroll
                        for (int k = 0; k < 4; ++k) P[k + 1] = (f32x2){acc[ai][bj][m][k >> 1][2 * (k & 1)], acc[ai][bj][m][k >> 1][2 * (k & 1) + 1]};
                        float p6 = __shfl_up(P[4].x, 16), p7 = __shfl_up(P[4].y, 16);
                        if (fq == 0) { unsigned tv = 0u; if (has_src) tv = tails[((swid * 2 + sbj) * 8 + ai * 4 + m) * 16 + fr];
                            p6 = __builtin_bit_cast(float, tv << 16); p7 = __builtin_bit_cast(float, tv & 0xffff0000u); }
                        if (firstgrp) P[1] = (f32x2){0.f, 0.f};
                        P[0] = (f32x2){p6, p7};
                        const PG8_LAS float* cf = coef + ai * 512 + 64 * wr + 16 * m + fr; const float w0 = cf[0], w1 = cf[128], w2 = cf[256], bb = cf[384];
                        const f32x2 W0 = {w0, w0}, W1 = {w1, w1}, W2 = {w2, w2}, BB = {bb, bb};
#pragma unroll
                        for (int k = 0; k < 4; ++k) { const f32x2 Q = {P[k].y, P[k + 1].x};
                            cv[ai][k] = W2 * P[k + 1] + (W1 * Q + (W0 * P[k] + BB)); }
                    }
                    float o[8];
#pragma unroll
                    for (int k = 0; k < 4; ++k) { const f32x2 t = cv[0][k] * (f32x2){-1.4426950408889634f, -1.4426950408889634f};
                        const f32x2 d = (f32x2){__builtin_amdgcn_exp2f(t.x), __builtin_amdgcn_exp2f(t.y)} + (f32x2){1.f, 1.f};
                        const f32x2 r = {__builtin_amdgcn_rcpf(d.x), __builtin_amdgcn_rcpf(d.y)};
                        const f32x2 ov = cv[0][k] * r * cv[1][k]; o[2 * k] = ov.x; o[2 * k + 1] = ov.y; }
#pragma unroll
                    for (int n = 0; n < 2; ++n) { pk[mq][n][0] = cvt_pk_bf16(o[4 * n], o[4 * n + 1]); pk[mq][n][1] = cvt_pk_bf16(o[4 * n + 2], o[4 * n + 3]); }
                }
#pragma unroll
                for (int n = 0; n < 2; ++n) {
#pragma unroll
                    for (int mq = 0; mq < 2; ++mq) {
                        ob[(4 * fq + 0) * 32 + 16 * mq + fr] = (unsigned short)(pk[mq][n][0] & 0xffffu); ob[(4 * fq + 1) * 32 + 16 * mq + fr] = (unsigned short)(pk[mq][n][0] >> 16);
                        ob[(4 * fq + 2) * 32 + 16 * mq + fr] = (unsigned short)(pk[mq][n][1] & 0xffffu); ob[(4 * fq + 3) * 32 + 16 * mq + fr] = (unsigned short)(pk[mq][n][1] >> 16); }
                    asm volatile("s_waitcnt lgkmcnt(0)" ::: "memory");
                    { const int trow = lane >> 2, chunk = lane & 3; const u32x4 v = *(const PG8_LAS u32x4*)(ob + trow * 32 + chunk * 8);
                      const int tl = 128 * bj + 32 * wc + 8 * (trow >> 2) + 4 * n + (trow & 3), t = tbase + tl;
                      asm volatile("s_waitcnt lgkmcnt(0)" ::: "memory");
                      if (tl >= 2 && tl < 2 + TSTRIDE && t < SEQL) *(u32x4*)(G + (size_t)(seq * SEQL + t) * FF + 128 * u.pm + 64 * wr + 32 * mp + 8 * chunk) = v; }
                }
            }
        }
    }
};
template <class Epi, class Sched, bool ALIGN_EPI = false, bool SP2 = false>
__device__ __forceinline__ void gemm_phase(PG8_LAS unsigned char* lds, const Gemm g, const Sched& S, const Epi& E) {
    const int tid = threadIdx.x, wid = __builtin_amdgcn_readfirstlane(tid >> 6), lane = tid & 63, wr = wid >> 2, wc = wid & 3, fr = lane & 15, fq = lane >> 4;
    const int K = g.K, nt = K / BK;
    unsigned voffA[2], voffB[2];
#pragma unroll
    for (int i = 0; i < 2; ++i) { int R, C; stage_rc(tid * 16 + i * 8192, R, C); const int Rb = Epi::PERM ? ((R & ~31) + perm32(R & 31)) : R;
        voffA[i] = (unsigned)(R * K + C) * 2u; voffB[i] = (unsigned)(Rb * K + C) * 2u; }
    const size_t kstep = (size_t)(BK * 2);
    const size_t hstep = (size_t)HALF * K * 2;
    const size_t tstep = 2 * hstep;
    const unsigned ldsw = (unsigned)wid * 1024u;
    const int aoff = lds_byte(wr * 64 + fr, fq * 8), boff = lds_byte(wc * 32 + fr, fq * 8);
#define PG8_SA(b, h) (((b) * 2 + (h)) * HTB)
#define PG8_SB(b, h) ((4 + (b) * 2 + (h)) * HTB)
#define PG8_STAGE(bufoff, gbase, voff) do { _Pragma("unroll") for (int _i = 0; _i < 2; ++_i) \
        __builtin_amdgcn_global_load_lds((const unsigned*)((const char*)(gbase) + (voff)[_i]), (PG8_LAS unsigned*)(lds + (bufoff) + ldsw + _i * 8192), 16, 0, 0); } while (0)
#define PG8_LDA(dst, b, h) do { _Pragma("unroll") for (int m = 0; m < 4; ++m) _Pragma("unroll") for (int k = 0; k < 2; ++k) dst[m][k] = *(const PG8_LAS bf16x8*)(lds + PG8_SA(b, h) + aoff + m * 2048 + k * 1024); } while (0)
#define PG8_LDB(dst, b, h) do { _Pragma("unroll") for (int n = 0; n < 2; ++n) _Pragma("unroll") for (int k = 0; k < 2; ++k) dst[n][k] = *(const PG8_LAS bf16x8*)(lds + PG8_SB(b, h) + boff + n * 2048 + k * 1024); } while (0)
#define PG8_MMA(ai, bj, At, Bt) do { __builtin_amdgcn_s_setprio(1); _Pragma("unroll") for (int m = 0; m < 4; ++m) _Pragma("unroll") for (int n = 0; n < 2; ++n) _Pragma("unroll") for (int k = 0; k < 2; ++k) \
        acc[ai][bj][m][n] = __builtin_amdgcn_mfma_f32_16x16x32_bf16(Bt[n][k], At[m][k], acc[ai][bj][m][n], 0, 0, 0); __builtin_amdgcn_s_setprio(0); } while (0)
#define PG8_WAIT_V(n) asm volatile("s_waitcnt vmcnt(" #n ")" ::: "memory")
#define PG8_WAIT_L(n) asm volatile("s_waitcnt lgkmcnt(" #n ")" ::: "memory")
#define PG8_BAR __builtin_amdgcn_s_barrier()
#define PG8_SCHED __builtin_amdgcn_sched_barrier(0)
    Unit cur, nxt; int ui = 0;
    if (!S.next(0, cur)) return;
    f32x4 acc[2][2][4][2];
    if constexpr (Epi::ACC_INIT) E.init(acc, cur, wr, wc, fr, fq); else {
#pragma unroll
    for (int a = 0; a < 2; ++a)
#pragma unroll
        for (int b = 0; b < 2; ++b)
#pragma unroll
            for (int m = 0; m < 4; ++m)
#pragma unroll
                for (int n = 0; n < 2; ++n) acc[a][b][m][n] = (f32x4){0.f, 0.f, 0.f, 0.f}; }
    bf16x8 At[4][2], B0[2][2], B1[2][2];
    const char* cA = (const char*)g.A + (long)Epi::a_row0(cur.pm) * (long)(K * 2); const char* cB = (const char*)g.Bt + (long)Epi::b_row0(cur.pn) * (long)(K * 2);
    S.a_ready(cur);
    if constexpr (SP2) {
        PG8_STAGE(PG8_SB(0, 0), cB, voffB); PG8_STAGE(PG8_SB(0, 1), cB + hstep, voffB); PG8_STAGE(PG8_SA(0, 0), cA, voffA); PG8_STAGE(PG8_SA(0, 1), cA + hstep, voffA);
        if (wr == 1) PG8_BAR;
        PG8_WAIT_V(2); PG8_BAR;
        PG8_STAGE(PG8_SB(1, 0), cB + kstep, voffB); PG8_STAGE(PG8_SA(1, 0), cA + kstep, voffA); PG8_STAGE(PG8_SB(1, 1), cB + hstep + kstep, voffB);
        PG8_WAIT_V(6); PG8_BAR;
    } else {
        PG8_STAGE(PG8_SB(0, 0), cB, voffB); PG8_STAGE(PG8_SA(0, 0), cA, voffA); PG8_STAGE(PG8_SB(0, 1), cB + hstep, voffB); PG8_STAGE(PG8_SA(0, 1), cA + hstep, voffA);
        if (wr == 1) PG8_BAR;
        PG8_WAIT_V(4); PG8_BAR;
        PG8_STAGE(PG8_SB(1, 0), cB + kstep, voffB); PG8_STAGE(PG8_SA(1, 0), cA + kstep, voffA); PG8_STAGE(PG8_SB(1, 1), cB + hstep + kstep, voffB);
        PG8_WAIT_V(6); PG8_BAR;
    }
    for (;;) {
        const bool has_next = S.next(ui + 1, nxt);
        const char* nA = has_next ? (const char*)g.A + (long)Epi::a_row0(nxt.pm) * (long)(K * 2) : cA; const char* nB = has_next ? (const char*)g.Bt + (long)Epi::b_row0(nxt.pn) * (long)(K * 2) : cB;
        for (int t = 0; t < nt; t += 2) {
            const bool last = (t == nt - 2);
            const char* a1 = cA + (size_t)(t + 1) * kstep;
            const char* a2 = last ? nA : cA + (size_t)(t + 2) * kstep; const char* b2 = last ? nB : cB + (size_t)(t + 2) * kstep;
            const char* a3 = a2 + kstep; const char* b3 = b2 + kstep;
            if (last && has_next) S.a_ready(nxt);
            if constexpr (SP2) {
            PG8_LDB(B0, 0, 0); PG8_LDB(B1, 0, 1); PG8_SCHED; PG8_LDA(At, 0, 0); PG8_STAGE(PG8_SA(1, 1), a1 + hstep, voffA);
            PG8_WAIT_V(8); PG8_WAIT_L(0); PG8_BAR; PG8_MMA(0, 0, At, B0); PG8_MMA(0, 1, At, B1); PG8_BAR; PG8_SCHED;
            PG8_LDA(At, 0, 1); PG8_STAGE(PG8_SB(0, 0), b2, voffB); PG8_STAGE(PG8_SB(0, 1), b2 + hstep, voffB); PG8_STAGE(PG8_SA(0, 0), a2, voffA);
            PG8_WAIT_V(8); PG8_WAIT_L(0); PG8_BAR; PG8_MMA(1, 0, At, B0); PG8_MMA(1, 1, At, B1); PG8_BAR; PG8_SCHED;
            PG8_LDB(B0, 1, 0); PG8_LDB(B1, 1, 1); PG8_SCHED; PG8_LDA(At, 1, 0); PG8_STAGE(PG8_SA(0, 1), a2 + hstep, voffA);
            PG8_WAIT_V(8); PG8_WAIT_L(0); PG8_BAR; PG8_MMA(0, 0, At, B0); PG8_MMA(0, 1, At, B1); PG8_BAR; PG8_SCHED;
            PG8_LDA(At, 1, 1); PG8_STAGE(PG8_SB(1, 0), b3, voffB); PG8_STAGE(PG8_SB(1, 1), b3 + hstep, voffB); PG8_STAGE(PG8_SA(1, 0), a3, voffA);
            PG8_WAIT_V(8); PG8_WAIT_L(0); PG8_BAR; PG8_MMA(1, 0, At, B0); PG8_MMA(1, 1, At, B1); PG8_BAR; PG8_SCHED;
            } else {
            PG8_LDB(B0, 0, 0); PG8_SCHED; PG8_LDA(At, 0, 0); PG8_STAGE(PG8_SA(1, 1), a1 + hstep, voffA);
            PG8_WAIT_L(8); PG8_BAR; PG8_WAIT_L(0); PG8_MMA(0, 0, At, B0); PG8_BAR; PG8_SCHED;
            PG8_LDB(B1, 0, 1); PG8_STAGE(PG8_SB(0, 0), b2, voffB);
            PG8_BAR; PG8_WAIT_L(0); PG8_MMA(0, 1, At, B1); PG8_BAR;
            PG8_LDA(At, 0, 1); PG8_STAGE(PG8_SA(0, 0), a2, voffA);
            PG8_BAR; PG8_WAIT_L(0); PG8_MMA(1, 0, At, B0); PG8_BAR; PG8_SCHED;
            PG8_STAGE(PG8_SB(0, 1), b2 + hstep, voffB);
            PG8_WAIT_V(6); PG8_BAR; PG8_MMA(1, 1, At, B1); PG8_BAR;
            PG8_LDB(B0, 1, 0); PG8_SCHED; PG8_LDA(At, 1, 0); PG8_STAGE(PG8_SA(0, 1), a2 + hstep, voffA);
            PG8_WAIT_L(8); PG8_BAR; PG8_WAIT_L(0); PG8_MMA(0, 0, At, B0); PG8_BAR; PG8_SCHED;
            PG8_LDB(B1, 1, 1); PG8_STAGE(PG8_SB(1, 0), b3, voffB);
            PG8_BAR; PG8_WAIT_L(0); PG8_MMA(0, 1, At, B1); PG8_BAR;
            PG8_LDA(At, 1, 1); PG8_STAGE(PG8_SA(1, 0), a3, voffA);
            PG8_BAR; PG8_WAIT_L(0); PG8_MMA(1, 0, At, B0); PG8_BAR; PG8_SCHED;
            PG8_STAGE(PG8_SB(1, 1), b3 + hstep, voffB);
            PG8_WAIT_V(6); PG8_BAR; PG8_MMA(1, 1, At, B1); PG8_BAR;
            }
        }
        if constexpr (ALIGN_EPI) { if (wr == 0) PG8_BAR; }
        if constexpr (!Epi::AFTER_DRAIN) { E(acc, cur, wr, wc, fr, fq, ui); S.done(cur); }
        if (!has_next) break;
        if constexpr (Epi::ACC_INIT) E.init(acc, nxt, wr, wc, fr, fq); else {
#pragma unroll
        for (int a = 0; a < 2; ++a)
#pragma unroll
            for (int b = 0; b < 2; ++b)
#pragma unroll
                for (int m = 0; m < 4; ++m)
#pragma unroll
                    for (int n = 0; n < 2; ++n) acc[a][b][m][n] = (f32x4){0.f, 0.f, 0.f, 0.f}; }
        cur = nxt; cA = nA; cB = nB; ++ui;
        if constexpr (ALIGN_EPI) { if (wr == 1) PG8_BAR; }
    }
    PG8_WAIT_V(0);
    if constexpr (!ALIGN_EPI) { if (wr == 0) PG8_BAR; }
    PG8_BAR;
    if constexpr (Epi::AFTER_DRAIN) { E.fused(acc, cur, wr, wc, fr, fq, lds, wid, lane); S.done(cur); }
#undef PG8_SA
#undef PG8_SB
#undef PG8_STAGE
#undef PG8_LDA
#undef PG8_LDB
#undef PG8_MMA
#undef PG8_WAIT_V
#undef PG8_WAIT_L
#undef PG8_BAR
#undef PG8_SCHED
}
}

constexpr int BATCH = 2, SEQ = 4096, DM = 2048, MROWS = BATCH * SEQ;
constexpr int AH = 16, AHD = 128, NQKV = 3 * DM;
constexpr int LH = 4, LDV = 512, LDK = 256, QKW = 1024, INW = 6152, INW_MAIN = 6144;
constexpr int FFN = 5632, FFN2 = 2 * FFN;
constexpr float NORM_EPS = 1e-6f;

typedef unsigned short bf16;
typedef unsigned v4u __attribute__((ext_vector_type(4)));
typedef unsigned v2u __attribute__((ext_vector_type(2)));
typedef float f32x4 __attribute__((ext_vector_type(4)));
typedef float f32x2 __attribute__((ext_vector_type(2)));
#define LAS __attribute__((address_space(3)))

__device__ __forceinline__ unsigned f2bf(float f) { unsigned u = __builtin_bit_cast(unsigned, f); return (u + 0x7fffu + ((u >> 16) & 1u)) >> 16; }
__device__ __forceinline__ unsigned pk2(float lo, float hi) { unsigned r; asm("v_cvt_pk_bf16_f32 %0, %1, %2" : "=v"(r) : "v"(lo), "v"(hi)); return r; }
template <int N> __device__ __forceinline__ float dpp_ror(float v) { return __builtin_bit_cast(float, __builtin_amdgcn_mov_dpp(__builtin_bit_cast(int, v), 0x120 + N, 0xf, 0xf, true)); }
__device__ __forceinline__ float row16_sum(float v) { v += dpp_ror<1>(v); v += dpp_ror<2>(v); v += dpp_ror<4>(v); v += dpp_ror<8>(v); return v; }
__device__ __forceinline__ float bf2f(unsigned short b) { return __builtin_bit_cast(float, (unsigned)b << 16); }
__device__ __forceinline__ float bflo(unsigned w) { return __builtin_bit_cast(float, w << 16); }
__device__ __forceinline__ float bfhi(unsigned w) { return __builtin_bit_cast(float, w & 0xffff0000u); }
__device__ __forceinline__ float wave_sum(float v) {
#pragma unroll
    for (int o = 1; o < 64; o <<= 1) v += __shfl_xor(v, o);
    return v;
}
__device__ __forceinline__ float sigmoidf_(float x) { return __builtin_amdgcn_rcpf(1.f + __expf(-x)); }
__device__ __forceinline__ float siluf_(float x) { return x * __builtin_amdgcn_rcpf(1.f + __expf(-x)); }

constexpr size_t MiB = 1u << 20;
constexpr size_t WS_CTL = 0;
constexpr size_t WS_WQKV = 1 * MiB;
constexpr size_t WS_WO   = WS_WQKV + (size_t)NQKV * DM * 2;
constexpr size_t WS_WIN  = WS_WO + (size_t)DM * DM * 2;
constexpr size_t WS_WOUT = WS_WIN + (size_t)INW_MAIN * DM * 2;
constexpr size_t WS_WUP  = WS_WOUT + (size_t)DM * DM * 2;
constexpr size_t WS_WDN  = WS_WUP + 2 * (size_t)FFN2 * DM * 2;
constexpr size_t WS_HN   = WS_WDN + 2 * (size_t)DM * FFN * 2;
constexpr size_t WS_G    = WS_HN + (size_t)MROWS * DM * 2;
constexpr size_t WS_R    = WS_G + (size_t)MROWS * FFN * 2;
constexpr size_t WS_QKV  = WS_R;
constexpr size_t WS_O    = WS_QKV + (size_t)MROWS * NQKV * 2;
constexpr size_t WS_QKC  = WS_O + (size_t)MROWS * DM * 2;
constexpr size_t WS_HS   = WS_QKC + (size_t)MROWS * DM * 2;
constexpr size_t WS_U    = WS_R;
constexpr size_t WS_REND = WS_HS + (size_t)MROWS * DM * 4;
static_assert(WS_U + (size_t)MROWS * FFN2 * 2 <= WS_REND, "U overlay");
constexpr size_t WS_GATES = WS_REND;
constexpr size_t WS_SU   = WS_GATES + (size_t)MROWS * 8 * 4;
constexpr size_t WS_SM   = WS_SU + 8 * SEQ * 4;
constexpr size_t WS_SE   = WS_SM + 8 * SEQ * 4;
constexpr size_t WS_NST  = WS_SE + 8 * SEQ * 4;
constexpr size_t WS_CST  = WS_NST + 8 * 64 * 256 * 4;
constexpr size_t WS_SSQ  = WS_CST + (size_t)8 * 64 * 17 * 16384;
constexpr size_t WS_GWT  = WS_SSQ + (size_t)MROWS * 32 * 4;
constexpr size_t WS_XR   = WS_HS;
constexpr size_t WS_END  = WS_GWT + (size_t)DM * 8 * 4;
static_assert(WS_END <= 738000000, "workspace");

__device__ __forceinline__ void transpose_load(const float* W, int ldn, int nblk, int item, int lane, f32x4 (&v)[8]) {
    const int kb = item / nblk, nb = item % nblk, k0 = 64 * kb, n0 = 32 * nb;
#pragma unroll
    for (int i = 0; i < 8; ++i) v[i] = *(const f32x4*)(W + (size_t)(k0 + 8 * i + (lane >> 3)) * ldn + n0 + 4 * (lane & 7));
}
__device__ __forceinline__ void transpose_store(const f32x4 (&v)[8], int K, int nblk, bf16* WT, LAS float* scr, int item, int lane, bool gate_perm, const LAS float* kgain) {
    const int kb = item / nblk, nb = item % nblk, k0 = 64 * kb, n0 = 32 * nb;
    const int r0 = !gate_perm ? n0 : (n0 < FFN ? (n0 / 128) * 256 + (n0 % 128) : ((n0 - FFN) / 128) * 256 + 128 + ((n0 - FFN) % 128));
#pragma unroll
    for (int i = 0; i < 8; ++i) { LAS float* d = scr + (8 * i + (lane >> 3)) * 33 + 4 * (lane & 7); d[0] = v[i][0]; d[1] = v[i][1]; d[2] = v[i][2]; d[3] = v[i][3]; }
    asm volatile("s_waitcnt lgkmcnt(0)" ::: "memory");
    const int c = lane & 7;
    f32x4 ga = (f32x4){1.f, 1.f, 1.f, 1.f}, gb = ga;
    if (kgain) { ga = *(const LAS f32x4*)(kgain + k0 + 8 * c); gb = *(const LAS f32x4*)(kgain + k0 + 8 * c + 4); }
#pragma unroll
    for (int j = 0; j < 4; ++j) { const int n = (lane >> 3) + 8 * j; const LAS float* s = scr + (8 * c) * 33 + n;
        v4u o; o.x = pk2(s[0 * 33] * ga[0], s[1 * 33] * ga[1]); o.y = pk2(s[2 * 33] * ga[2], s[3 * 33] * ga[3]); o.z = pk2(s[4 * 33] * gb[0], s[5 * 33] * gb[1]); o.w = pk2(s[6 * 33] * gb[2], s[7 * 33] * gb[3]);
        *(v4u*)(WT + (size_t)(r0 + n) * K + k0 + 8 * c) = o; }
    asm volatile("s_waitcnt lgkmcnt(0)" ::: "memory");
}

#define XB_TMO      128
#define XB_XCNT(j)  (256  + 64 * (j))
#define XB_XSUB(j)  (1280 + 64 * (j))
#define XB_XGEN(j)  (2304 + 64 * (j))
#define XB_TOP      3328
#define XB_TOPGEN   3392
#define XCD_BAR_WORDS 3456
#define XB_SPIN_CAP (1u << 18)

__device__ __forceinline__ unsigned xb_ld(unsigned* p)              { return __hip_atomic_load(p, __ATOMIC_RELAXED, __HIP_MEMORY_SCOPE_AGENT); }
__device__ __forceinline__ unsigned xb_add(unsigned* p, unsigned v) { return __hip_atomic_fetch_add(p, v, __ATOMIC_RELAXED, __HIP_MEMORY_SCOPE_AGENT); }
__device__ __forceinline__ unsigned xb_xcc_id() { return (unsigned)__builtin_amdgcn_s_getreg((3 << 11) | 20) & 0xFu; }
#define XB_SPIN(cond, bar) do { unsigned _sp = 0; while (cond) { __builtin_amdgcn_s_sleep(1); \
    if ((++_sp & 255u) == 0u) { if (xb_ld(&(bar)[XB_TMO])) break; if (_sp > XB_SPIN_CAP) { atomicAdd(&(bar)[XB_TMO], 1u); break; } } } } while (0)

struct XcdBarrier {
    unsigned* bar; unsigned x;
    volatile LAS unsigned* st;
};

__device__ __forceinline__ XcdBarrier xcd_barrier_post(unsigned* bar, volatile LAS unsigned* st) {
    XcdBarrier b; b.bar = bar; b.x = xb_xcc_id(); b.st = st;
    if (threadIdx.x == 0) (void)xb_add(&bar[XB_XCNT(b.x)], 1u);
    return b;
}
__device__ __forceinline__ void xcd_barrier_complete(unsigned* bar, unsigned x, unsigned& nloc, unsigned& nx) {
    const unsigned G = gridDim.x * gridDim.y * gridDim.z;
    unsigned sum, cnt, mine, sp = 0u;
    for (;;) {
        sum = 0u; cnt = 0u; mine = 0u;
#pragma unroll
        for (unsigned j = 0; j < 16; ++j) { const unsigned c = xb_ld(&bar[XB_XCNT(j)]); sum += c; cnt += (c > 0u) ? 1u : 0u; mine = (j == x) ? c : mine; }
        if (sum == G) break;
        __builtin_amdgcn_s_sleep(1);
        if ((++sp & 255u) == 0u) { if (xb_ld(&bar[XB_TMO])) break; if (sp > XB_SPIN_CAP) { atomicAdd(&bar[XB_TMO], 1u); break; } }
    }
    nloc = mine > 0u ? mine : 1u; nx = cnt > 0u ? cnt : 1u;
}

__device__ __forceinline__ void xcd_barrier(const XcdBarrier& b) {
    asm volatile("s_waitcnt vmcnt(0)" ::: "memory");
    __syncthreads();
    if (threadIdx.x == 0) {
        unsigned* bar = b.bar;
        __builtin_amdgcn_s_waitcnt(0);
        unsigned nloc = b.st[0], nx = b.st[1];
        if (nloc == 0u) { xcd_barrier_complete(bar, b.x, nloc, nx); b.st[0] = nloc; b.st[1] = nx; }
        const unsigned old = xb_add(&bar[XB_XSUB(b.x)], 1u);
        const unsigned gen = old / nloc;
        if (old + 1u == (gen + 1u) * nloc) {
            __builtin_amdgcn_fence(__ATOMIC_RELEASE, "agent");
            asm volatile("s_waitcnt vmcnt(0)" ::: "memory");
            const unsigned og = xb_add(&bar[XB_TOP], 1u);
            const unsigned tg = og / nx;
            if (og + 1u == (tg + 1u) * nx) xb_add(&bar[XB_TOPGEN], 1u);
            else XB_SPIN(xb_ld(&bar[XB_TOPGEN]) == tg, bar);
            __builtin_amdgcn_fence(__ATOMIC_ACQUIRE, "agent");
            xb_add(&bar[XB_XGEN(b.x)], 1u);
            asm volatile("s_waitcnt vmcnt(0)" ::: "memory");
        } else {
            XB_SPIN(xb_ld(&bar[XB_XGEN(b.x)]) == gen, bar);
            __builtin_amdgcn_fence(__ATOMIC_ACQUIRE, "agent");
            asm volatile("s_waitcnt vmcnt(0)" ::: "memory");
        }
    }
    __syncthreads();
}


constexpr int NWAVES = 8, NTHREADS = 512;
constexpr int RING_BYTES = 131072;
constexpr int MISC_OFF = 163840 - 256;
constexpr int LDS_BYTES = 163840;
constexpr int CW_BAR = 4096;
constexpr size_t CTL_ZERO_BYTES = 64 * 1024;

struct Args { const float* in[18]; float* out; unsigned char* ws; int ph_lo, ph_hi; };

struct Frame {
    LAS unsigned char* lds; int tid, lane, wave, vcu, G;
};

__device__ __forceinline__ void p_convert(const Frame& F, const float* W, bf16* WT, int K, int ldn, int N, bool gate_perm = false, int rank0 = 0, int nranks = 0, const float* kgain = nullptr) {
    LAS float* scr = (LAS float*)(F.lds + F.wave * 16384);
    if (nranks == 0) nranks = F.G;
    if (F.vcu < rank0 || F.vcu >= rank0 + nranks) return;
    const int gw = (F.vcu - rank0) * NWAVES + F.wave, NGW = nranks * NWAVES;
    const int nblk = N / 32, items = (K / 64) * nblk;
    const LAS float* kgl = nullptr;
    if (kgain) { LAS float* gl = (LAS float*)(F.lds + NWAVES * 16384); __syncthreads();
        for (int i = F.tid; i < K / 4; i += NTHREADS) *(LAS f32x4*)(gl + 4 * i) = *(const f32x4*)(kgain + 4 * i);
        __syncthreads(); kgl = gl; }
    f32x4 cur[8], nxt[8];
    if (gw < items) transpose_load(W, ldn, nblk, gw, F.lane, nxt);
    for (int it = gw; it < items; it += NGW) {
#pragma unroll
        for (int i = 0; i < 8; ++i) cur[i] = nxt[i];
        if (it + NGW < items) transpose_load(W, ldn, nblk, it + NGW, F.lane, nxt);
        transpose_store(cur, K, nblk, WT, scr, it, F.lane, gate_perm, kgl);
    }
}

__device__ __forceinline__ void p_pack_gates(const Frame& F, const float* w_in, float* gwt) {
    for (int id = F.vcu * NTHREADS + F.tid; id < DM * 2; id += F.G * NTHREADS) { const int k = id >> 1, hf = id & 1; *(f32x4*)(gwt + k * 8 + hf * 4) = *(const f32x4*)(w_in + (size_t)k * INW + INW_MAIN + hf * 4); }
}
template <bool XBF> __device__ __forceinline__ int nrm_idx(int q, int lane) { return XBF ? 2 * (64 * (q >> 1) + lane) + (q & 1) : 64 * q + lane; }
template <bool XBF> __device__ __forceinline__ f32x4 nrm_ld(const void* x, size_t row, int q, int lane) {
    if constexpr (XBF) { const v2u w = ((const v2u*)((const bf16*)x + row * DM))[nrm_idx<XBF>(q, lane)]; return (f32x4){bflo(w.x), bfhi(w.x), bflo(w.y), bfhi(w.y)}; }
    else return ((const f32x4*)((const float*)x + row * DM))[nrm_idx<XBF>(q, lane)];
}
template <bool XBF> __device__ __forceinline__ void p_rmsnorm(const Frame& F, const void* x, const float* g, bf16* hn, const float* w_in, const float* gate_bias, float* gates) {
    const int gw = F.vcu * NWAVES + F.wave, NGW = F.G * NWAVES, lane = F.lane;
    LAS float* gwl = (LAS float*)F.lds;
    if (w_in) { __syncthreads();
#pragma unroll
        for (int i = 0; i < 8; ++i) { const int id = F.tid + NTHREADS * i, k = id >> 1; *(LAS f32x4*)(gwl + (k >> 3) * 68 + (k & 7) * 8 + (id & 1) * 4) = *(const f32x4*)(w_in + id * 4); }
        __syncthreads(); }
    f32x4 gg[8], nx[8];
#pragma unroll
    for (int j = 0; j < 8; ++j) gg[j] = ((const f32x4*)g)[nrm_idx<XBF>(j, lane)];
    if (gw < MROWS) {
#pragma unroll
        for (int j = 0; j < 8; ++j) nx[j] = nrm_ld<XBF>(x, (size_t)gw, j, lane); }
    for (int row = gw; row < MROWS; row += NGW) {
        f32x4 v[8]; float s = 0.f;
#pragma unroll
        for (int j = 0; j < 8; ++j) { v[j] = nx[j]; s += (v[j].x * v[j].x + v[j].y * v[j].y) + (v[j].z * v[j].z + v[j].w * v[j].w); }
        if (row + NGW < MROWS) {
#pragma unroll
            for (int j = 0; j < 8; ++j) nx[j] = nrm_ld<XBF>(x, (size_t)(row + NGW), j, lane); }
        const float rstd = 1.f / sqrtf(wave_sum(s) * (1.f / DM) + NORM_EPS);
#pragma unroll
        for (int j = 0; j < 8; ++j) v[j] = v[j] * rstd * gg[j];
        if constexpr (XBF) { v4u* o16 = (v4u*)(hn + (size_t)row * DM) + lane;
#pragma unroll
            for (int jj = 0; jj < 4; ++jj) { v4u w; w.x = pk2(v[2 * jj].x, v[2 * jj].y); w.y = pk2(v[2 * jj].z, v[2 * jj].w); w.z = pk2(v[2 * jj + 1].x, v[2 * jj + 1].y); w.w = pk2(v[2 * jj + 1].z, v[2 * jj + 1].w); o16[64 * jj] = w; } }
        else {
            const bool odd = lane & 1; bf16* ob_ = hn + (size_t)row * DM;
#pragma unroll
            for (int jj = 0; jj < 4; ++jj) { const unsigned a0 = pk2(v[2 * jj].x, v[2 * jj].y), a1 = pk2(v[2 * jj].z, v[2 * jj].w), b0 = pk2(v[2 * jj + 1].x, v[2 * jj + 1].y), b1 = pk2(v[2 * jj + 1].z, v[2 * jj + 1].w);
                const unsigned s0 = odd ? a0 : b0, s1 = odd ? a1 : b1;
                const unsigned r0 = (unsigned)__builtin_amdgcn_mov_dpp((int)s0, 0xB1, 0xf, 0xf, true), r1 = (unsigned)__builtin_amdgcn_mov_dpp((int)s1, 0xB1, 0xf, 0xf, true);
                v4u w; if (odd) { w.x = r0; w.y = r1; w.z = b0; w.w = b1; } else { w.x = a0; w.y = a1; w.z = r0; w.w = r1; }
                *(v4u*)(ob_ + 4 * (64 * (2 * jj + (odd ? 1 : 0)) + (lane & ~1))) = w; } }
        if (w_in) {
            float acc[8];
#pragma unroll
            for (int q = 0; q < 8; ++q) acc[q] = 0.f;
#pragma unroll
            for (int j = 0; j < 8; ++j) { asm volatile("" ::: "memory");
#pragma unroll
                for (int e = 0; e < 4; ++e) { const int k = 4 * nrm_idx<XBF>(j, lane) + e; const LAS float* wp = gwl + (k >> 3) * 68 + (k & 7) * 8; const f32x4 a = *(const LAS f32x4*)wp, b = *(const LAS f32x4*)(wp + 4); const float hv = v[j][e];
                    acc[0] += hv * a.x; acc[1] += hv * a.y; acc[2] += hv * a.z; acc[3] += hv * a.w; acc[4] += hv * b.x; acc[5] += hv * b.y; acc[6] += hv * b.z; acc[7] += hv * b.w; } }
#pragma unroll
            for (int q = 0; q < 8; ++q) acc[q] = wave_sum(acc[q]);
            if (lane < 8) { float r = acc[0];
#pragma unroll
                for (int q = 1; q < 8; ++q) r = (lane == q) ? acc[q] : r;
                gates[(size_t)row * 8 + lane] = r + gate_bias[lane]; }
        }
    }
}

__device__ __forceinline__ void unpack8(const v4u v, float (&f)[8]) { f[0] = bflo(v.x); f[1] = bfhi(v.x); f[2] = bflo(v.y); f[3] = bfhi(v.y); f[4] = bflo(v.z); f[5] = bfhi(v.z); f[6] = bflo(v.w); f[7] = bfhi(v.w); }
__device__ __forceinline__ void p_lstm_conv(const Frame& F, const bf16* z, const float* cw, const float* cb, bf16* qk) {
    constexpr int NCH = DM / 8, SEGR = 16, NSEG = MROWS / SEGR;
    const int total = NCH * NSEG, stride = F.G * NTHREADS;
    for (int item = F.vcu * NTHREADS + F.tid; item < total; item += stride) {
        const int cc = item % NCH, seg = item / NCH, c = 8 * cc, r0 = seg * SEGR, t0 = r0 & (SEQ - 1);
        float w[4][8], bb[8];
        { const f32x4 b0 = *(const f32x4*)(cb + c), b1 = *(const f32x4*)(cb + c + 4);
#pragma unroll
          for (int e = 0; e < 4; ++e) { bb[e] = b0[e]; bb[4 + e] = b1[e]; }
#pragma unroll
          for (int j = 0; j < 4; ++j) { const f32x4 w0 = *(const f32x4*)(cw + j * DM + c), w1 = *(const f32x4*)(cw + j * DM + c + 4);
#pragma unroll
              for (int e = 0; e < 4; ++e) { w[j][e] = w0[e]; w[j][4 + e] = w1[e]; } } }
        const float sc = (c >= QKW) ? 0.0625f : 1.f;
        float x3[8], x2[8], x1[8];
#pragma unroll
        for (int e = 0; e < 8; ++e) { x3[e] = 0.f; x2[e] = 0.f; x1[e] = 0.f; }
        if (t0 > 0) { unpack8(*(const v4u*)(z + (size_t)(r0 - 3) * INW_MAIN + c), x3); unpack8(*(const v4u*)(z + (size_t)(r0 - 2) * INW_MAIN + c), x2); unpack8(*(const v4u*)(z + (size_t)(r0 - 1) * INW_MAIN + c), x1); }
#pragma unroll 4
        for (int r = 0; r < SEGR; ++r) {
            float x0[8]; unpack8(*(const v4u*)(z + (size_t)(r0 + r) * INW_MAIN + c), x0);
            float o[8];
#pragma unroll
            for (int e = 0; e < 8; ++e) { const float a = bb[e] + w[0][e] * x3[e] + w[1][e] * x2[e] + w[2][e] * x1[e] + w[3][e] * x0[e]; o[e] = siluf_(a) * sc; x3[e] = x2[e]; x2[e] = x1[e]; x1[e] = x0[e]; }
            v4u ow; ow.x = pk2(o[0], o[1]); ow.y = pk2(o[2], o[3]); ow.z = pk2(o[4], o[5]); ow.w = pk2(o[6], o[7]);
            *(v4u*)(qk + (size_t)(r0 + r) * DM + c) = ow;
        }
    }
}

typedef short bf16x8 __attribute__((ext_vector_type(8)));
typedef short s16x4 __attribute__((ext_vector_type(4)));
typedef float f32x16 __attribute__((ext_vector_type(16)));
typedef __attribute__((address_space(3))) const unsigned char* lds_cptr;
__device__ __forceinline__ s16x4 vtr(lds_cptr p) { return __builtin_bit_cast(s16x4, __builtin_amdgcn_ds_read_tr16_b64_v4i16((__attribute__((address_space(3))) s16x4*)p)); }
__device__ __forceinline__ bf16x8 cat8(s16x4 lo, s16x4 hi) { return (bf16x8){lo[0], lo[1], lo[2], lo[3], hi[0], hi[1], hi[2], hi[3]}; }

constexpr int NSL = 17;
constexpr size_t CST_SLICE = 16384;
constexpr int L2_KSTR = 576, L2_KBUF = 64 * L2_KSTR;
constexpr int L2_VBUF = 64 * 64;

__device__ __forceinline__ float log_sigmoidf_(float x) { return (x >= 0.f) ? -log1pf(__expf(-x)) : x - log1pf(__expf(x)); }
__device__ __forceinline__ void p_lstm_scan2(const Frame& F, const float* gates, float* U, float* Mx, float* E) {
    if (F.vcu >= 8) return;
    const int bh = F.vcu, b = bh >> 2, h = bh & 3, tid = F.tid, lane = F.lane, w = F.wave, t0 = tid * 8;
    LAS float* wsum = (LAS float*)F.lds; LAS float* wmax = wsum + 8;
    const float* gb = gates + (size_t)(b * SEQ + t0) * 8;
    float lf[8], li[8];
#pragma unroll
    for (int i = 0; i < 8; ++i) { lf[i] = gb[i * 8 + 4 + h]; li[i] = gb[i * 8 + h]; }
    float s = 0.f;
#pragma unroll
    for (int i = 0; i < 8; ++i) { lf[i] = log_sigmoidf_(lf[i]); s += lf[i]; }
    float inc = s;
#pragma unroll
    for (int o = 1; o < 64; o <<= 1) { const float y = __shfl_up(inc, o); if (lane >= o) inc += y; }
    __syncthreads();
    if (lane == 63) wsum[w] = inc;
    __syncthreads();
    float base = 0.f;
#pragma unroll
    for (int q = 0; q < 8; ++q) base += (q < w) ? wsum[q] : 0.f;
    float Fc = base + inc - s, lm = -INFINITY; float u[8], Fv[8];
#pragma unroll
    for (int i = 0; i < 8; ++i) { Fc += lf[i]; Fv[i] = Fc; u[i] = li[i] - Fc; lm = fmaxf(lm, u[i]); }
    float pm = lm;
#pragma unroll
    for (int o = 1; o < 64; o <<= 1) { const float y = __shfl_up(pm, o); if (lane >= o) pm = fmaxf(pm, y); }
    if (lane == 63) wmax[w] = pm;
    __syncthreads();
    float mm = __shfl_up(pm, 1); if (lane == 0) mm = 0.f;
#pragma unroll
    for (int q = 0; q < 8; ++q) mm = fmaxf(mm, (q < w) ? wmax[q] : 0.f);
    mm = fmaxf(mm, 0.f);
#pragma unroll
    for (int i = 0; i < 8; ++i) { mm = fmaxf(mm, u[i]); U[bh * SEQ + t0 + i] = u[i]; Mx[bh * SEQ + t0 + i] = mm; E[bh * SEQ + t0 + i] = __expf(-(Fv[i] + mm)); }
    __syncthreads();
}

__device__ __forceinline__ void p_lstm_state(const Frame& F, const bf16* qk, const bf16* z, const float* U, const float* Mx, unsigned char* cst, float* nst) {
    const int item = F.vcu; if (item >= 8 * NSL) return;
    const int bh = item / NSL, j = item % NSL, b = bh >> 2, h = bh & 3;
    const int tid = F.tid, lane = F.lane, w = F.wave, hi = lane >> 5, g1 = (lane >> 4) & 1, q4 = (lane & 15) >> 2, p4 = lane & 3;
    LAS unsigned char* kb0 = F.lds; LAS unsigned char* vb0 = F.lds + 2 * L2_KBUF;
    const size_t rbase = (size_t)b * SEQ;
    const bf16* kg = qk + rbase * DM + QKW + h * LDK;
    const bf16* vg = z + rbase * INW_MAIN + 2 * QKW + h * LDV + 32 * j;
    const float* Ub = U + bh * SEQ; const float* Mb = Mx + bh * SEQ;
    const bool ones = (j == NSL - 1);
    f32x16 acc;
#pragma unroll
    for (int r = 0; r < 16; ++r) acc[r] = 0.f;
    v4u kreg[4][4]; v4u vreg[4];
#pragma unroll
    for (int q = 0; q < 4; ++q) vreg[q] = (v4u){0u, 0u, 0u, 0u};
    LAS float* wtl = (LAS float*)(F.lds + 2 * L2_KBUF + 2 * L2_VBUF); LAS float* decl = wtl + SEQ;
    __syncthreads();
#pragma unroll
    for (int i = 0; i < 8; ++i) { const int t = tid + 512 * i; wtl[t] = __expf(Ub[t] - Mb[(t & ~63) + 63]); }
    if (tid < 64) decl[tid] = __expf((tid > 0 ? Mb[tid * 64 - 1] : 0.f) - Mb[tid * 64 + 63]);
    const int vrow = tid >> 2, vch = tid & 3;
#define L2_LOAD(c, sl) do { const int t0_ = (c) * 64; \
        _Pragma("unroll") for (int i_ = 0; i_ < 4; ++i_) { const int id_ = tid + 512 * i_, row_ = id_ >> 5, ch_ = id_ & 31; kreg[sl][i_] = *(const v4u*)(kg + (size_t)(t0_ + row_) * DM + ch_ * 8); } \
        if (tid < 256 && !ones) vreg[sl] = *(const v4u*)(vg + (size_t)(t0_ + vrow) * INW_MAIN + vch * 8); } while (0)
#define L2_STORE(sl, buf, c_) do { \
        _Pragma("unroll") for (int i_ = 0; i_ < 4; ++i_) { const int id_ = tid + 512 * i_, row_ = id_ >> 5, ch_ = id_ & 31; *(LAS v4u*)(kb0 + (buf) * L2_KBUF + row_ * L2_KSTR + ch_ * 16) = kreg[sl][i_]; } \
        if (tid < 256) { const float wt_ = wtl[(c_) * 64 + vrow]; v4u o_; const v4u vr_ = vreg[sl]; \
            if (ones) { const unsigned pw_ = pk2(wt_, wt_); o_ = (v4u){pw_, pw_, pw_, pw_}; } \
            else { o_.x = pk2(bflo(vr_.x) * wt_, bfhi(vr_.x) * wt_); o_.y = pk2(bflo(vr_.y) * wt_, bfhi(vr_.y) * wt_); o_.z = pk2(bflo(vr_.z) * wt_, bfhi(vr_.z) * wt_); o_.w = pk2(bflo(vr_.w) * wt_, bfhi(vr_.w) * wt_); } \
            *(LAS v4u*)(vb0 + (buf) * L2_VBUF + vrow * 64 + vch * 16) = o_; } } while (0)
    const int koff = (8 * hi + q4) * L2_KSTR + (32 * w + 16 * g1 + 4 * p4) * 2;
    const int voff = (8 * hi + q4) * 64 + (16 * g1 + 4 * p4) * 2;
    unsigned char* cdst = cst + ((size_t)(bh * 64) * NSL + j) * CST_SLICE + ((size_t)(w * 2) * 64 + lane) * 16;
    __syncthreads();
    L2_LOAD(0, 0); L2_LOAD(1, 1); L2_LOAD(2, 2); L2_LOAD(3, 3);
    L2_STORE(0, 0, 0);
    __syncthreads();
#define L2_ITER(c, sl, sln) do { \
        { unsigned char* d = cdst + (size_t)(c) * NSL * CST_SLICE; \
          _Pragma("unroll") for (int s_ = 0; s_ < 2; ++s_) { v4u o; o.x = pk2(acc[8 * s_ + 0], acc[8 * s_ + 1]); o.y = pk2(acc[8 * s_ + 2], acc[8 * s_ + 3]); o.z = pk2(acc[8 * s_ + 4], acc[8 * s_ + 5]); o.w = pk2(acc[8 * s_ + 6], acc[8 * s_ + 7]); \
              *(v4u*)(d + s_ * 1024) = o; } \
          if (ones && (lane & 31) == 0) { float* nd = nst + (size_t)(bh * 64 + (c)) * LDK + 32 * w + 4 * hi; \
              _Pragma("unroll") for (int r = 0; r < 16; ++r) nd[(r & 3) + 8 * (r >> 2)] = acc[r]; } } \
        const float decay = decl[c]; \
        _Pragma("unroll") for (int r = 0; r < 16; ++r) acc[r] *= decay; \
        { lds_cptr kp = (lds_cptr)(kb0 + ((c) & 1) * L2_KBUF + koff); lds_cptr vp = (lds_cptr)(vb0 + ((c) & 1) * L2_VBUF + voff); \
          _Pragma("unroll") for (int ks = 0; ks < 4; ++ks) { \
              const bf16x8 a = cat8(vtr(kp + ks * 16 * L2_KSTR), vtr(kp + ks * 16 * L2_KSTR + 4 * L2_KSTR)); \
              const bf16x8 bb = cat8(vtr(vp + ks * 16 * 64), vtr(vp + ks * 16 * 64 + 4 * 64)); \
              acc = __builtin_amdgcn_mfma_f32_32x32x16_bf16(a, bb, acc, 0, 0, 0); } } \
        if ((c) + 1 < 64) { L2_STORE(sln, ((c) + 1) & 1, (c) + 1); } \
        if ((c) + 4 < 64) L2_LOAD((c) + 4, sl); \
        asm volatile("s_waitcnt lgkmcnt(0)" ::: "memory"); __builtin_amdgcn_s_barrier(); asm volatile("" ::: "memory"); } while (0)
    for (int c4 = 0; c4 < 64; c4 += 4) { L2_ITER(c4, 0, 1); L2_ITER(c4 + 1, 1, 2); L2_ITER(c4 + 2, 2, 3); L2_ITER(c4 + 3, 3, 0); }
#undef L2_ITER
#undef L2_LOAD
#undef L2_STORE
}

constexpr int L3_QSTR = 528, L3_VSTR = 1088, L3_WSTR = 144;
constexpr int L3_Q = 0, L3_K = L3_Q + 64 * L3_QSTR, L3_V = L3_K + 64 * L3_QSTR, L3_W = L3_V + 64 * L3_VSTR, L3_SC = L3_W + 64 * L3_WSTR, L3_END = L3_SC + 8192;
__device__ __forceinline__ void p_lstm_out(const Frame& F, const bf16* qk, const bf16* z, const float* U, const float* Mx, const float* E, const unsigned char* cst, const float* nst, const float* hgain, bf16* O) {
    const int tid = F.tid, lane = F.lane, w = F.wave, hi = lane >> 5, g1 = (lane >> 4) & 1, q4 = (lane & 15) >> 2, p4 = lane & 3, l31 = lane & 31;
    LAS unsigned char* lds = F.lds;
    LAS float* sc = (LAS float*)(lds + L3_SC);
    LAS float* uS = sc, *Mrow = sc + 64, *inter = sc + 128, *Erow = sc + 192, *dinv = sc + 256, *nvec = sc + 320, *ssq = sc + 576, *rstdv = sc + 1088;
    for (int item = F.vcu; item < 8 * 64; item += F.G) {
        const int bh = item >> 6, c = item & 63, b = bh >> 2, h = bh & 3, t0 = c * 64;
        const size_t row0 = (size_t)b * SEQ + t0;
        __syncthreads();
        { v4u rq[4], rk[4], rv[8];
#pragma unroll
          for (int i = 0; i < 4; ++i) { const int id = tid + 512 * i, r = id >> 5, ch = id & 31;
              rq[i] = *(const v4u*)(qk + (row0 + r) * DM + h * LDK + ch * 8); rk[i] = *(const v4u*)(qk + (row0 + r) * DM + QKW + h * LDK + ch * 8); }
#pragma unroll
          for (int i = 0; i < 8; ++i) { const int id = tid + 512 * i, r = id >> 6, ch = id & 63; rv[i] = *(const v4u*)(z + (row0 + r) * INW_MAIN + 2 * QKW + h * LDV + ch * 8); }
#pragma unroll
          for (int i = 0; i < 4; ++i) { const int id = tid + 512 * i, r = id >> 5, ch = id & 31;
              *(LAS v4u*)(lds + L3_Q + r * L3_QSTR + ch * 16) = rq[i]; *(LAS v4u*)(lds + L3_K + r * L3_QSTR + ch * 16) = rk[i]; }
#pragma unroll
          for (int i = 0; i < 8; ++i) { const int id = tid + 512 * i, r = id >> 6, ch = id & 63; *(LAS v4u*)(lds + L3_V + r * L3_VSTR + ch * 16) = rv[i]; } }
        if (tid < 64) { const float mr = Mx[bh * SEQ + t0 + tid]; const float mp = (c > 0) ? Mx[bh * SEQ + t0 - 1] : 0.f;
            uS[tid] = U[bh * SEQ + t0 + tid]; Mrow[tid] = mr; inter[tid] = __expf(mp - mr); Erow[tid] = E[bh * SEQ + t0 + tid]; }
        else if (tid < 128) { const int i4 = tid - 64; *(LAS f32x4*)(nvec + 4 * i4) = *(const f32x4*)(nst + (size_t)(bh * 64 + c) * LDK + 4 * i4); }
        __syncthreads();
        { const int rt = w >> 1, i15 = lane & 15, quad = lane >> 4;
#pragma unroll
          for (int cc = 0; cc < 2; ++cc) { const int ct = 2 * (w & 1) + cc;
              pg8::f32x4 sacc = (pg8::f32x4){0.f, 0.f, 0.f, 0.f};
              if (ct <= rt) {
                  const LAS unsigned char* qa = lds + L3_Q + (16 * rt + i15) * L3_QSTR + quad * 16; const LAS unsigned char* ka = lds + L3_K + (16 * ct + i15) * L3_QSTR + quad * 16;
#pragma unroll
                  for (int ks = 0; ks < 8; ++ks) { const bf16x8 a = *(const LAS bf16x8*)(qa + ks * 64), bb = *(const LAS bf16x8*)(ka + ks * 64);
                      sacc = __builtin_amdgcn_mfma_f32_16x16x32_bf16(a, bb, sacc, 0, 0, 0); } }
              const int s_ = 16 * ct + i15; const float us = uS[s_];
#pragma unroll
              for (int e = 0; e < 4; ++e) { const int l_ = 16 * rt + 4 * quad + e; const float wv = (s_ <= l_) ? sacc[e] * __expf(us - Mrow[l_]) : 0.f;
                  *(LAS unsigned short*)(lds + L3_W + l_ * L3_WSTR + s_ * 2) = (unsigned short)f2bf(wv); } } }
        __syncthreads();
        { const int r = tid >> 3, part = tid & 7; const v4u wv = *(const LAS v4u*)(lds + L3_W + r * L3_WSTR + part * 16);
          float rs = (bflo(wv.x) + bfhi(wv.x)) + (bflo(wv.y) + bfhi(wv.y)) + (bflo(wv.z) + bfhi(wv.z)) + (bflo(wv.w) + bfhi(wv.w)); float qn = 0.f;
#pragma unroll
          for (int i = 0; i < 4; ++i) { const v4u qv = *(const LAS v4u*)(lds + L3_Q + r * L3_QSTR + part * 64 + i * 16); const LAS float* np = nvec + part * 32 + i * 8;
              qn += bflo(qv.x) * np[0] + bfhi(qv.x) * np[1] + bflo(qv.y) * np[2] + bfhi(qv.y) * np[3] + bflo(qv.z) * np[4] + bfhi(qv.z) * np[5] + bflo(qv.w) * np[6] + bfhi(qv.w) * np[7]; }
          float den = inter[r] * qn + rs; den += __shfl_xor(den, 1); den += __shfl_xor(den, 2); den += __shfl_xor(den, 4);
          if (part == 0) dinv[r] = 1.f / fmaxf(fabsf(den), Erow[r]); }
        f32x16 acc[2][2];
#pragma unroll
        for (int a = 0; a < 2; ++a)
#pragma unroll
            for (int bq = 0; bq < 2; ++bq)
#pragma unroll
                for (int r = 0; r < 16; ++r) acc[a][bq][r] = 0.f;
        { const unsigned char* cb = cst + ((size_t)(bh * 64 + c) * NSL + 2 * w) * CST_SLICE + (size_t)lane * 16;
          const LAS unsigned char* qa = lds + L3_Q + l31 * L3_QSTR + hi * 8;
          bf16x8 bfr[2][8];
#pragma unroll
          for (int q = 0; q < 4; ++q) { bfr[0][2 * q] = *(const bf16x8*)(cb + q * 1024); bfr[0][2 * q + 1] = *(const bf16x8*)(cb + CST_SLICE + q * 1024); }
#pragma unroll
          for (int gq = 0; gq < 4; ++gq) {
              if (gq < 3) {
#pragma unroll
                  for (int q = 0; q < 4; ++q) { bfr[(gq + 1) & 1][2 * q] = *(const bf16x8*)(cb + (4 * (gq + 1) + q) * 1024); bfr[(gq + 1) & 1][2 * q + 1] = *(const bf16x8*)(cb + CST_SLICE + (4 * (gq + 1) + q) * 1024); } }
#pragma unroll
              for (int q = 0; q < 4; ++q) { const int kk = 4 * gq + q; const bf16x8 b0 = bfr[gq & 1][2 * q], b1 = bfr[gq & 1][2 * q + 1];
                  bf16x8 a[2];
#pragma unroll
                  for (int rt = 0; rt < 2; ++rt) { const s16x4 lo = *(const LAS s16x4*)(qa + rt * 32 * L3_QSTR + kk * 32), hh = *(const LAS s16x4*)(qa + rt * 32 * L3_QSTR + kk * 32 + 16); a[rt] = cat8(lo, hh); }
                  acc[0][0] = __builtin_amdgcn_mfma_f32_32x32x16_bf16(a[0], b0, acc[0][0], 0, 0, 0);
                  acc[0][1] = __builtin_amdgcn_mfma_f32_32x32x16_bf16(a[0], b1, acc[0][1], 0, 0, 0);
                  acc[1][0] = __builtin_amdgcn_mfma_f32_32x32x16_bf16(a[1], b0, acc[1][0], 0, 0, 0);
                  acc[1][1] = __builtin_amdgcn_mfma_f32_32x32x16_bf16(a[1], b1, acc[1][1], 0, 0, 0); }
              __builtin_amdgcn_sched_barrier(0); } }
#pragma unroll
        for (int rt = 0; rt < 2; ++rt)
#pragma unroll
            for (int r = 0; r < 16; ++r) { const float f = inter[32 * rt + (r & 3) + 8 * (r >> 2) + 4 * hi]; acc[rt][0][r] *= f; acc[rt][1][r] *= f; }
        { const LAS unsigned char* wa = lds + L3_W + l31 * L3_WSTR + hi * 16;
          lds_cptr vp = (lds_cptr)(lds + L3_V + (8 * hi + q4) * L3_VSTR + (64 * w + 16 * g1 + 4 * p4) * 2);
#pragma unroll
          for (int ks = 0; ks < 4; ++ks) {
              const bf16x8 a0 = *(const LAS bf16x8*)(wa + ks * 32), a1 = *(const LAS bf16x8*)(wa + 32 * L3_WSTR + ks * 32);
              const bf16x8 b0 = cat8(vtr(vp + ks * 16 * L3_VSTR), vtr(vp + ks * 16 * L3_VSTR + 4 * L3_VSTR));
              const bf16x8 b1 = cat8(vtr(vp + ks * 16 * L3_VSTR + 64), vtr(vp + ks * 16 * L3_VSTR + 4 * L3_VSTR + 64));
              acc[0][0] = __builtin_amdgcn_mfma_f32_32x32x16_bf16(a0, b0, acc[0][0], 0, 0, 0);
              acc[0][1] = __builtin_amdgcn_mfma_f32_32x32x16_bf16(a0, b1, acc[0][1], 0, 0, 0);
              acc[1][0] = __builtin_amdgcn_mfma_f32_32x32x16_bf16(a1, b0, acc[1][0], 0, 0, 0);
              acc[1][1] = __builtin_amdgcn_mfma_f32_32x32x16_bf16(a1, b1, acc[1][1], 0, 0, 0); } }
        __syncthreads();
        { LAS unsigned short* hb = (LAS unsigned short*)(lds + L3_V);
#pragma unroll
          for (int rt = 0; rt < 2; ++rt)
#pragma unroll
              for (int r = 0; r < 16; ++r) { const int l_ = 32 * rt + (r & 3) + 8 * (r >> 2) + 4 * hi; const float dn = dinv[l_];
                  const float x0 = acc[rt][0][r] * dn, x1 = acc[rt][1][r] * dn;
                  const unsigned pw = pk2(x0, x1);
                  hb[l_ * (L3_VSTR / 2) + 64 * w + l31] = (unsigned short)(pw & 0xffffu); hb[l_ * (L3_VSTR / 2) + 64 * w + 32 + l31] = (unsigned short)(pw >> 16);
                  float q2 = x0 * x0 + x1 * x1; q2 += __shfl_xor(q2, 1); q2 += __shfl_xor(q2, 2); q2 += __shfl_xor(q2, 4); q2 += __shfl_xor(q2, 8); q2 += __shfl_xor(q2, 16);
                  if (l31 == 0) ssq[w * 64 + l_] = q2; } }
        __syncthreads();
        if (tid < 64) { float tot = 0.f;
#pragma unroll
            for (int ww = 0; ww < 8; ++ww) tot += ssq[ww * 64 + tid];
            rstdv[tid] = 1.f / sqrtf(tot * (1.f / LDV) + NORM_EPS); }
        __syncthreads();
        { const int ch = tid & 63; const f32x4 ga = *(const f32x4*)(hgain + h * LDV + ch * 8), gb = *(const f32x4*)(hgain + h * LDV + ch * 8 + 4);
#pragma unroll 2
          for (int i = 0; i < 8; ++i) { const int r = (tid >> 6) + 8 * i;
              const v4u ogv = *(const v4u*)(z + (row0 + r) * INW_MAIN + 2 * QKW + DM + h * LDV + ch * 8);
              const v4u hv = *(const LAS v4u*)(lds + L3_V + r * L3_VSTR + ch * 16);
              float hf[8], gf[8]; unpack8(hv, hf); unpack8(ogv, gf);
              const float rstd = rstdv[r];
#pragma unroll
              for (int e = 0; e < 8; ++e) gf[e] = rstd * __builtin_amdgcn_rcpf(1.f + __expf(-gf[e]));
              v4u o; o.x = pk2(hf[0] * ga[0] * gf[0], hf[1] * ga[1] * gf[1]); o.y = pk2(hf[2] * ga[2] * gf[2], hf[3] * ga[3] * gf[3]);
              o.z = pk2(hf[4] * gb[0] * gf[4], hf[5] * gb[1] * gf[5]); o.w = pk2(hf[6] * gb[2] * gf[6], hf[7] * gb[3] * gf[7]);
              *(v4u*)(O + (row0 + r) * DM + h * LDV + ch * 8) = o; } }
    }
    __syncthreads();
}


constexpr int AT_K = 0, AT_V = 65536;
__device__ __forceinline__ void p_attn(const Frame& F, const bf16* qkv, const float* qg, const float* kg, bf16* OG, float* LSE) {
    const int tid = F.tid, lane = F.lane, w = F.wave, i15 = lane & 15, quad = lane >> 4, q4 = i15 >> 2, p4 = lane & 3;
    LAS unsigned char* lds = F.lds;
    int lk[4];
#pragma unroll
    for (int ks = 0; ks < 4; ++ks) lk[ks] = i15 * 256 + (((4 * ks + quad) ^ i15) << 4);
    int lv[8];
    { const int rl = 4 * quad + q4, sw = (rl & 7) << 1, ps = ((p4 & 1) << 1) | (p4 >> 1);
#pragma unroll
      for (int dt = 0; dt < 8; ++dt) lv[dt] = rl * 256 + (((2 * dt + (ps >> 1)) ^ sw) << 4) + 8 * (ps & 1); }
#define AT_NIT(it_) ((F.vcu + F.G * ((it_) / 12)) < 256)
#define AT_DECODE(it_) const int grp_ = F.vcu + F.G * ((it_) / 12), k_ = (it_) % 12, b_ = grp_ >> 7, h_ = (grp_ >> 3) & 15, o_ = grp_ & 7; \
        const int g_ = k_ >> 2, dil_ = (g_ == 0) ? 1 : (g_ == 1) ? 4 : 16; \
        const int res_ = (g_ == 0) ? 0 : (g_ == 1) ? (o_ >> 1) : (2 * o_ + ((k_ - 8) >> 1)), n_ = (g_ == 0) ? (4 * o_ + k_) : (g_ == 1) ? (4 * (o_ & 1) + (k_ - 4)) : (k_ & 1); \
        const bool first_ = (g_ == 2) ? ((k_ & 1) == 0) : ((k_ & 3) == 0); const size_t brow_ = (size_t)b_ * SEQ;
    v4u pkc[4], pvc[4], pkp[4], pvp[4], pq_[4];
#define AT_PRELOAD(it_) do { AT_DECODE(it_) \
        _Pragma("unroll") for (int i = 0; i < 4; ++i) { const int id = tid + 512 * i, j = id >> 4, ch = id & 15; \
            const bf16* src = qkv + (brow_ + (size_t)(128 * n_ + j) * dil_ + res_) * NQKV + DM + h_ * AHD + ch * 8; pkc[i] = *(const v4u*)src; pvc[i] = *(const v4u*)(src + DM); } \
        if (first_ && n_ > 0) { _Pragma("unroll") for (int i = 0; i < 4; ++i) { const int id = tid + 512 * i, j = id >> 4, ch = id & 15; \
            const bf16* src = qkv + (brow_ + (size_t)(128 * (n_ - 1) + j) * dil_ + res_) * NQKV + DM + h_ * AHD + ch * 8; pkp[i] = *(const v4u*)src; pvp[i] = *(const v4u*)(src + DM); } } \
        { const size_t qrow_ = brow_ + (size_t)(128 * n_ + 16 * w + i15) * dil_ + res_; \
          _Pragma("unroll") for (int ks = 0; ks < 4; ++ks) pq_[ks] = *(const v4u*)(qkv + qrow_ * NQKV + h_ * AHD + 32 * ks + 8 * quad); } } while (0)
    if (AT_NIT(0)) AT_PRELOAD(0);
    for (int it = 0; AT_NIT(it); ++it) {
        AT_DECODE(it)
        const int g = g_, h = h_, n = n_, dil = dil_, res = res_; const size_t brow = brow_;
        const int hcur = (n & 1) * 32768, hprev = 32768 - hcur;
        asm volatile("s_waitcnt lgkmcnt(0)" ::: "memory"); __builtin_amdgcn_s_barrier(); asm volatile("" ::: "memory");
#pragma unroll
        for (int i = 0; i < 4; ++i) { const int id = tid + 512 * i, j = id >> 4, ch = id & 15;
            *(LAS v4u*)(lds + AT_K + hcur + j * 256 + ((ch ^ (j & 15)) << 4)) = pkc[i];
            *(LAS v4u*)(lds + AT_V + hcur + j * 256 + ((ch ^ ((j & 7) << 1)) << 4)) = pvc[i]; }
        if (first_) {
#pragma unroll
            for (int i = 0; i < 4; ++i) { const int id = tid + 512 * i, j = id >> 4, ch = id & 15;
                v4u kv = pkp[i], vvv = pvp[i]; if (n == 0) { kv = (v4u){0u, 0u, 0u, 0u}; vvv = kv; }
                *(LAS v4u*)(lds + AT_K + hprev + j * 256 + ((ch ^ (j & 15)) << 4)) = kv;
                *(LAS v4u*)(lds + AT_V + hprev + j * 256 + ((ch ^ ((j & 7) << 1)) << 4)) = vvv; } }
        const size_t qrow = brow + (size_t)(128 * n + 16 * w + i15) * dil + res;
        bf16x8 qf[4];
#pragma unroll
        for (int ks = 0; ks < 4; ++ks) qf[ks] = __builtin_bit_cast(bf16x8, pq_[ks]);
        asm volatile("s_waitcnt lgkmcnt(0)" ::: "memory"); __builtin_amdgcn_s_barrier(); asm volatile("" ::: "memory");
        if (AT_NIT(it + 1)) AT_PRELOAD(it + 1);
#define AT_TOFF(T) ((((T) < 8) ? hprev : hcur) + ((T) & 7) * 4096)
        pg8::f32x4 st[9];
        { bf16x8 ka[3][4];
#pragma unroll
          for (int ks = 0; ks < 4; ++ks) { ka[0][ks] = *(const LAS bf16x8*)(lds + AT_K + AT_TOFF(w) + lk[ks]); ka[1][ks] = *(const LAS bf16x8*)(lds + AT_K + AT_TOFF(w + 1) + lk[ks]); }
#pragma unroll
          for (int jt = 0; jt < 9; ++jt) { st[jt] = (pg8::f32x4){0.f, 0.f, 0.f, 0.f};
              if (jt < 7) {
#pragma unroll
                  for (int ks = 0; ks < 4; ++ks) ka[(jt + 2) % 3][ks] = *(const LAS bf16x8*)(lds + AT_K + AT_TOFF(w + jt + 2) + lk[ks]); }
              if (n > 0 || w + jt >= 8) {
#pragma unroll
              for (int ks = 0; ks < 4; ++ks) st[jt] = __builtin_amdgcn_mfma_f32_16x16x32_bf16(ka[jt % 3][ks], qf[ks], st[jt], 0, 0, 0); }
              __builtin_amdgcn_sched_barrier(0); } }
        float mx = -INFINITY;
#pragma unroll
        for (int jt = 0; jt < 9; ++jt) { const bool tile_ok = (n > 0) || (w + jt >= 8);
#pragma unroll
            for (int e = 0; e < 4; ++e) { const int dj = 16 * jt + 4 * quad + e - i15;
                const bool ok = tile_ok && (jt != 0 || dj >= 0) && (jt != 8 || dj <= 128);
                const float s = ok ? st[jt][e] : -INFINITY; st[jt][e] = s; mx = fmaxf(mx, s); } }
        mx = fmaxf(mx, __shfl_xor(mx, 16)); mx = fmaxf(mx, __shfl_xor(mx, 32));
        float l = 0.f;
#pragma unroll
        for (int jt = 0; jt < 9; ++jt)
#pragma unroll
            for (int e = 0; e < 4; ++e) { const float p = __builtin_amdgcn_exp2f(st[jt][e] - mx); st[jt][e] = p; l += p; }
        l += __shfl_xor(l, 16); l += __shfl_xor(l, 32);
        pg8::f32x4 ot[8];
#pragma unroll
        for (int dt = 0; dt < 8; ++dt) ot[dt] = (pg8::f32x4){0.f, 0.f, 0.f, 0.f};
        { bf16x8 pb[5];
#pragma unroll
          for (int kk = 0; kk < 5; ++kk) { v4u pw; pw.x = pk2(st[2 * kk][0], st[2 * kk][1]); pw.y = pk2(st[2 * kk][2], st[2 * kk][3]);
              if (kk < 4) { pw.z = pk2(st[2 * kk + 1][0], st[2 * kk + 1][1]); pw.w = pk2(st[2 * kk + 1][2], st[2 * kk + 1][3]); } else { pw.z = 0u; pw.w = 0u; }
              pb[kk] = __builtin_bit_cast(bf16x8, pw); }
          s16x4 vf[3][4][2];
          const int t1last = (w == 7) ? 8 : 9;
#define AT_VLOAD(bt, buf) do { const int kk_ = (bt) >> 1, hf_ = (bt) & 1; const int t0_ = w + 2 * kk_, t1_ = w + ((kk_ < 4) ? (2 * kk_ + 1) : t1last); const int o0_ = AT_TOFF(t0_), o1_ = AT_TOFF(t1_); \
          _Pragma("unroll") for (int d_ = 0; d_ < 4; ++d_) { vf[buf][d_][0] = vtr((lds_cptr)(lds + AT_V + o0_ + lv[4 * hf_ + d_])); vf[buf][d_][1] = vtr((lds_cptr)(lds + AT_V + o1_ + lv[4 * hf_ + d_])); } } while (0)
          AT_VLOAD(0, 0); AT_VLOAD(1, 1);
#pragma unroll
          for (int bt = 0; bt < 10; ++bt) {
              if (bt < 8) AT_VLOAD(bt + 2, (bt + 2) % 3);
              if (n > 0 || w + 2 * (bt >> 1) + 1 >= 8) {
#pragma unroll
              for (int d = 0; d < 4; ++d) ot[4 * (bt & 1) + d] = __builtin_amdgcn_mfma_f32_16x16x32_bf16(cat8(vf[bt % 3][d][0], vf[bt % 3][d][1]), pb[bt >> 1], ot[4 * (bt & 1) + d], 0, 0, 0); }
              __builtin_amdgcn_sched_barrier(0); }
#undef AT_VLOAD
        }
#undef AT_TOFF
        { const float il = 1.f / l; const int hi32 = quad >> 1, ql = quad & 1; bf16* op = OG + ((size_t)g * MROWS + qrow) * DM + h * AHD + 16 * hi32 + 8 * ql;
#pragma unroll
          for (int dp = 0; dp < 4; ++dp) { const unsigned x0 = pk2(ot[2 * dp][0] * il, ot[2 * dp][1] * il), x1 = pk2(ot[2 * dp][2] * il, ot[2 * dp][3] * il);
              const unsigned y0 = pk2(ot[2 * dp + 1][0] * il, ot[2 * dp + 1][1] * il), y1 = pk2(ot[2 * dp + 1][2] * il, ot[2 * dp + 1][3] * il);
              const auto r0 = __builtin_amdgcn_permlane32_swap(x0, y0, false, false), r1 = __builtin_amdgcn_permlane32_swap(x1, y1, false, false);
              v4u o; o.x = r0[0]; o.y = r1[0]; o.z = r0[1]; o.w = r1[1]; *(v4u*)(op + 32 * dp) = o; }
          if (quad == 0) LSE[(qrow * AH + h) * 4 + g] = (mx + __log2f(l)) * 0.6931471805599453f; }
    }
#undef AT_NIT
#undef AT_DECODE
#undef AT_PRELOAD
    __syncthreads();
}
__device__ __forceinline__ void p_attn_combine(const Frame& F, const bf16* OG, const float* LSE, bf16* O) {
    const size_t total = (size_t)MROWS * (DM / 8), stride = (size_t)F.G * NTHREADS;
    for (size_t idx = (size_t)F.vcu * NTHREADS + F.tid; idx < total; idx += stride) {
        const int c8 = (int)(idx & 255), row = (int)(idx >> 8), h = c8 >> 4;
        const f32x4 lv = *(const f32x4*)(LSE + ((size_t)row * AH + h) * 4); const float l0 = lv[0], l1 = lv[1], l2 = lv[2];
        const float m = fmaxf(l0, fmaxf(l1, l2)); float w0 = __expf(l0 - m), w1 = __expf(l1 - m), w2 = __expf(l2 - m); const float inv = 1.f / (w0 + w1 + w2); w0 *= inv; w1 *= inv; w2 *= inv;
        const v4u a = *(const v4u*)(OG + ((size_t)0 * MROWS + row) * DM + c8 * 8), bq = *(const v4u*)(OG + ((size_t)1 * MROWS + row) * DM + c8 * 8), cq = *(const v4u*)(OG + ((size_t)2 * MROWS + row) * DM + c8 * 8);
        v4u o;
        o.x = pk2(w0 * bflo(a.x) + w1 * bflo(bq.x) + w2 * bflo(cq.x), w0 * bfhi(a.x) + w1 * bfhi(bq.x) + w2 * bfhi(cq.x));
        o.y = pk2(w0 * bflo(a.y) + w1 * bflo(bq.y) + w2 * bflo(cq.y), w0 * bfhi(a.y) + w1 * bfhi(bq.y) + w2 * bfhi(cq.y));
        o.z = pk2(w0 * bflo(a.z) + w1 * bflo(bq.z) + w2 * bflo(cq.z), w0 * bfhi(a.z) + w1 * bfhi(bq.z) + w2 * bfhi(cq.z));
        o.w = pk2(w0 * bflo(a.w) + w1 * bflo(bq.w) + w2 * bflo(cq.w), w0 * bfhi(a.w) + w1 * bfhi(bq.w) + w2 * bfhi(cq.w));
        *(v4u*)(O + (size_t)row * DM + c8 * 8) = o;
    }
}

__device__ __forceinline__ void p_gemm_bf16(const Frame& F, const bf16* A, const bf16* Bt, int N, int K, bf16* O) {
    pg8::Gemm g{A, Bt, MROWS, N, K}; pg8::EpiBf16<0> E{O, N, nullptr, 0, 0, 1.f};
    pg8::StaticOrder S; S.init(MROWS, N, F.G, (int)blockIdx.x);
    pg8::gemm_phase<pg8::EpiBf16<0>, pg8::StaticOrder, true, true>(F.lds, g, S, E);
}
template <bool RB_IN, bool RB_OUT, bool WITH_SSQ> __device__ __forceinline__ void p_gemm_res(const Frame& F, const bf16* A, const bf16* Bt, int N, int K, const void* base, void* out, float* ssq = nullptr) {
    pg8::Gemm g{A, Bt, MROWS, N, K}; pg8::EpiRes<RB_IN, RB_OUT, WITH_SSQ> E{base, out, N, ssq};
    pg8::StaticOrder S; S.init(MROWS, N, F.G, (int)blockIdx.x);
    pg8::gemm_phase<pg8::EpiRes<RB_IN, RB_OUT, WITH_SSQ>, pg8::StaticOrder, true, true>(F.lds, g, S, E);
}
__device__ __forceinline__ void p_gemm_convgate(const Frame& F, const bf16* X, const bf16* Wt, const float* cw, const float* cb, bf16* Gout, const float* ssq) {
    pg8::Gemm g{Wt, X, FFN2, MROWS, DM}; pg8::EpiConvGateT E{Gout, cw, cb, (PG8_LAS float*)(F.lds + RING_BYTES)};
    pg8::StaticOrder S; S.init_tiles(FFN2 / 256, 2 * pg8::EpiConvGateT::TPS, F.G, (int)blockIdx.x);
    { LAS float* rsl = (LAS float*)(F.lds + RING_BYTES) + 5120; const int rl = F.tid >> 1, hf = F.tid & 1;
      __syncthreads();
#pragma unroll 2
      for (int i = 0; i < 7; ++i) { pg8::Unit u; if (!S.next(i, u)) break;
          int grow = pg8::EpiConvGateT::b_row0(u.pn) + rl; grow = grow < 0 ? 0 : (grow > MROWS - 1 ? MROWS - 1 : grow);
          const float* sp = ssq + (size_t)grow * 32 + 16 * hf; const f32x4 a0 = *(const f32x4*)sp, a1 = *(const f32x4*)(sp + 4), a2 = *(const f32x4*)(sp + 8), a3 = *(const f32x4*)(sp + 12);
          float t = ((a0[0] + a0[1]) + (a0[2] + a0[3])) + ((a1[0] + a1[1]) + (a1[2] + a1[3])) + ((a2[0] + a2[1]) + (a2[2] + a2[3])) + ((a3[0] + a3[1]) + (a3[2] + a3[3]));
          t += __shfl_xor(t, 1); if (hf == 0) rsl[256 * i + rl] = __builtin_amdgcn_rsqf(t * (1.f / DM) + NORM_EPS); }
      __syncthreads(); }
    pg8::gemm_phase<pg8::EpiConvGateT, pg8::StaticOrder, true, true>(F.lds, g, S, E);
}

__device__ __forceinline__ void p_gemm_qkv(const Frame& F, const bf16* A, const bf16* Bt, const float* qg, const float* kg, bf16* O) {
    pg8::Gemm g{A, Bt, MROWS, NQKV, DM}; pg8::EpiQKV E{O, NQKV, qg, kg, (PG8_LAS float*)(F.lds + RING_BYTES), 0.08838834764831845f * 1.4426950408889634f};
    pg8::StaticOrder S; S.init(MROWS, NQKV, F.G, (int)blockIdx.x);
    pg8::gemm_phase<pg8::EpiQKV, pg8::StaticOrder, true, true>(F.lds, g, S, E);
}

constexpr int N_PHASES = 15;
__global__ void __launch_bounds__(NTHREADS, 2) mega(Args args) {
    extern __shared__ __attribute__((aligned(16))) unsigned char lds_raw[];
    Frame F; F.lds = (LAS unsigned char*)lds_raw;
    F.tid = threadIdx.x; F.lane = F.tid & 63; F.wave = __builtin_amdgcn_readfirstlane(F.tid >> 6);
    F.G = gridDim.x; { const int bx = blockIdx.x; F.vcu = (F.G % 8 == 0) ? (bx % 8) * (F.G / 8) + bx / 8 : bx; }
    volatile LAS unsigned* MISC = (volatile LAS unsigned*)(F.lds + MISC_OFF);
    static_assert(L3_END <= MISC_OFF, "LDS map");
    for (int u = F.tid; u < (LDS_BYTES - MISC_OFF) / 4; u += NTHREADS) ((LAS unsigned*)(F.lds + MISC_OFF))[u] = 0u;
    __syncthreads();
    unsigned char* ws = args.ws;
    unsigned* ctl = (unsigned*)(ws + WS_CTL);
    XcdBarrier bar = xcd_barrier_post(ctl + CW_BAR, MISC);

    const float* x = args.in[0];
    const float *attn_norm = args.in[1], *w_qkv = args.in[2], *q_gain = args.in[3], *k_gain = args.in[4], *w_o = args.in[5];
    const float *lstm_norm = args.in[6], *w_in = args.in[7], *gate_bias = args.in[8], *lconv_w = args.in[9], *lconv_b = args.in[10], *head_gain = args.in[11], *w_out = args.in[12];
    const float *ffn_norm = args.in[13], *w_up = args.in[14], *fconv_w = args.in[15], *fconv_b = args.in[16], *w_down = args.in[17];
    float* out = args.out;
    bf16 *Wqkv = (bf16*)(ws + WS_WQKV), *Wo = (bf16*)(ws + WS_WO), *Win = (bf16*)(ws + WS_WIN), *Wout = (bf16*)(ws + WS_WOUT), *Wup = (bf16*)(ws + WS_WUP), *Wdn = (bf16*)(ws + WS_WDN);
    bf16 *HN = (bf16*)(ws + WS_HN), *G = (bf16*)(ws + WS_G), *QKV = (bf16*)(ws + WS_QKV), *O = (bf16*)(ws + WS_O), *QKC = (bf16*)(ws + WS_QKC), *U = (bf16*)(ws + WS_U);
    bf16* OG = (bf16*)(ws + WS_QKC); float* LSE = (float*)(ws + WS_G);
    float* SSQ = (float*)(ws + WS_SSQ); float* GWT = (float*)(ws + WS_GWT); bf16* XR = (bf16*)(ws + WS_XR);
    float *GATES = (float*)(ws + WS_GATES), *SU = (float*)(ws + WS_SU), *SM = (float*)(ws + WS_SM), *SE = (float*)(ws + WS_SE);

    const int lo = args.ph_lo, hi = args.ph_hi;
#define IN(k) (lo <= (k) && (k) < hi)

    int ph = 0;
#ifndef PROBE_MASK
#define PROBE_MASK 0u
#endif
#define PHASE(body) do { if (IN(ph)) { body; if ((PROBE_MASK >> ph) & 1u) { body; } } if (IN(ph) && IN(ph + 1)) xcd_barrier(bar); ++ph; } while (0)
    PHASE(
        p_convert(F, w_qkv, Wqkv, DM, NQKV, NQKV);
        p_convert(F, w_o, Wo, DM, DM, DM);
        p_convert(F, w_in, Win, DM, INW, INW_MAIN);
        p_convert(F, w_out, Wout, DM, DM, DM);
        p_convert(F, w_up, Wup, DM, FFN2, FFN2, true, 0, 0, ffn_norm);
        p_convert(F, w_down, Wdn, FFN, DM, DM);
        p_pack_gates(F, w_in, GWT);
        p_rmsnorm<false>(F, x, attn_norm, HN, nullptr, nullptr, nullptr));
    PHASE(p_gemm_qkv(F, HN, Wqkv, q_gain, k_gain, QKV));
    PHASE(p_attn(F, QKV, q_gain, k_gain, OG, LSE));
    PHASE(p_attn_combine(F, OG, LSE, O));
    PHASE((p_gemm_res<false, true, true>(F, O, Wo, DM, DM, x, XR, SSQ)));
    PHASE(p_gemm_convgate(F, XR, Wup, fconv_w, fconv_b, G, SSQ));
    PHASE((p_gemm_res<true, true, false>(F, G, Wdn, DM, FFN, XR, XR)));
    PHASE(p_rmsnorm<true>(F, XR, lstm_norm, HN, GWT, gate_bias, GATES));
    PHASE(p_gemm_bf16(F, HN, Win, INW_MAIN, DM, QKV));
    PHASE(p_lstm_scan2(F, GATES, SU, SM, SE); p_lstm_conv(F, QKV, lconv_w, lconv_b, QKC));
    PHASE(p_lstm_state(F, QKC, QKV, SU, SM, ws + WS_CST, (float*)(ws + WS_NST));
          p_convert(F, w_up + (size_t)DM * FFN2, Wup + (size_t)FFN2 * DM, DM, FFN2, FFN2, true, 8 * NSL, F.G - 8 * NSL, ffn_norm + DM);
          p_convert(F, w_down + (size_t)FFN * DM, Wdn + (size_t)DM * FFN, FFN, DM, DM, false, 8 * NSL, F.G - 8 * NSL));
    PHASE(p_lstm_out(F, QKC, QKV, SU, SM, SE, ws + WS_CST, (const float*)(ws + WS_NST), head_gain, O));
    PHASE((p_gemm_res<true, true, true>(F, O, Wout, DM, DM, XR, XR, SSQ)));
    PHASE(p_gemm_convgate(F, XR, Wup + (size_t)FFN2 * DM, fconv_w + 3 * FFN2, fconv_b + FFN2, G, SSQ));
    PHASE((p_gemm_res<true, false, false>(F, G, Wdn + (size_t)DM * FFN, DM, FFN, XR, out)));
#undef PHASE
#undef IN
}

extern "C" void kernel_launch(void* const* d_in, const int* in_sizes, int n_in, void* d_out, int out_size, void* d_ws, size_t ws_size, hipStream_t stream) {
    static int grid = 0;
    if (grid == 0) {
        if (n_in != 18 || in_sizes[0] != MROWS * DM || out_size != MROWS * DM || ws_size < WS_END) { fprintf(stderr, "kernel_launch: unexpected problem (n_in %d, ws %zu < %zu)\n", n_in, ws_size, (size_t)WS_END); grid = -1; return; }
        int dev = 0, cus = 0, per_cu = 0;
        if (hipGetDevice(&dev) != hipSuccess || hipDeviceGetAttribute(&cus, hipDeviceAttributeMultiprocessorCount, dev) != hipSuccess) { grid = -1; return; }
        if (hipFuncSetAttribute((const void*)mega, hipFuncAttributeMaxDynamicSharedMemorySize, LDS_BYTES) != hipSuccess) { fprintf(stderr, "kernel_launch: hipFuncSetAttribute failed\n"); grid = -1; return; }
        if (hipOccupancyMaxActiveBlocksPerMultiprocessor(&per_cu, (const void*)mega, NTHREADS, LDS_BYTES) != hipSuccess || per_cu < 1) { fprintf(stderr, "kernel_launch: occupancy query says %d\n", per_cu); per_cu = 1; }
        (void)hipGetLastError();
        grid = cus;
    }
    if (grid < 0) return;
    if (hipMemsetAsync((char*)d_ws + WS_CTL, 0, CTL_ZERO_BYTES, stream) != hipSuccess) return;
    Args a; memset(&a, 0, sizeof(a));
    for (int i = 0; i < 18; ++i) a.in[i] = (const float*)d_in[i];
    a.out = (float*)d_out; a.ws = (unsigned char*)d_ws; a.ph_lo = 0; a.ph_hi = N_PHASES;
    void* kargs[] = {&a};
    hipError_t e = hipLaunchCooperativeKernel((const void*)mega, dim3(grid), dim3(NTHREADS), kargs, LDS_BYTES, stream);
    if (e != hipSuccess) { fprintf(stderr, "kernel_launch: cooperative launch failed: %s; plain launch instead\n", hipGetErrorString(e)); (void)hipGetLastError();
        hipLaunchKernelGGL(mega, dim3(grid), dim3(NTHREADS), LDS_BYTES, stream, a); }
}
```

```cpp
#include <hip/hip_runtime.h>
#include <cstdio>
#include <cstdint>
#include <cstring>

namespace pg8 {
#define PG8_LAS __attribute__((address_space(3)))
typedef unsigned short bf16_t;
typedef short bf16x8 __attribute__((ext_vector_type(8)));
typedef float f32x4 __attribute__((ext_vector_type(4)));
typedef unsigned u32x4 __attribute__((ext_vector_type(4)));
constexpr int BM = 256, BK = 64, HALF = 128, HTB = HALF * BK * 2  , STAGE_BYTES = 8 * HTB, NXCD = 8, WGM = 8;

__host__ __device__ __forceinline__ int lds_byte(int r, int c) { const int st = (r >> 4) * 2 + (c >> 5), rr = r & 15, cc = c & 31, ob = rr * 64 + cc * 2; return st * 1024 + (ob ^ (((ob >> 9) & 1) << 5)); }
__host__ __device__ __forceinline__ void stage_rc(int b, int& R, int& C) { const int st = b / 1024, sb = b % 1024, swz = sb ^ (((sb >> 9) & 1) << 5); R = (st >> 1) * 16 + swz / 64; C = (st & 1) * 32 + (swz % 64) / 2; }
__host__ __device__ __forceinline__ int perm32(int rho) { const int n = rho >> 4, i = rho & 15; return 8 * (i >> 2) + 4 * n + (i & 3); }

struct Unit { int pm, pn; };
struct Gemm { const bf16_t* A; const bf16_t* Bt; int M, N, K; };

struct StaticOrder {
    int nM, nN, nwg, G, c;
    __host__ __device__ void init(int M, int N, int G_, int c_) { nM = M / BM; nN = N / BM; nwg = nM * nN; G = G_; c = c_; }
    __host__ __device__ void init_tiles(int nM_, int nN_, int G_, int c_) { nM = nM_; nN = nN_; nwg = nM * nN; G = G_; c = c_; }
    __host__ __device__ bool next(int i, Unit& u) const {
        const long L = (long)i * G + c; if (L >= nwg) return false;
        int wgid = (int)L; { const int q = nwg / NXCD, r = nwg % NXCD, xcd = wgid % NXCD, off = wgid / NXCD; wgid = (xcd < r ? xcd * (q + 1) : r * (q + 1) + (xcd - r) * q) + off; }
        const int nig = WGM * nN, gid = wgid / nig, fm = gid * WGM, gsz = (nM - fm) < WGM ? (nM - fm) : WGM;
        u.pm = fm + ((wgid % nig) % gsz); u.pn = (wgid % nig) / gsz; return true;
    }
    __device__ __forceinline__ void a_ready(const Unit&) const {}
    __device__ __forceinline__ void done(const Unit&) const {}
};
__device__ __forceinline__ unsigned cvt_pk_bf16(float lo, float hi) { unsigned r; asm volatile("v_cvt_pk_bf16_f32 %0, %1, %2" : "=v"(r) : "v"(lo), "v"(hi)); return r; }
typedef float f32x2 __attribute__((ext_vector_type(2)));
__device__ __forceinline__ f32x2 gelu_pk(f32x2 v) {
    const f32x2 av = __builtin_elementwise_abs(v), d = av * 0.2316418882f + 1.0f;
    f32x2 t; t.x = __builtin_amdgcn_rcpf(d.x); t.y = __builtin_amdgcn_rcpf(d.y);
    f32x2 q = t * 0.5307027145f + (-0.7265760135f); q = q * t + 0.7107068705f; q = q * t + (-0.142248368f); q = q * t + 0.127414796f; q = q * t;
    const f32x2 s = (v * v) * (-0.72134752044f);
    f32x2 e; e.x = __builtin_amdgcn_exp2f(s.x); e.y = __builtin_amdgcn_exp2f(s.y);
    const f32x2 m = v * (q * e), r = v - m;
    f32x2 o; o.x = v.x < 0.f ? m.x : r.x; o.y = v.y < 0.f ? m.y : r.y; return o;
}

template <int ACT  > struct EpiBf16 {
    static constexpr bool PERM = true, AFTER_DRAIN = false, ACC_INIT = false; static_assert(ACT == 0 || ACT == 1, "EpiBf16: ACT is 0 (none) or 1 (gelu_pk)");
    static __host__ __device__ __forceinline__ int a_row0(int pm) { return pm * BM; }
    static __host__ __device__ __forceinline__ int b_row0(int pn) { return pn * BM; }
    bf16_t* O; int ldc; const float* bias; int split_cols; size_t split_stride; float scale0;
    __device__ __forceinline__ void operator()(const f32x4 (&acc)[2][2][4][2], const Unit& u, int wr, int wc, int fr, int fq, int ui) const {
        const int row0 = u.pm * BM + wr * 64 + fr; int colt = u.pn * BM; bf16_t* base = O;
        float sc = 1.f; if (split_cols) { const int t = colt / split_cols; base += (size_t)t * split_stride; colt -= t * split_cols; if (t == 0) sc = scale0; }
        const int col0 = colt + wc * 32 + 8 * fq, bcol0 = u.pn * BM + wc * 32 + 8 * fq;
        f32x4 bv[2][2];
#pragma unroll
        for (int bj = 0; bj < 2; ++bj)
#pragma unroll
            for (int n = 0; n < 2; ++n) bv[bj][n] = bias ? *(const f32x4*)(bias + bcol0 + bj * HALF + 4 * n) : (f32x4){0.f, 0.f, 0.f, 0.f};
#pragma unroll
        for (int ai = 0; ai < 2; ++ai)
#pragma unroll
            for (int m = 0; m < 4; ++m) { bf16_t* rowp = base + (size_t)(row0 + ai * HALF + m * 16) * ldc + col0;
#pragma unroll
                for (int bj = 0; bj < 2; ++bj) { f32x4 v0 = acc[ai][bj][m][0] + bv[bj][0], v1 = acc[ai][bj][m][1] + bv[bj][1];
                    if (ACT == 1) { f32x2 a = gelu_pk((f32x2){v0[0], v0[1]}), b = gelu_pk((f32x2){v0[2], v0[3]}), c = gelu_pk((f32x2){v1[0], v1[1]}), d = gelu_pk((f32x2){v1[2], v1[3]});
                        v0 = (f32x4){a.x, a.y, b.x, b.y}; v1 = (f32x4){c.x, c.y, d.x, d.y}; }
                    v0 = v0 * sc; v1 = v1 * sc; u32x4 w; w.x = cvt_pk_bf16(v0[0], v0[1]); w.y = cvt_pk_bf16(v0[2], v0[3]); w.z = cvt_pk_bf16(v1[0], v1[1]); w.w = cvt_pk_bf16(v1[2], v1[3]);
                    *(u32x4*)(rowp + bj * HALF) = w; } }
    }
};
template <bool RB_IN, bool RB_OUT, bool WITH_SSQ> struct EpiRes {
    static constexpr bool PERM = true, AFTER_DRAIN = false, ACC_INIT = true;
    static __host__ __device__ __forceinline__ int a_row0(int pm) { return pm * BM; }
    static __host__ __device__ __forceinline__ int b_row0(int pn) { return pn * BM; }
    const void* base; void* out; int ldc; float* ssq;
    static __device__ __forceinline__ f32x4 up2(unsigned lo, unsigned hi) { return (f32x4){__builtin_bit_cast(float, lo << 16), __builtin_bit_cast(float, lo & 0xffff0000u), __builtin_bit_cast(float, hi << 16), __builtin_bit_cast(float, hi & 0xffff0000u)}; }
    __device__ __forceinline__ void init(f32x4 (&acc)[2][2][4][2], const Unit& u, int wr, int wc, int fr, int fq) const {
        const int row0 = u.pm * BM + wr * 64 + fr, col0 = u.pn * BM + wc * 32 + 8 * fq;
#pragma unroll
        for (int ai = 0; ai < 2; ++ai)
#pragma unroll
            for (int m = 0; m < 4; ++m) { const size_t ro = (size_t)(row0 + ai * HALF + m * 16) * ldc + col0;
#pragma unroll
                for (int bj = 0; bj < 2; ++bj) { const size_t o = ro + bj * HALF;
                    if constexpr (RB_IN) { const u32x4 w = *(const u32x4*)((const bf16_t*)base + o); acc[ai][bj][m][0] = up2(w.x, w.y); acc[ai][bj][m][1] = up2(w.z, w.w); }
                    else { acc[ai][bj][m][0] = *(const f32x4*)((const float*)base + o); acc[ai][bj][m][1] = *(const f32x4*)((const float*)base + o + 4); } } }
    }
    __device__ __forceinline__ void operator()(const f32x4 (&acc)[2][2][4][2], const Unit& u, int wr, int wc, int fr, int fq, int ui) const {
        const int row0 = u.pm * BM + wr * 64 + fr, col0 = u.pn * BM + wc * 32 + 8 * fq;
#pragma unroll
        for (int ai = 0; ai < 2; ++ai)
#pragma unroll
            for (int m = 0; m < 4; ++m) { const size_t ro = (size_t)(row0 + ai * HALF + m * 16) * ldc + col0; float q = 0.f;
#pragma unroll
                for (int bj = 0; bj < 2; ++bj) { const size_t o = ro + bj * HALF; const f32x4 v0 = acc[ai][bj][m][0], v1 = acc[ai][bj][m][1];
                    if constexpr (RB_OUT) { u32x4 w; w.x = cvt_pk_bf16(v0[0], v0[1]); w.y = cvt_pk_bf16(v0[2], v0[3]); w.z = cvt_pk_bf16(v1[0], v1[1]); w.w = cvt_pk_bf16(v1[2], v1[3]); *(u32x4*)((bf16_t*)out + o) = w; }
                    else { *(f32x4*)((float*)out + o) = v0; *(f32x4*)((float*)out + o + 4) = v1; }
                    if constexpr (WITH_SSQ) q += ((v0[0] * v0[0] + v0[1] * v0[1]) + (v0[2] * v0[2] + v0[3] * v0[3])) + ((v1[0] * v1[0] + v1[1] * v1[1]) + (v1[2] * v1[2] + v1[3] * v1[3])); }
                if constexpr (WITH_SSQ) { q += __shfl_xor(q, 16); q += __shfl_xor(q, 32); if (fq == 0) ssq[(size_t)(row0 + ai * HALF + m * 16) * 32 + 4 * u.pn + wc] = q; } }
    }
};
struct EpiQKV {
    static constexpr bool PERM = true, AFTER_DRAIN = false, ACC_INIT = false;
    static __host__ __device__ __forceinline__ int a_row0(int pm) { return pm * BM; }
    static __host__ __device__ __forceinline__ int b_row0(int pn) { return pn * BM; }
    bf16_t* O; int ldc; const float* qg; const float* kg; PG8_LAS float* part; float qscale;
    __device__ __forceinline__ void operator()(const f32x4 (&acc)[2][2][4][2], const Unit& u, int wr, int wc, int fr, int fq, int ui) const {
        const int kind = u.pn >> 3;
        const int row0 = u.pm * BM + wr * 64 + fr, col0 = u.pn * BM + wc * 32 + 8 * fq;
        if (kind < 2) {
#pragma unroll
            for (int ai = 0; ai < 2; ++ai)
#pragma unroll
                for (int m = 0; m < 4; ++m)
#pragma unroll
                    for (int bj = 0; bj < 2; ++bj) { const f32x4 a = acc[ai][bj][m][0], b = acc[ai][bj][m][1];
                        float q = ((a[0] * a[0] + a[1] * a[1]) + (a[2] * a[2] + a[3] * a[3])) + ((b[0] * b[0] + b[1] * b[1]) + (b[2] * b[2] + b[3] * b[3]));
                        q += __shfl_xor(q, 16); q += __shfl_xor(q, 32);
                        if (fq == 0) part[((ai * HALF + wr * 64 + m * 16 + fr) * 2 + bj) * 4 + wc] = q; }
        }
        asm volatile("s_waitcnt lgkmcnt(0)" ::: "memory"); __builtin_amdgcn_s_barrier(); asm volatile("" ::: "memory");
        f32x4 g0 = (f32x4){1.f, 1.f, 1.f, 1.f}, g1 = g0;
        if (kind < 2) { const float* gp = (kind == 0 ? qg : kg) + wc * 32 + 8 * fq; g0 = *(const f32x4*)gp; g1 = *(const f32x4*)(gp + 4); }
        const float sc = (kind == 0) ? qscale : 1.f;
#pragma unroll
        for (int ai = 0; ai < 2; ++ai)
#pragma unroll
            for (int m = 0; m < 4; ++m) { bf16_t* rowp = O + (size_t)(row0 + ai * HALF + m * 16) * ldc + col0;
#pragma unroll
                for (int bj = 0; bj < 2; ++bj) { float rs = 1.f;
                    if (kind < 2) { const f32x4 pp = *(const PG8_LAS f32x4*)(part + ((ai * HALF + wr * 64 + m * 16 + fr) * 2 + bj) * 4); rs = sc * __builtin_amdgcn_rsqf(((pp[0] + pp[1]) + (pp[2] + pp[3])) * (1.f / 128.f) + 1e-6f); }
                    const f32x4 v0 = acc[ai][bj][m][0] * g0 * rs, v1 = acc[ai][bj][m][1] * g1 * rs;
                    u32x4 w; w.x = cvt_pk_bf16(v0[0], v0[1]); w.y = cvt_pk_bf16(v0[2], v0[3]); w.z = cvt_pk_bf16(v1[0], v1[1]); w.w = cvt_pk_bf16(v1[2], v1[3]);
                    *(u32x4*)(rowp + bj * HALF) = w; } }
    }
};
__device__ __forceinline__ float dpp_ror1(float v) { return __builtin_bit_cast(float, __builtin_amdgcn_mov_dpp(__builtin_bit_cast(int, v), 0x121, 0xf, 0xf, true)); }
__device__ __forceinline__ float dpp_ror2(float v) { return __builtin_bit_cast(float, __builtin_amdgcn_mov_dpp(__builtin_bit_cast(int, v), 0x122, 0xf, 0xf, true)); }
struct EpiConvGate {
    static constexpr bool PERM = true, AFTER_DRAIN = false, ACC_INIT = false;
    static constexpr int TPS = 17, TSTRIDE = 241, SEQL = 4096, FF = 5632;
    static __host__ __device__ __forceinline__ int a_row0(int pm) { return (pm / TPS) * SEQL + (pm % TPS) * TSTRIDE - 2; }
    static __host__ __device__ __forceinline__ int b_row0(int pn) { return pn * BM; }
    bf16_t* G; const float* cw; const float* cb; PG8_LAS float* tails; const float* ssq;
    __device__ __forceinline__ void operator()(const f32x4 (&acc)[2][2][4][2], const Unit& u, int wr, int wc, int fr, int fq, int ui) const {
        const int wid = wr * 4 + wc, seq = u.pm / TPS, tbase = (u.pm % TPS) * TSTRIDE - 2;
        const int ch0 = 128 * u.pn + 32 * wc + 8 * fq;
        if (fr >= 14) {
#pragma unroll
            for (int ai = 0; ai < 2; ++ai)
#pragma unroll
                for (int bj = 0; bj < 2; ++bj)
#pragma unroll
                    for (int n = 0; n < 2; ++n) *(PG8_LAS f32x4*)(tails + (((wid * 2 + ai) * 2 + (fr - 14)) * 2 + bj) * 32 + fq * 8 + n * 4) = acc[ai][bj][3][n];
        }
        const PG8_LAS float* rsl = tails + 2048 + 256 * ui;
        PG8_LAS float* coef = tails + 2048 + 12 * 256;
        { const int tid_ = threadIdx.x; if (tid_ < 256) { const int a_ = tid_ >> 5, c_ = tid_ & 31;
            const float* src = (a_ < 6 ? cw + (a_ >> 1) * 2 * FF : cb) + (a_ & 1) * FF + 128 * u.pn + 4 * c_;
            *(PG8_LAS f32x4*)(coef + a_ * 128 + 4 * c_) = *(const f32x4*)src; } }
        asm volatile("s_waitcnt lgkmcnt(0)" ::: "memory"); __builtin_amdgcn_s_barrier(); asm volatile("" ::: "memory");
        const bool is15 = (fr == 15), ge14 = (fr >= 14);
#pragma unroll
        for (int ai = 0; ai < 2; ++ai) {
            const bool has_src = !(ai == 0 && wr == 0);
            const int swid = (wr ^ 1) * 4 + wc, sai = (wr == 1) ? ai : ai - 1;
#pragma unroll
            for (int n = 0; n < 2; ++n) {
                f32x4 gv[4];
#pragma unroll
                for (int bj = 0; bj < 2; ++bj) {
                    const PG8_LAS float* cfp = coef + bj * 128 + 32 * wc + 8 * fq + 4 * n;
                    const f32x4 w0 = *(const PG8_LAS f32x4*)cfp, w1 = *(const PG8_LAS f32x4*)(cfp + 256), w2 = *(const PG8_LAS f32x4*)(cfp + 512), bb = *(const PG8_LAS f32x4*)(cfp + 768);
                    f32x4 prev = (f32x4){0.f, 0.f, 0.f, 0.f};
                    if (ge14 && has_src) { prev = *(const PG8_LAS f32x4*)(tails + (((swid * 2 + sai) * 2 + (fr - 14)) * 2 + bj) * 32 + fq * 8 + n * 4);
                        if (ssq) prev = prev * rsl[128 * ai + 64 * wr - 16 + fr]; }
#pragma unroll
                    for (int m = 0; m < 4; ++m) {
                        f32x4 cur = acc[ai][bj][m][n]; if (ssq) cur = cur * rsl[128 * ai + 64 * wr + 16 * m + fr];
                        const int t = tbase + 128 * ai + 64 * wr + 16 * m + fr;
                        f32x4 cv;
#pragma unroll
                        for (int e = 0; e < 4; ++e) {
                            float p1 = dpp_ror1(is15 ? prev[e] : cur[e]), p2 = dpp_ror2(ge14 ? prev[e] : cur[e]);
                            if (ai == 0 && m == 0) { p1 = (t >= 1) ? p1 : 0.f; p2 = (t >= 2) ? p2 : 0.f; }
                            cv[e] = bb[e] + w0[e] * p2 + w1[e] * p1 + w2[e] * cur[e]; }
                        if (bj == 0) {
#pragma unroll
                            for (int e = 0; e < 4; ++e) gv[m][e] = cv[e] * __builtin_amdgcn_rcpf(1.f + __expf(-cv[e]));
                        } else { const f32x4 o = gv[m] * cv; const int rl = 128 * ai + 64 * wr + 16 * m + fr;
                            if (rl >= 2 && rl < 2 + TSTRIDE && t < SEQL) { typedef unsigned u32x2 __attribute__((ext_vector_type(2))); u32x2 w; w.x = cvt_pk_bf16(o[0], o[1]); w.y = cvt_pk_bf16(o[2], o[3]);
                                *(u32x2*)(G + (size_t)(seq * SEQL + t) * FF + ch0 + 4 * n) = w; } }
                        prev = cur;
                    }
                }
            }
        }
    }
};
struct EpiConvGateT {
    static constexpr bool PERM = true, AFTER_DRAIN = false, ACC_INIT = false;
    static constexpr int TPS = 17, TSTRIDE = 241, SEQL = 4096, FF = 5632;
    static __host__ __device__ __forceinline__ int a_row0(int pm) { return pm * BM; }
    static __host__ __device__ __forceinline__ int b_row0(int pn) { return (pn / TPS) * SEQL + (pn % TPS) * TSTRIDE - 2; }
    bf16_t* G; const float* cw; const float* cb; PG8_LAS float* xl;
    __device__ __forceinline__ void operator()(f32x4 (&acc)[2][2][4][2], const Unit& u, int wr, int wc, int fr, int fq, int ui) const {
        const int wid = wr * 4 + wc, lane = fq * 16 + fr, seq = u.pn / TPS, tbase = (u.pn % TPS) * TSTRIDE - 2;
        PG8_LAS unsigned* tails = (PG8_LAS unsigned*)xl; PG8_LAS unsigned short* ob = (PG8_LAS unsigned short*)(xl + 2048) + wid * 512; PG8_LAS float* coef = xl + 4096; const PG8_LAS float* rsl = xl + 5120 + 256 * ui;
#pragma unroll
        for (int bj = 0; bj < 2; ++bj) { const f32x4 r0 = *(const PG8_LAS f32x4*)(rsl + 128 * bj + 32 * wc + 8 * fq), r1 = *(const PG8_LAS f32x4*)(rsl + 128 * bj + 32 * wc + 8 * fq + 4);
#pragma unroll
            for (int ai = 0; ai < 2; ++ai)
#pragma unroll
                for (int m = 0; m < 4; ++m) { acc[ai][bj][m][0] = acc[ai][bj][m][0] * r0; acc[ai][bj][m][1] = acc[ai][bj][m][1] * r1; } }
        if (fq == 3) {
#pragma unroll
            for (int bj = 0; bj < 2; ++bj)
#pragma unroll
                for (int ai = 0; ai < 2; ++ai)
#pragma unroll
                    for (int m = 0; m < 4; ++m) tails[((wid * 2 + bj) * 8 + ai * 4 + m) * 16 + fr] = cvt_pk_bf16(acc[ai][bj][m][1][2], acc[ai][bj][m][1][3]);
        }
        { const int tid_ = threadIdx.x; if (tid_ < 256) { const int a_ = tid_ >> 5, c_ = tid_ & 31, up_ = a_ >> 2, j_ = a_ & 3;
            const float* src = (j_ < 3 ? cw + j_ * 2 * FF : cb) + up_ * FF + 128 * u.pm + 4 * c_;
            *(PG8_LAS f32x4*)(coef + a_ * 128 + 4 * c_) = *(const f32x4*)src; } }
        asm volatile("s_waitcnt lgkmcnt(0)" ::: "memory"); __builtin_amdgcn_s_barrier(); asm volatile("" ::: "memory");
#pragma unroll
        for (int bj = 0; bj < 2; ++bj) {
            const bool has_src = (wc > 0) || (bj == 1);
            const int swid = (wc > 0) ? wid - 1 : wr * 4 + 3, sbj = (wc > 0) ? bj : 0;
            const bool firstgrp = (tbase < 0) && (bj == 0) && (wc == 0) && (fq == 0);
#pragma unroll
            for (int mp = 0; mp < 2; ++mp) {
                unsigned pk[2][2][2];
#pragma unroll
                for (int mq = 0; mq < 2; ++mq) { const int m = 2 * mp + mq;
                    float cv[2][8];
#pragma unroll
                    for (int ai = 0; ai < 2; ++ai) {
                        float sq[8];
#pragma unroll
                        for (int j = 0; j < 8; ++j) sq[j] = acc[ai][bj][m][j >> 2][j & 3];
                        float p6 = __shfl_up(sq[6], 16), p7 = __shfl_up(sq[7], 16);
                        if (fq == 0) { unsigned tv = 0u; if (has_src) tv = tails[((swid * 2 + sbj) * 8 + ai * 4 + m) * 16 + fr];
                            p6 = __builtin_bit_cast(float, tv << 16); p7 = __builtin_bit_cast(float, tv & 0xffff0000u); }
                        if (firstgrp) { sq[0] = 0.f; sq[1] = 0.f; }
                        const PG8_LAS float* cf = coef + ai * 512 + 64 * wr + 16 * m + fr; const float w0 = cf[0], w1 = cf[128], w2 = cf[256], bb = cf[384];
                        cv[ai][0] = bb + w0 * p6 + w1 * p7 + w2 * sq[0];
                        cv[ai][1] = bb + w0 * p7 + w1 * sq[0] + w2 * sq[1];
#pragma unroll
                        for (int j = 2; j < 8; ++j) cv[ai][j] = bb + w0 * sq[j - 2] + w1 * sq[j - 1] + w2 * sq[j];
                    }
                    float o[8];
#pragma unroll
                    for (int j = 0; j < 8; ++j) o[j] = cv[0][j] * __builtin_amdgcn_rcpf(1.f + __expf(-cv[0][j])) * cv[1][j];
#pragma unroll
                    for (int n = 0; n < 2; ++n) { pk[mq][n][0] = cvt_pk_bf16(o[4 * n], o[4 * n + 1]); pk[mq][n][1] = cvt_pk_bf16(o[4 * n + 2], o[4 * n + 3]); }
                }
#pragma unroll
                for (int n = 0; n < 2; ++n) {
#pragma unroll
                    for (int mq = 0; mq < 2; ++mq) {
                        ob[(4 * fq + 0) * 32 + 16 * mq + fr] = (unsigned short)(pk[mq][n][0] & 0xffffu); ob[(4 * fq + 1) * 32 + 16 * mq + fr] = (unsigned short)(pk[mq][n][0] >> 16);
                        ob[(4 * fq + 2) * 32 + 16 * mq + fr] = (unsigned short)(pk[mq][n][1] & 0xffffu); ob[(4 * fq + 3) * 32 + 16 * mq + fr] = (unsigned short)(pk[mq][n][1] >> 16); }
                    asm volatile("s_waitcnt lgkmcnt(0)" ::: "memory");
                    { const int trow = lane >> 2, chunk = lane & 3; const u32x4 v = *(const PG8_LAS u32x4*)(ob + trow * 32 + chunk * 8);
                      const int tl = 128 * bj + 32 * wc + 8 * (trow >> 2) + 4 * n + (trow & 3), t = tbase + tl;
                      asm volatile("s_waitcnt lgkmcnt(0)" ::: "memory");
                      if (tl >= 2 && tl < 2 + TSTRIDE && t < SEQL) *(u32x4*)(G + (size_t)(seq * SEQL + t) * FF + 128 * u.pm + 64 * wr + 32 * mp + 8 * chunk) = v; }
                }
            }
        }
    }
};
template <class Epi, class Sched, bool ALIGN_EPI = false, bool SP2 = false>
__device__ __forceinline__ void gemm_phase(PG8_LAS unsigned char* lds, const Gemm g, const Sched& S, const Epi& E) {
    const int tid = threadIdx.x, wid = __builtin_amdgcn_readfirstlane(tid >> 6), lane = tid & 63, wr = wid >> 2, wc = wid & 3, fr = lane & 15, fq = lane >> 4;
    const int K = g.K, nt = K / BK;
    unsigned voffA[2], voffB[2];
#pragma unroll
    for (int i = 0; i < 2; ++i) { int R, C; stage_rc(tid * 16 + i * 8192, R, C); const int Rb = Epi::PERM ? ((R & ~31) + perm32(R & 31)) : R;
        voffA[i] = (unsigned)(R * K + C) * 2u; voffB[i] = (unsigned)(Rb * K + C) * 2u; }
    const size_t kstep = (size_t)(BK * 2);
    const size_t hstep = (size_t)HALF * K * 2;
    const size_t tstep = 2 * hstep;
    const unsigned ldsw = (unsigned)wid * 1024u;
    const int aoff = lds_byte(wr * 64 + fr, fq * 8), boff = lds_byte(wc * 32 + fr, fq * 8);
#define PG8_SA(b, h) (((b) * 2 + (h)) * HTB)
#define PG8_SB(b, h) ((4 + (b) * 2 + (h)) * HTB)
#define PG8_STAGE(bufoff, gbase, voff) do { _Pragma("unroll") for (int _i = 0; _i < 2; ++_i) \
        __builtin_amdgcn_global_load_lds((const unsigned*)((const char*)(gbase) + (voff)[_i]), (PG8_LAS unsigned*)(lds + (bufoff) + ldsw + _i * 8192), 16, 0, 0); } while (0)
#define PG8_LDA(dst, b, h) do { _Pragma("unroll") for (int m = 0; m < 4; ++m) _Pragma("unroll") for (int k = 0; k < 2; ++k) dst[m][k] = *(const PG8_LAS bf16x8*)(lds + PG8_SA(b, h) + aoff + m * 2048 + k * 1024); } while (0)
#define PG8_LDB(dst, b, h) do { _Pragma("unroll") for (int n = 0; n < 2; ++n) _Pragma("unroll") for (int k = 0; k < 2; ++k) dst[n][k] = *(const PG8_LAS bf16x8*)(lds + PG8_SB(b, h) + boff + n * 2048 + k * 1024); } while (0)
#define PG8_MMA(ai, bj, At, Bt) do { __builtin_amdgcn_s_setprio(1); _Pragma("unroll") for (int m = 0; m < 4; ++m) _Pragma("unroll") for (int n = 0; n < 2; ++n) _Pragma("unroll") for (int k = 0; k < 2; ++k) \
        acc[ai][bj][m][n] = __builtin_amdgcn_mfma_f32_16x16x32_bf16(Bt[n][k], At[m][k], acc[ai][bj][m][n], 0, 0, 0); __builtin_amdgcn_s_setprio(0); } while (0)
#define PG8_WAIT_V(n) asm volatile("s_waitcnt vmcnt(" #n ")" ::: "memory")
#define PG8_WAIT_L(n) asm volatile("s_waitcnt lgkmcnt(" #n ")" ::: "memory")
#define PG8_BAR __builtin_amdgcn_s_barrier()
#define PG8_SCHED __builtin_amdgcn_sched_barrier(0)
    Unit cur, nxt; int ui = 0;
    if (!S.next(0, cur)) return;
    f32x4 acc[2][2][4][2];
    if constexpr (Epi::ACC_INIT) E.init(acc, cur, wr, wc, fr, fq); else {
#pragma unroll
    for (int a = 0; a < 2; ++a)
#pragma unroll
        for (int b = 0; b < 2; ++b)
#pragma unroll
            for (int m = 0; m < 4; ++m)
#pragma unroll
                for (int n = 0; n < 2; ++n) acc[a][b][m][n] = (f32x4){0.f, 0.f, 0.f, 0.f}; }
    bf16x8 At[4][2], B0[2][2], B1[2][2];
    const char* cA = (const char*)g.A + (long)Epi::a_row0(cur.pm) * (long)(K * 2); const char* cB = (const char*)g.Bt + (long)Epi::b_row0(cur.pn) * (long)(K * 2);
    S.a_ready(cur);
    if constexpr (SP2) {
        PG8_STAGE(PG8_SB(0, 0), cB, voffB); PG8_STAGE(PG8_SB(0, 1), cB + hstep, voffB); PG8_STAGE(PG8_SA(0, 0), cA, voffA); PG8_STAGE(PG8_SA(0, 1), cA + hstep, voffA);
        if (wr == 1) PG8_BAR;
        PG8_WAIT_V(2); PG8_BAR;
        PG8_STAGE(PG8_SB(1, 0), cB + kstep, voffB); PG8_STAGE(PG8_SA(1, 0), cA + kstep, voffA); PG8_STAGE(PG8_SB(1, 1), cB + hstep + kstep, voffB);
        PG8_WAIT_V(6); PG8_BAR;
    } else {
        PG8_STAGE(PG8_SB(0, 0), cB, voffB); PG8_STAGE(PG8_SA(0, 0), cA, voffA); PG8_STAGE(PG8_SB(0, 1), cB + hstep, voffB); PG8_STAGE(PG8_SA(0, 1), cA + hstep, voffA);
        if (wr == 1) PG8_BAR;
        PG8_WAIT_V(4); PG8_BAR;
        PG8_STAGE(PG8_SB(1, 0), cB + kstep, voffB); PG8_STAGE(PG8_SA(1, 0), cA + kstep, voffA); PG8_STAGE(PG8_SB(1, 1), cB + hstep + kstep, voffB);
        PG8_WAIT_V(6); PG8_BAR;
    }
    for (;;) {
        const bool has_next = S.next(ui + 1, nxt);
        const char* nA = has_next ? (const char*)g.A + (long)Epi::a_row0(nxt.pm) * (long)(K * 2) : cA; const char* nB = has_next ? (const char*)g.Bt + (long)Epi::b_row0(nxt.pn) * (long)(K * 2) : cB;
        for (int t = 0; t < nt; t += 2) {
            const bool last = (t == nt - 2);
            const char* a1 = cA + (size_t)(t + 1) * kstep;
            const char* a2 = last ? nA : cA + (size_t)(t + 2) * kstep; const char* b2 = last ? nB : cB + (size_t)(t + 2) * kstep;
            const char* a3 = a2 + kstep; const char* b3 = b2 + kstep;
            if (last && has_next) S.a_ready(nxt);
            if constexpr (SP2) {
            PG8_LDB(B0, 0, 0); PG8_LDB(B1, 0, 1); PG8_SCHED; PG8_LDA(At, 0, 0); PG8_STAGE(PG8_SA(1, 1), a1 + hstep, voffA);
            PG8_WAIT_V(8); PG8_WAIT_L(0); PG8_BAR; PG8_MMA(0, 0, At, B0); PG8_MMA(0, 1, At, B1); PG8_BAR; PG8_SCHED;
            PG8_LDA(At, 0, 1); PG8_STAGE(PG8_SB(0, 0), b2, voffB); PG8_STAGE(PG8_SB(0, 1), b2 + hstep, voffB); PG8_STAGE(PG8_SA(0, 0), a2, voffA);
            PG8_WAIT_V(8); PG8_WAIT_L(0); PG8_BAR; PG8_MMA(1, 0, At, B0); PG8_MMA(1, 1, At, B1); PG8_BAR; PG8_SCHED;
            PG8_LDB(B0, 1, 0); PG8_LDB(B1, 1, 1); PG8_SCHED; PG8_LDA(At, 1, 0); PG8_STAGE(PG8_SA(0, 1), a2 + hstep, voffA);
            PG8_WAIT_V(8); PG8_WAIT_L(0); PG8_BAR; PG8_MMA(0, 0, At, B0); PG8_MMA(0, 1, At, B1); PG8_BAR; PG8_SCHED;
            PG8_LDA(At, 1, 1); PG8_STAGE(PG8_SB(1, 0), b3, voffB); PG8_STAGE(PG8_SB(1, 1), b3 + hstep, voffB); PG8_STAGE(PG8_SA(1, 0), a3, voffA);
            PG8_WAIT_V(8); PG8_WAIT_L(0); PG8_BAR; PG8_MMA(1, 0, At, B0); PG8_MMA(1, 1, At, B1); PG8_BAR; PG8_SCHED;
            } else {
            PG8_LDB(B0, 0, 0); PG8_SCHED; PG8_LDA(At, 0, 0); PG8_STAGE(PG8_SA(1, 1), a1 + hstep, voffA);
            PG8_WAIT_L(8); PG8_BAR; PG8_WAIT_L(0); PG8_MMA(0, 0, At, B0); PG8_BAR; PG8_SCHED;
            PG8_LDB(B1, 0, 1); PG8_STAGE(PG8_SB(0, 0), b2, voffB);
            PG8_BAR; PG8_WAIT_L(0); PG8_MMA(0, 1, At, B1); PG8_BAR;
            PG8_LDA(At, 0, 1); PG8_STAGE(PG8_SA(0, 0), a2, voffA);
            PG8_BAR; PG8_WAIT_L(0); PG8_MMA(1, 0, At, B0); PG8_BAR; PG8_SCHED;
            PG8_STAGE(PG8_SB(0, 1), b2 + hstep, voffB);
            PG8_WAIT_V(6); PG8_BAR; PG8_MMA(1, 1, At, B1); PG8_BAR;
            PG8_LDB(B0, 1, 0); PG8_SCHED; PG8_LDA(At, 1, 0); PG8_STAGE(PG8_SA(0, 1), a2 + hstep, voffA);
            PG8_WAIT_L(8); PG8_BAR; PG8_WAIT_L(0); PG8_MMA(0, 0, At, B0); PG8_BAR; PG8_SCHED;
            PG8_LDB(B1, 1, 1); PG8_STAGE(PG8_SB(1, 0), b3, voffB);
            PG8_BAR; PG8_WAIT_L(0); PG8_MMA(0, 1, At, B1); PG8_BAR;
            PG8_LDA(At, 1, 1); PG8_STAGE(PG8_SA(1, 0), a3, voffA);
            PG8_BAR; PG8_WAIT_L(0); PG8_MMA(1, 0, At, B0); PG8_BAR; PG8_SCHED;
            PG8_STAGE(PG8_SB(1, 1), b3 + hstep, voffB);
            PG8_WAIT_V(6); PG8_BAR; PG8_MMA(1, 1, At, B1); PG8_BAR;
            }
        }
        if constexpr (ALIGN_EPI) { if (wr == 0) PG8_BAR; }
        if constexpr (!Epi::AFTER_DRAIN) { E(acc, cur, wr, wc, fr, fq, ui); S.done(cur); }
        if (!has_next) break;
        if constexpr (Epi::ACC_INIT) E.init(acc, nxt, wr, wc, fr, fq); else {
#pragma unroll
        for (int a = 0; a < 2; ++a)
#pragma unroll
            for (int b = 0; b < 2; ++b)
#pragma unroll
                for (int m = 0; m < 4; ++m)
#pragma unroll
                    for (int n = 0; n < 2; ++n) acc[a][b][m][n] = (f32x4){0.f, 0.f, 0.f, 0.f}; }
        cur = nxt; cA = nA; cB = nB; ++ui;
        if constexpr (ALIGN_EPI) { if (wr == 1) PG8_BAR; }
    }
    PG8_WAIT_V(0);
    if constexpr (!ALIGN_EPI) { if (wr == 0) PG8_BAR; }
    PG8_BAR;
    if constexpr (Epi::AFTER_DRAIN) { E.fused(acc, cur, wr, wc, fr, fq, lds, wid, lane); S.done(cur); }
#undef PG8_SA
#undef PG8_SB
#undef PG8_STAGE
#undef PG8_LDA
#undef PG8_LDB
#undef PG8_MMA
#undef PG8_WAIT_V
#undef PG8_WAIT_L
#undef PG8_BAR
#undef PG8_SCHED
}
}

constexpr int BATCH = 2, SEQ = 4096, DM = 2048, MROWS = BATCH * SEQ;
constexpr int AH = 16, AHD = 128, NQKV = 3 * DM;
constexpr int LH = 4, LDV = 512, LDK = 256, QKW = 1024, INW = 6152, INW_MAIN = 6144;
constexpr int FFN = 5632, FFN2 = 2 * FFN;
constexpr float NORM_EPS = 1e-6f;

typedef unsigned short bf16;
typedef unsigned v4u __attribute__((ext_vector_type(4)));
typedef unsigned v2u __attribute__((ext_vector_type(2)));
typedef float f32x4 __attribute__((ext_vector_type(4)));
typedef float f32x2 __attribute__((ext_vector_type(2)));
#define LAS __attribute__((address_space(3)))

__device__ __forceinline__ unsigned f2bf(float f) { unsigned u = __builtin_bit_cast(unsigned, f); return (u + 0x7fffu + ((u >> 16) & 1u)) >> 16; }
__device__ __forceinline__ unsigned pk2(float lo, float hi) { unsigned r; asm("v_cvt_pk_bf16_f32 %0, %1, %2" : "=v"(r) : "v"(lo), "v"(hi)); return r; }
template <int N> __device__ __forceinline__ float dpp_ror(float v) { return __builtin_bit_cast(float, __builtin_amdgcn_mov_dpp(__builtin_bit_cast(int, v), 0x120 + N, 0xf, 0xf, true)); }
__device__ __forceinline__ float row16_sum(float v) { v += dpp_ror<1>(v); v += dpp_ror<2>(v); v += dpp_ror<4>(v); v += dpp_ror<8>(v); return v; }
__device__ __forceinline__ float bf2f(unsigned short b) { return __builtin_bit_cast(float, (unsigned)b << 16); }
__device__ __forceinline__ float bflo(unsigned w) { return __builtin_bit_cast(float, w << 16); }
__device__ __forceinline__ float bfhi(unsigned w) { return __builtin_bit_cast(float, w & 0xffff0000u); }
__device__ __forceinline__ float wave_sum(float v) {
#pragma unroll
    for (int o = 1; o < 64; o <<= 1) v += __shfl_xor(v, o);
    return v;
}
__device__ __forceinline__ float sigmoidf_(float x) { return __builtin_amdgcn_rcpf(1.f + __expf(-x)); }
__device__ __forceinline__ float siluf_(float x) { return x * __builtin_amdgcn_rcpf(1.f + __expf(-x)); }

constexpr size_t MiB = 1u << 20;
constexpr size_t WS_CTL = 0;
constexpr size_t WS_WQKV = 1 * MiB;
constexpr size_t WS_WO   = WS_WQKV + (size_t)NQKV * DM * 2;
constexpr size_t WS_WIN  = WS_WO + (size_t)DM * DM * 2;
constexpr size_t WS_WOUT = WS_WIN + (size_t)INW_MAIN * DM * 2;
constexpr size_t WS_WUP  = WS_WOUT + (size_t)DM * DM * 2;
constexpr size_t WS_WDN  = WS_WUP + 2 * (size_t)FFN2 * DM * 2;
constexpr size_t WS_HN   = WS_WDN + 2 * (size_t)DM * FFN * 2;
constexpr size_t WS_G    = WS_HN + (size_t)MROWS * DM * 2;
constexpr size_t WS_R    = WS_G + (size_t)MROWS * FFN * 2;
constexpr size_t WS_QKV  = WS_R;
constexpr size_t WS_O    = WS_QKV + (size_t)MROWS * NQKV * 2;
constexpr size_t WS_QKC  = WS_O + (size_t)MROWS * DM * 2;
constexpr size_t WS_HS   = WS_QKC + (size_t)MROWS * DM * 2;
constexpr size_t WS_U    = WS_R;
constexpr size_t WS_REND = WS_HS + (size_t)MROWS * DM * 4;
static_assert(WS_U + (size_t)MROWS * FFN2 * 2 <= WS_REND, "U overlay");
constexpr size_t WS_GATES = WS_REND;
constexpr size_t WS_SU   = WS_GATES + (size_t)MROWS * 8 * 4;
constexpr size_t WS_SM   = WS_SU + 8 * SEQ * 4;
constexpr size_t WS_SE   = WS_SM + 8 * SEQ * 4;
constexpr size_t WS_NST  = WS_SE + 8 * SEQ * 4;
constexpr size_t WS_CST  = WS_NST + 8 * 64 * 256 * 4;
constexpr size_t WS_SSQ  = WS_CST + (size_t)8 * 64 * 17 * 16384;
constexpr size_t WS_GWT  = WS_SSQ + (size_t)MROWS * 32 * 4;
constexpr size_t WS_XR   = WS_HS;
constexpr size_t WS_END  = WS_GWT + (size_t)DM * 8 * 4;
static_assert(WS_END <= 738000000, "workspace");

__device__ __forceinline__ void transpose_load(const float* W, int ldn, int nblk, int item, int lane, f32x4 (&v)[8]) {
    const int kb = item / nblk, nb = item % nblk, k0 = 64 * kb, n0 = 32 * nb;
#pragma unroll
    for (int i = 0; i < 8; ++i) v[i] = *(const f32x4*)(W + (size_t)(k0 + 8 * i + (lane >> 3)) * ldn + n0 + 4 * (lane & 7));
}
__device__ __forceinline__ void transpose_store(const f32x4 (&v)[8], int K, int nblk, bf16* WT, LAS float* scr, int item, int lane, bool gate_perm, const LAS float* kgain) {
    const int kb = item / nblk, nb = item % nblk, k0 = 64 * kb, n0 = 32 * nb;
    const int r0 = !gate_perm ? n0 : (n0 < FFN ? (n0 / 128) * 256 + (n0 % 128) : ((n0 - FFN) / 128) * 256 + 128 + ((n0 - FFN) % 128));
#pragma unroll
    for (int i = 0; i < 8; ++i) { LAS float* d = scr + (8 * i + (lane >> 3)) * 33 + 4 * (lane & 7); d[0] = v[i][0]; d[1] = v[i][1]; d[2] = v[i][2]; d[3] = v[i][3]; }
    asm volatile("s_waitcnt lgkmcnt(0)" ::: "memory");
    const int c = lane & 7;
    f32x4 ga = (f32x4){1.f, 1.f, 1.f, 1.f}, gb = ga;
    if (kgain) { ga = *(const LAS f32x4*)(kgain + k0 + 8 * c); gb = *(const LAS f32x4*)(kgain + k0 + 8 * c + 4); }
#pragma unroll
    for (int j = 0; j < 4; ++j) { const int n = (lane >> 3) + 8 * j; const LAS float* s = scr + (8 * c) * 33 + n;
        v4u o; o.x = pk2(s[0 * 33] * ga[0], s[1 * 33] * ga[1]); o.y = pk2(s[2 * 33] * ga[2], s[3 * 33] * ga[3]); o.z = pk2(s[4 * 33] * gb[0], s[5 * 33] * gb[1]); o.w = pk2(s[6 * 33] * gb[2], s[7 * 33] * gb[3]);
        *(v4u*)(WT + (size_t)(r0 + n) * K + k0 + 8 * c) = o; }
    asm volatile("s_waitcnt lgkmcnt(0)" ::: "memory");
}

#define XB_TMO      128
#define XB_XCNT(j)  (256  + 64 * (j))
#define XB_XSUB(j)  (1280 + 64 * (j))
#define XB_XGEN(j)  (2304 + 64 * (j))
#define XB_TOP      3328
#define XB_TOPGEN   3392
#define XCD_BAR_WORDS 3456
#define XB_SPIN_CAP (1u << 18)

__device__ __forceinline__ unsigned xb_ld(unsigned* p)              { return __hip_atomic_load(p, __ATOMIC_RELAXED, __HIP_MEMORY_SCOPE_AGENT); }
__device__ __forceinline__ unsigned xb_add(unsigned* p, unsigned v) { return __hip_atomic_fetch_add(p, v, __ATOMIC_RELAXED, __HIP_MEMORY_SCOPE_AGENT); }
__device__ __forceinline__ unsigned xb_xcc_id() { return (unsigned)__builtin_amdgcn_s_getreg((3 << 11) | 20) & 0xFu; }
#define XB_SPIN(cond, bar) do { unsigned _sp = 0; while (cond) { __builtin_amdgcn_s_sleep(1); \
    if ((++_sp & 255u) == 0u) { if (xb_ld(&(bar)[XB_TMO])) break; if (_sp > XB_SPIN_CAP) { atomicAdd(&(bar)[XB_TMO], 1u); break; } } } } while (0)

struct XcdBarrier {
    unsigned* bar; unsigned x;
    volatile LAS unsigned* st;
};

__device__ __forceinline__ XcdBarrier xcd_barrier_post(unsigned* bar, volatile LAS unsigned* st) {
    XcdBarrier b; b.bar = bar; b.x = xb_xcc_id(); b.st = st;
    if (threadIdx.x == 0) (void)xb_add(&bar[XB_XCNT(b.x)], 1u);
    return b;
}
__device__ __forceinline__ void xcd_barrier_complete(unsigned* bar, unsigned x, unsigned& nloc, unsigned& nx) {
    const unsigned G = gridDim.x * gridDim.y * gridDim.z;
    unsigned sum, cnt, mine, sp = 0u;
    for (;;) {
        sum = 0u; cnt = 0u; mine = 0u;
#pragma unroll
        for (unsigned j = 0; j < 16; ++j) { const unsigned c = xb_ld(&bar[XB_XCNT(j)]); sum += c; cnt += (c > 0u) ? 1u : 0u; mine = (j == x) ? c : mine; }
        if (sum == G) break;
        __builtin_amdgcn_s_sleep(1);
        if ((++sp & 255u) == 0u) { if (xb_ld(&bar[XB_TMO])) break; if (sp > XB_SPIN_CAP) { atomicAdd(&bar[XB_TMO], 1u); break; } }
    }
    nloc = mine > 0u ? mine : 1u; nx = cnt > 0u ? cnt : 1u;
}

__device__ __forceinline__ void xcd_barrier(const XcdBarrier& b) {
    asm volatile("s_waitcnt vmcnt(0)" ::: "memory");
    __syncthreads();
    if (threadIdx.x == 0) {
        unsigned* bar = b.bar;
        __builtin_amdgcn_s_waitcnt(0);
        unsigned nloc = b.st[0], nx = b.st[1];
        if (nloc == 0u) { xcd_barrier_complete(bar, b.x, nloc, nx); b.st[0] = nloc; b.st[1] = nx; }
        const unsigned old = xb_add(&bar[XB_XSUB(b.x)], 1u);
        const unsigned gen = old / nloc;
        if (old + 1u == (gen + 1u) * nloc) {
            __builtin_amdgcn_fence(__ATOMIC_RELEASE, "agent");
            asm volatile("s_waitcnt vmcnt(0)" ::: "memory");
            const unsigned og = xb_add(&bar[XB_TOP], 1u);
            const unsigned tg = og / nx;
            if (og + 1u == (tg + 1u) * nx) xb_add(&bar[XB_TOPGEN], 1u);
            else XB_SPIN(xb_ld(&bar[XB_TOPGEN]) == tg, bar);
            __builtin_amdgcn_fence(__ATOMIC_ACQUIRE, "agent");
            xb_add(&bar[XB_XGEN(b.x)], 1u);
            asm volatile("s_waitcnt vmcnt(0)" ::: "memory");
        } else {
            XB_SPIN(xb_ld(&bar[XB_XGEN(b.x)]) == gen, bar);
            __builtin_amdgcn_fence(__ATOMIC_ACQUIRE, "agent");
            asm volatile("s_waitcnt vmcnt(0)" ::: "memory");
        }
    }
    __syncthreads();
}


constexpr int NWAVES = 8, NTHREADS = 512;
constexpr int RING_BYTES = 131072;
constexpr int MISC_OFF = 163840 - 256;
constexpr int LDS_BYTES = 163840;
constexpr int CW_BAR = 4096;
constexpr size_t CTL_ZERO_BYTES = 64 * 1024;

struct Args { const float* in[18]; float* out; unsigned char* ws; int ph_lo, ph_hi; };

struct Frame {
    LAS unsigned char* lds; int tid, lane, wave, vcu, G;
};

__device__ __forceinline__ void p_convert(const Frame& F, const float* W, bf16* WT, int K, int ldn, int N, bool gate_perm = false, int rank0 = 0, int nranks = 0, const float* kgain = nullptr) {
    LAS float* scr = (LAS float*)(F.lds + F.wave * 16384);
    if (nranks == 0) nranks = F.G;
    if (F.vcu < rank0 || F.vcu >= rank0 + nranks) return;
    const int gw = (F.vcu - rank0) * NWAVES + F.wave, NGW = nranks * NWAVES;
    const int nblk = N / 32, items = (K / 64) * nblk;
    const LAS float* kgl = nullptr;
    if (kgain) { LAS float* gl = (LAS float*)(F.lds + NWAVES * 16384); __syncthreads();
        for (int i = F.tid; i < K / 4; i += NTHREADS) *(LAS f32x4*)(gl + 4 * i) = *(const f32x4*)(kgain + 4 * i);
        __syncthreads(); kgl = gl; }
    f32x4 cur[8], nxt[8];
    if (gw < items) transpose_load(W, ldn, nblk, gw, F.lane, nxt);
    for (int it = gw; it < items; it += NGW) {
#pragma unroll
        for (int i = 0; i < 8; ++i) cur[i] = nxt[i];
        if (it + NGW < items) transpose_load(W, ldn, nblk, it + NGW, F.lane, nxt);
        transpose_store(cur, K, nblk, WT, scr, it, F.lane, gate_perm, kgl);
    }
}

__device__ __forceinline__ void p_pack_gates(const Frame& F, const float* w_in, float* gwt) {
    for (int id = F.vcu * NTHREADS + F.tid; id < DM * 2; id += F.G * NTHREADS) { const int k = id >> 1, hf = id & 1; *(f32x4*)(gwt + k * 8 + hf * 4) = *(const f32x4*)(w_in + (size_t)k * INW + INW_MAIN + hf * 4); }
}
template <bool XBF> __device__ __forceinline__ int nrm_idx(int q, int lane) { return XBF ? 2 * (64 * (q >> 1) + lane) + (q & 1) : 64 * q + lane; }
template <bool XBF> __device__ __forceinline__ f32x4 nrm_ld(const void* x, size_t row, int q, int lane) {
    if constexpr (XBF) { const v2u w = ((const v2u*)((const bf16*)x + row * DM))[nrm_idx<XBF>(q, lane)]; return (f32x4){bflo(w.x), bfhi(w.x), bflo(w.y), bfhi(w.y)}; }
    else return ((const f32x4*)((const float*)x + row * DM))[nrm_idx<XBF>(q, lane)];
}
template <bool XBF> __device__ __forceinline__ void p_rmsnorm(const Frame& F, const void* x, const float* g, bf16* hn, const float* w_in, const float* gate_bias, float* gates) {
    const int gw = F.vcu * NWAVES + F.wave, NGW = F.G * NWAVES, lane = F.lane;
    LAS float* gwl = (LAS float*)F.lds;
    if (w_in) { __syncthreads();
#pragma unroll
        for (int i = 0; i < 8; ++i) { const int id = F.tid + NTHREADS * i, k = id >> 1; *(LAS f32x4*)(gwl + (k >> 3) * 68 + (k & 7) * 8 + (id & 1) * 4) = *(const f32x4*)(w_in + id * 4); }
        __syncthreads(); }
    f32x4 gg[8], nx[8];
#pragma unroll
    for (int j = 0; j < 8; ++j) gg[j] = ((const f32x4*)g)[nrm_idx<XBF>(j, lane)];
    if (gw < MROWS) {
#pragma unroll
        for (int j = 0; j < 8; ++j) nx[j] = nrm_ld<XBF>(x, (size_t)gw, j, lane); }
    for (int row = gw; row < MROWS; row += NGW) {
        f32x4 v[8]; float s = 0.f;
#pragma unroll
        for (int j = 0; j < 8; ++j) { v[j] = nx[j]; s += (v[j].x * v[j].x + v[j].y * v[j].y) + (v[j].z * v[j].z + v[j].w * v[j].w); }
        if (row + NGW < MROWS) {
#pragma unroll
            for (int j = 0; j < 8; ++j) nx[j] = nrm_ld<XBF>(x, (size_t)(row + NGW), j, lane); }
        const float rstd = 1.f / sqrtf(wave_sum(s) * (1.f / DM) + NORM_EPS);
#pragma unroll
        for (int j = 0; j < 8; ++j) v[j] = v[j] * rstd * gg[j];
        if constexpr (XBF) { v4u* o16 = (v4u*)(hn + (size_t)row * DM) + lane;
#pragma unroll
            for (int jj = 0; jj < 4; ++jj) { v4u w; w.x = pk2(v[2 * jj].x, v[2 * jj].y); w.y = pk2(v[2 * jj].z, v[2 * jj].w); w.z = pk2(v[2 * jj + 1].x, v[2 * jj + 1].y); w.w = pk2(v[2 * jj + 1].z, v[2 * jj + 1].w); o16[64 * jj] = w; } }
        else {
            const bool odd = lane & 1; bf16* ob_ = hn + (size_t)row * DM;
#pragma unroll
            for (int jj = 0; jj < 4; ++jj) { const unsigned a0 = pk2(v[2 * jj].x, v[2 * jj].y), a1 = pk2(v[2 * jj].z, v[2 * jj].w), b0 = pk2(v[2 * jj + 1].x, v[2 * jj + 1].y), b1 = pk2(v[2 * jj + 1].z, v[2 * jj + 1].w);
                const unsigned s0 = odd ? a0 : b0, s1 = odd ? a1 : b1;
                const unsigned r0 = (unsigned)__builtin_amdgcn_mov_dpp((int)s0, 0xB1, 0xf, 0xf, true), r1 = (unsigned)__builtin_amdgcn_mov_dpp((int)s1, 0xB1, 0xf, 0xf, true);
                v4u w; if (odd) { w.x = r0; w.y = r1; w.z = b0; w.w = b1; } else { w.x = a0; w.y = a1; w.z = r0; w.w = r1; }
                *(v4u*)(ob_ + 4 * (64 * (2 * jj + (odd ? 1 : 0)) + (lane & ~1))) = w; } }
        if (w_in) {
            float acc[8];
#pragma unroll
            for (int q = 0; q < 8; ++q) acc[q] = 0.f;
#pragma unroll
            for (int j = 0; j < 8; ++j) { asm volatile("" ::: "memory");
#pragma unroll
                for (int e = 0; e < 4; ++e) { const int k = 4 * nrm_idx<XBF>(j, lane) + e; const LAS float* wp = gwl + (k >> 3) * 68 + (k & 7) * 8; const f32x4 a = *(const LAS f32x4*)wp, b = *(const LAS f32x4*)(wp + 4); const float hv = v[j][e];
                    acc[0] += hv * a.x; acc[1] += hv * a.y; acc[2] += hv * a.z; acc[3] += hv * a.w; acc[4] += hv * b.x; acc[5] += hv * b.y; acc[6] += hv * b.z; acc[7] += hv * b.w; } }
#pragma unroll
            for (int q = 0; q < 8; ++q) acc[q] = wave_sum(acc[q]);
            if (lane < 8) { float r = acc[0];
#pragma unroll
                for (int q = 1; q < 8; ++q) r = (lane == q) ? acc[q] : r;
                gates[(size_t)row * 8 + lane] = r + gate_bias[lane]; }
        }
    }
}

__device__ __forceinline__ void unpack8(const v4u v, float (&f)[8]) { f[0] = bflo(v.x); f[1] = bfhi(v.x); f[2] = bflo(v.y); f[3] = bfhi(v.y); f[4] = bflo(v.z); f[5] = bfhi(v.z); f[6] = bflo(v.w); f[7] = bfhi(v.w); }
__device__ __forceinline__ float swapadd32(float a, float b) { asm volatile("s_nop 1\n\tv_permlane32_swap_b32 %0, %1" : "+v"(a), "+v"(b)); return a + b; }
__device__ __forceinline__ float swapadd16(float a, float b) { asm volatile("s_nop 1\n\tv_permlane16_swap_b32 %0, %1" : "+v"(a), "+v"(b)); return a + b; }
__device__ __forceinline__ float wave_sum_dpp(float v) { v = row16_sum(v);
    const int u = __builtin_bit_cast(int, v);
    return (__builtin_bit_cast(float, __builtin_amdgcn_readlane(u, 0)) + __builtin_bit_cast(float, __builtin_amdgcn_readlane(u, 16))) + (__builtin_bit_cast(float, __builtin_amdgcn_readlane(u, 32)) + __builtin_bit_cast(float, __builtin_amdgcn_readlane(u, 48))); }
__device__ __forceinline__ void p_lstm_norm(const Frame& F, const bf16* x, const float* g, bf16* hn, const float* gwt, const float* gate_bias, float* gates) {
    const int gw = __builtin_amdgcn_readfirstlane(F.vcu * NWAVES + F.wave), NGW = F.G * NWAVES, lane = F.lane;
    LAS float* gwl = (LAS float*)F.lds;
    __syncthreads();
#pragma unroll
    for (int i = 0; i < 8; ++i) { const int id = F.tid + NTHREADS * i, k = id >> 1; *(LAS f32x4*)(gwl + (k >> 3) * 68 + (k & 7) * 8 + (id & 1) * 4) = *(const f32x4*)(gwt + id * 4); }
    __syncthreads();
    const float gb = gate_bias[lane & 7];
    for (int row0 = gw; row0 < MROWS; row0 += 4 * NGW) {
        v4u raw[4][4];
#pragma unroll
        for (int r = 0; r < 4; ++r) { const int row = min(row0 + r * NGW, MROWS - 1);
#pragma unroll
            for (int jj = 0; jj < 4; ++jj) raw[r][jj] = ((const v4u*)(x + (size_t)row * DM))[64 * jj + lane]; }
        float rstd[4];
#pragma unroll
        for (int r = 0; r < 4; ++r) { float s = 0.f;
#pragma unroll
            for (int jj = 0; jj < 4; ++jj) { const v4u w = raw[r][jj];
                s += (bflo(w.x) * bflo(w.x) + bfhi(w.x) * bfhi(w.x)) + (bflo(w.y) * bflo(w.y) + bfhi(w.y) * bfhi(w.y)) + (bflo(w.z) * bflo(w.z) + bfhi(w.z) * bfhi(w.z)) + (bflo(w.w) * bflo(w.w) + bfhi(w.w) * bfhi(w.w)); }
            rstd[r] = 1.f / sqrtf(wave_sum_dpp(s) * (1.f / DM) + NORM_EPS); }
        float acc[4][8];
#pragma unroll
        for (int r = 0; r < 4; ++r)
#pragma unroll
            for (int q = 0; q < 8; ++q) acc[r][q] = 0.f;
        const bf16* xr[4]; bf16* hr[4]; bool ok[4];
#pragma unroll
        for (int r = 0; r < 4; ++r) { const int row = row0 + r * NGW; ok[r] = row < MROWS; const int rc = min(row, MROWS - 1); xr[r] = x + (size_t)rc * DM; hr[r] = hn + (size_t)rc * DM; }
        v4u cur[4];
#pragma unroll
        for (int r = 0; r < 4; ++r) cur[r] = ((const v4u*)xr[r])[lane];
#pragma unroll 1
        for (int jj = 0; jj < 4; ++jj) {
            v4u nxt[4]; const int jn = jj < 3 ? jj + 1 : 3;
#pragma unroll
            for (int r = 0; r < 4; ++r) nxt[r] = ((const v4u*)xr[r])[64 * jn + lane];
            const f32x4 gg0 = ((const f32x4*)g)[2 * (64 * jj + lane)], gg1 = ((const f32x4*)g)[2 * (64 * jj + lane) + 1];
            float v[4][8];
#pragma unroll
            for (int r = 0; r < 4; ++r) { const v4u w = cur[r]; const f32x4 g0 = gg0 * rstd[r], g1 = gg1 * rstd[r];
                v[r][0] = bflo(w.x) * g0.x; v[r][1] = bfhi(w.x) * g0.y; v[r][2] = bflo(w.y) * g0.z; v[r][3] = bfhi(w.y) * g0.w;
                v[r][4] = bflo(w.z) * g1.x; v[r][5] = bfhi(w.z) * g1.y; v[r][6] = bflo(w.w) * g1.z; v[r][7] = bfhi(w.w) * g1.w;
                if (ok[r]) { v4u o; o.x = pk2(v[r][0], v[r][1]); o.y = pk2(v[r][2], v[r][3]); o.z = pk2(v[r][4], v[r][5]); o.w = pk2(v[r][6], v[r][7]); ((v4u*)hr[r])[64 * jj + lane] = o; } }
            const LAS float* wp = gwl + (64 * jj + lane) * 68;
#pragma unroll
            for (int e = 0; e < 8; ++e) { const f32x4 a = *(const LAS f32x4*)(wp + e * 8), b = *(const LAS f32x4*)(wp + e * 8 + 4);
#pragma unroll
                for (int r = 0; r < 4; ++r) { const float hv = v[r][e]; acc[r][0] += hv * a.x; acc[r][1] += hv * a.y; acc[r][2] += hv * a.z; acc[r][3] += hv * a.w; acc[r][4] += hv * b.x; acc[r][5] += hv * b.y; acc[r][6] += hv * b.z; acc[r][7] += hv * b.w; } }
#pragma unroll
            for (int r = 0; r < 4; ++r) cur[r] = nxt[r];
        }
        float X[16], Z[8];
#pragma unroll
        for (int j = 0; j < 16; ++j) { const int r = j >> 3, q = j & 7; X[j] = swapadd32(acc[r][q], acc[r + 2][q]); }
#pragma unroll
        for (int i = 0; i < 8; ++i) Z[i] = row16_sum(swapadd16(X[i], X[i + 8]));
        { const int rho = lane >> 4, l = lane & 15, row = row0 + rho * NGW; float rv = Z[0];
#pragma unroll
          for (int q = 1; q < 8; ++q) rv = (l == q) ? Z[q] : rv;
          if (l < 8 && row < MROWS) gates[(size_t)row * 8 + l] = rv + gb; }
    }
}

__device__ __forceinline__ void p_lstm_conv(const Frame& F, const bf16* z, const float* cw, const float* cb, bf16* qk) {
    constexpr int NCH = DM / 8, SEGR = 16, NSEG = MROWS / SEGR;
    const int total = NCH * NSEG, stride = F.G * NTHREADS;
    for (int item = F.vcu * NTHREADS + F.tid; item < total; item += stride) {
        const int cc = item % NCH, seg = item / NCH, c = 8 * cc, r0 = seg * SEGR, t0 = r0 & (SEQ - 1);
        float w[4][8], bb[8];
        { const f32x4 b0 = *(const f32x4*)(cb + c), b1 = *(const f32x4*)(cb + c + 4);
#pragma unroll
          for (int e = 0; e < 4; ++e) { bb[e] = b0[e]; bb[4 + e] = b1[e]; }
#pragma unroll
          for (int j = 0; j < 4; ++j) { const f32x4 w0 = *(const f32x4*)(cw + j * DM + c), w1 = *(const f32x4*)(cw + j * DM + c + 4);
#pragma unroll
              for (int e = 0; e < 4; ++e) { w[j][e] = w0[e]; w[j][4 + e] = w1[e]; } } }
        const float sc = (c >= QKW) ? 0.0625f : 1.f;
        float x3[8], x2[8], x1[8];
#pragma unroll
        for (int e = 0; e < 8; ++e) { x3[e] = 0.f; x2[e] = 0.f; x1[e] = 0.f; }
        if (t0 > 0) { unpack8(*(const v4u*)(z + (size_t)(r0 - 3) * INW_MAIN + c), x3); unpack8(*(const v4u*)(z + (size_t)(r0 - 2) * INW_MAIN + c), x2); unpack8(*(const v4u*)(z + (size_t)(r0 - 1) * INW_MAIN + c), x1); }
#pragma unroll 4
        for (int r = 0; r < SEGR; ++r) {
            float x0[8]; unpack8(*(const v4u*)(z + (size_t)(r0 + r) * INW_MAIN + c), x0);
            float o[8];
#pragma unroll
            for (int e = 0; e < 8; ++e) { const float a = bb[e] + w[0][e] * x3[e] + w[1][e] * x2[e] + w[2][e] * x1[e] + w[3][e] * x0[e]; o[e] = siluf_(a) * sc; x3[e] = x2[e]; x2[e] = x1[e]; x1[e] = x0[e]; }
            v4u ow; ow.x = pk2(o[0], o[1]); ow.y = pk2(o[2], o[3]); ow.z = pk2(o[4], o[5]); ow.w = pk2(o[6], o[7]);
            *(v4u*)(qk + (size_t)(r0 + r) * DM + c) = ow;
        }
    }
}

typedef short bf16x8 __attribute__((ext_vector_type(8)));
typedef short s16x4 __attribute__((ext_vector_type(4)));
typedef float f32x16 __attribute__((ext_vector_type(16)));
typedef __attribute__((address_space(3))) const unsigned char* lds_cptr;
__device__ __forceinline__ s16x4 vtr(lds_cptr p) { return __builtin_bit_cast(s16x4, __builtin_amdgcn_ds_read_tr16_b64_v4i16((__attribute__((address_space(3))) s16x4*)p)); }
__device__ __forceinline__ bf16x8 cat8(s16x4 lo, s16x4 hi) { return (bf16x8){lo[0], lo[1], lo[2], lo[3], hi[0], hi[1], hi[2], hi[3]}; }

constexpr int NSL = 17;
constexpr size_t CST_SLICE = 16384;
constexpr int L2_KSTR = 576, L2_KBUF = 64 * L2_KSTR;
constexpr int L2_VBUF = 64 * 64;

__device__ __forceinline__ float log_sigmoidf_(float x) { return (x >= 0.f) ? -log1pf(__expf(-x)) : x - log1pf(__expf(x)); }
__device__ __forceinline__ void p_lstm_scan2(const Frame& F, const float* gates, float* U, float* Mx, float* E) {
    if (F.vcu >= 8) return;
    const int bh = F.vcu, b = bh >> 2, h = bh & 3, tid = F.tid, lane = F.lane, w = F.wave, t0 = tid * 8;
    LAS float* wsum = (LAS float*)F.lds; LAS float* wmax = wsum + 8;
    const float* gb = gates + (size_t)(b * SEQ + t0) * 8;
    float lf[8], li[8];
#pragma unroll
    for (int i = 0; i < 8; ++i) { lf[i] = gb[i * 8 + 4 + h]; li[i] = gb[i * 8 + h]; }
    float s = 0.f;
#pragma unroll
    for (int i = 0; i < 8; ++i) { lf[i] = log_sigmoidf_(lf[i]); s += lf[i]; }
    float inc = s;
#pragma unroll
    for (int o = 1; o < 64; o <<= 1) { const float y = __shfl_up(inc, o); if (lane >= o) inc += y; }
    __syncthreads();
    if (lane == 63) wsum[w] = inc;
    __syncthreads();
    float base = 0.f;
#pragma unroll
    for (int q = 0; q < 8; ++q) base += (q < w) ? wsum[q] : 0.f;
    float Fc = base + inc - s, lm = -INFINITY; float u[8], Fv[8];
#pragma unroll
    for (int i = 0; i < 8; ++i) { Fc += lf[i]; Fv[i] = Fc; u[i] = li[i] - Fc; lm = fmaxf(lm, u[i]); }
    float pm = lm;
#pragma unroll
    for (int o = 1; o < 64; o <<= 1) { const float y = __shfl_up(pm, o); if (lane >= o) pm = fmaxf(pm, y); }
    if (lane == 63) wmax[w] = pm;
    __syncthreads();
    float mm = __shfl_up(pm, 1); if (lane == 0) mm = 0.f;
#pragma unroll
    for (int q = 0; q < 8; ++q) mm = fmaxf(mm, (q < w) ? wmax[q] : 0.f);
    mm = fmaxf(mm, 0.f);
#pragma unroll
    for (int i = 0; i < 8; ++i) { mm = fmaxf(mm, u[i]); U[bh * SEQ + t0 + i] = u[i]; Mx[bh * SEQ + t0 + i] = mm; E[bh * SEQ + t0 + i] = __expf(-(Fv[i] + mm)); }
    __syncthreads();
}

__device__ __forceinline__ void p_lstm_state(const Frame& F, const bf16* qk, const bf16* z, const float* U, const float* Mx, unsigned char* cst, float* nst) {
    const int item = F.vcu; if (item >= 8 * NSL) return;
    const int bh = item / NSL, j = item % NSL, b = bh >> 2, h = bh & 3;
    const int tid = F.tid, lane = F.lane, w = F.wave, hi = lane >> 5, g1 = (lane >> 4) & 1, q4 = (lane & 15) >> 2, p4 = lane & 3;
    LAS unsigned char* kb0 = F.lds; LAS unsigned char* vb0 = F.lds + 2 * L2_KBUF;
    const size_t rbase = (size_t)b * SEQ;
    const bf16* kg = qk + rbase * DM + QKW + h * LDK;
    const bf16* vg = z + rbase * INW_MAIN + 2 * QKW + h * LDV + 32 * j;
    const float* Ub = U + bh * SEQ; const float* Mb = Mx + bh * SEQ;
    const bool ones = (j == NSL - 1);
    f32x16 acc;
#pragma unroll
    for (int r = 0; r < 16; ++r) acc[r] = 0.f;
    v4u kreg[4][4]; v4u vreg[4];
#pragma unroll
    for (int q = 0; q < 4; ++q) vreg[q] = (v4u){0u, 0u, 0u, 0u};
    LAS float* wtl = (LAS float*)(F.lds + 2 * L2_KBUF + 2 * L2_VBUF); LAS float* decl = wtl + SEQ;
    __syncthreads();
#pragma unroll
    for (int i = 0; i < 8; ++i) { const int t = tid + 512 * i; wtl[t] = __expf(Ub[t] - Mb[(t & ~63) + 63]); }
    if (tid < 64) decl[tid] = __expf((tid > 0 ? Mb[tid * 64 - 1] : 0.f) - Mb[tid * 64 + 63]);
    const int vrow = tid >> 2, vch = tid & 3;
#define L2_LOAD(c, sl) do { const int t0_ = (c) * 64; \
        _Pragma("unroll") for (int i_ = 0; i_ < 4; ++i_) { const int id_ = tid + 512 * i_, row_ = id_ >> 5, ch_ = id_ & 31; kreg[sl][i_] = *(const v4u*)(kg + (size_t)(t0_ + row_) * DM + ch_ * 8); } \
        if (tid < 256 && !ones) vreg[sl] = *(const v4u*)(vg + (size_t)(t0_ + vrow) * INW_MAIN + vch * 8); } while (0)
#define L2_STORE(sl, buf, c_) do { \
        _Pragma("unroll") for (int i_ = 0; i_ < 4; ++i_) { const int id_ = tid + 512 * i_, row_ = id_ >> 5, ch_ = id_ & 31; *(LAS v4u*)(kb0 + (buf) * L2_KBUF + row_ * L2_KSTR + ch_ * 16) = kreg[sl][i_]; } \
        if (tid < 256) { const float wt_ = wtl[(c_) * 64 + vrow]; v4u o_; const v4u vr_ = vreg[sl]; \
            if (ones) { const unsigned pw_ = pk2(wt_, wt_); o_ = (v4u){pw_, pw_, pw_, pw_}; } \
            else { o_.x = pk2(bflo(vr_.x) * wt_, bfhi(vr_.x) * wt_); o_.y = pk2(bflo(vr_.y) * wt_, bfhi(vr_.y) * wt_); o_.z = pk2(bflo(vr_.z) * wt_, bfhi(vr_.z) * wt_); o_.w = pk2(bflo(vr_.w) * wt_, bfhi(vr_.w) * wt_); } \
            *(LAS v4u*)(vb0 + (buf) * L2_VBUF + vrow * 64 + vch * 16) = o_; } } while (0)
    const int koff = (8 * hi + q4) * L2_KSTR + (32 * w + 16 * g1 + 4 * p4) * 2;
    const int voff = (8 * hi + q4) * 64 + (16 * g1 + 4 * p4) * 2;
    unsigned char* cdst = cst + ((size_t)(bh * 64) * NSL + j) * CST_SLICE + ((size_t)(w * 2) * 64 + lane) * 16;
    __syncthreads();
    L2_LOAD(0, 0); L2_LOAD(1, 1); L2_LOAD(2, 2); L2_LOAD(3, 3);
    L2_STORE(0, 0, 0);
    __syncthreads();
#define L2_ITER(c, sl, sln) do { \
        { unsigned char* d = cdst + (size_t)(c) * NSL * CST_SLICE; \
          _Pragma("unroll") for (int s_ = 0; s_ < 2; ++s_) { v4u o; o.x = pk2(acc[8 * s_ + 0], acc[8 * s_ + 1]); o.y = pk2(acc[8 * s_ + 2], acc[8 * s_ + 3]); o.z = pk2(acc[8 * s_ + 4], acc[8 * s_ + 5]); o.w = pk2(acc[8 * s_ + 6], acc[8 * s_ + 7]); \
              *(v4u*)(d + s_ * 1024) = o; } \
          if (ones && (lane & 31) == 0) { float* nd = nst + (size_t)(bh * 64 + (c)) * LDK + 32 * w + 4 * hi; \
              _Pragma("unroll") for (int r = 0; r < 16; ++r) nd[(r & 3) + 8 * (r >> 2)] = acc[r]; } } \
        const float decay = decl[c]; \
        _Pragma("unroll") for (int r = 0; r < 16; ++r) acc[r] *= decay; \
        { lds_cptr kp = (lds_cptr)(kb0 + ((c) & 1) * L2_KBUF + koff); lds_cptr vp = (lds_cptr)(vb0 + ((c) & 1) * L2_VBUF + voff); \
          _Pragma("unroll") for (int ks = 0; ks < 4; ++ks) { \
              const bf16x8 a = cat8(vtr(kp + ks * 16 * L2_KSTR), vtr(kp + ks * 16 * L2_KSTR + 4 * L2_KSTR)); \
              const bf16x8 bb = cat8(vtr(vp + ks * 16 * 64), vtr(vp + ks * 16 * 64 + 4 * 64)); \
              acc = __builtin_amdgcn_mfma_f32_32x32x16_bf16(a, bb, acc, 0, 0, 0); } } \
        if ((c) + 1 < 64) { L2_STORE(sln, ((c) + 1) & 1, (c) + 1); } \
        if ((c) + 4 < 64) L2_LOAD((c) + 4, sl); \
        asm volatile("s_waitcnt lgkmcnt(0)" ::: "memory"); __builtin_amdgcn_s_barrier(); asm volatile("" ::: "memory"); } while (0)
    for (int c4 = 0; c4 < 64; c4 += 4) { L2_ITER(c4, 0, 1); L2_ITER(c4 + 1, 1, 2); L2_ITER(c4 + 2, 2, 3); L2_ITER(c4 + 3, 3, 0); }
#undef L2_ITER
#undef L2_LOAD
#undef L2_STORE
}

constexpr int L3_QSTR = 528, L3_VSTR = 1088, L3_WSTR = 144;
constexpr int L3_Q = 0, L3_K = L3_Q + 64 * L3_QSTR, L3_V = L3_K + 64 * L3_QSTR, L3_W = L3_V + 64 * L3_VSTR, L3_SC = L3_W + 64 * L3_WSTR, L3_END = L3_SC + 8192;
__device__ __forceinline__ void p_lstm_out(const Frame& F, const bf16* qk, const bf16* z, const float* U, const float* Mx, const float* E, const unsigned char* cst, const float* nst, const float* hgain, bf16* O) {
    const int tid = F.tid, lane = F.lane, w = F.wave, hi = lane >> 5, g1 = (lane >> 4) & 1, q4 = (lane & 15) >> 2, p4 = lane & 3, l31 = lane & 31;
    LAS unsigned char* lds = F.lds;
    LAS float* sc = (LAS float*)(lds + L3_SC);
    LAS float* uS = sc, *Mrow = sc + 64, *inter = sc + 128, *Erow = sc + 192, *dinv = sc + 256, *nvec = sc + 320, *ssq = sc + 576, *rstdv = sc + 1088;
    for (int item = F.vcu; item < 8 * 64; item += F.G) {
        const int bh = item >> 6, c = item & 63, b = bh >> 2, h = bh & 3, t0 = c * 64;
        const size_t row0 = (size_t)b * SEQ + t0;
        __syncthreads();
        { v4u rq[4], rk[4], rv[8];
#pragma unroll
          for (int i = 0; i < 4; ++i) { const int id = tid + 512 * i, r = id >> 5, ch = id & 31;
              rq[i] = *(const v4u*)(qk + (row0 + r) * DM + h * LDK + ch * 8); rk[i] = *(const v4u*)(qk + (row0 + r) * DM + QKW + h * LDK + ch * 8); }
#pragma unroll
          for (int i = 0; i < 8; ++i) { const int id = tid + 512 * i, r = id >> 6, ch = id & 63; rv[i] = *(const v4u*)(z + (row0 + r) * INW_MAIN + 2 * QKW + h * LDV + ch * 8); }
#pragma unroll
          for (int i = 0; i < 4; ++i) { const int id = tid + 512 * i, r = id >> 5, ch = id & 31;
              *(LAS v4u*)(lds + L3_Q + r * L3_QSTR + ch * 16) = rq[i]; *(LAS v4u*)(lds + L3_K + r * L3_QSTR + ch * 16) = rk[i]; }
#pragma unroll
          for (int i = 0; i < 8; ++i) { const int id = tid + 512 * i, r = id >> 6, ch = id & 63; *(LAS v4u*)(lds + L3_V + r * L3_VSTR + ch * 16) = rv[i]; } }
        if (tid < 64) { const float mr = Mx[bh * SEQ + t0 + tid]; const float mp = (c > 0) ? Mx[bh * SEQ + t0 - 1] : 0.f;
            uS[tid] = U[bh * SEQ + t0 + tid]; Mrow[tid] = mr; inter[tid] = __expf(mp - mr); Erow[tid] = E[bh * SEQ + t0 + tid]; }
        else if (tid < 128) { const int i4 = tid - 64; *(LAS f32x4*)(nvec + 4 * i4) = *(const f32x4*)(nst + (size_t)(bh * 64 + c) * LDK + 4 * i4); }
        __syncthreads();
        { const int rt = w >> 1, i15 = lane & 15, quad = lane >> 4;
#pragma unroll
          for (int cc = 0; cc < 2; ++cc) { const int ct = 2 * (w & 1) + cc;
              pg8::f32x4 sacc = (pg8::f32x4){0.f, 0.f, 0.f, 0.f};
              if (ct <= rt) {
                  const LAS unsigned char* qa = lds + L3_Q + (16 * rt + i15) * L3_QSTR + quad * 16; const LAS unsigned char* ka = lds + L3_K + (16 * ct + i15) * L3_QSTR + quad * 16;
#pragma unroll
                  for (int ks = 0; ks < 8; ++ks) { const bf16x8 a = *(const LAS bf16x8*)(qa + ks * 64), bb = *(const LAS bf16x8*)(ka + ks * 64);
                      sacc = __builtin_amdgcn_mfma_f32_16x16x32_bf16(a, bb, sacc, 0, 0, 0); } }
              const int s_ = 16 * ct + i15; const float us = uS[s_];
#pragma unroll
              for (int e = 0; e < 4; ++e) { const int l_ = 16 * rt + 4 * quad + e; const float wv = (s_ <= l_) ? sacc[e] * __expf(us - Mrow[l_]) : 0.f;
                  *(LAS unsigned short*)(lds + L3_W + l_ * L3_WSTR + s_ * 2) = (unsigned short)f2bf(wv); } } }
        __syncthreads();
        { const int r = tid >> 3, part = tid & 7; const v4u wv = *(const LAS v4u*)(lds + L3_W + r * L3_WSTR + part * 16);
          float rs = (bflo(wv.x) + bfhi(wv.x)) + (bflo(wv.y) + bfhi(wv.y)) + (bflo(wv.z) + bfhi(wv.z)) + (bflo(wv.w) + bfhi(wv.w)); float qn = 0.f;
#pragma unroll
          for (int i = 0; i < 4; ++i) { const v4u qv = *(const LAS v4u*)(lds + L3_Q + r * L3_QSTR + part * 64 + i * 16); const LAS float* np = nvec + part * 32 + i * 8;
              qn += bflo(qv.x) * np[0] + bfhi(qv.x) * np[1] + bflo(qv.y) * np[2] + bfhi(qv.y) * np[3] + bflo(qv.z) * np[4] + bfhi(qv.z) * np[5] + bflo(qv.w) * np[6] + bfhi(qv.w) * np[7]; }
          float den = inter[r] * qn + rs; den += __shfl_xor(den, 1); den += __shfl_xor(den, 2); den += __shfl_xor(den, 4);
          if (part == 0) dinv[r] = 1.f / fmaxf(fabsf(den), Erow[r]); }
        f32x16 acc[2][2];
#pragma unroll
        for (int a = 0; a < 2; ++a)
#pragma unroll
            for (int bq = 0; bq < 2; ++bq)
#pragma unroll
                for (int r = 0; r < 16; ++r) acc[a][bq][r] = 0.f;
        { const unsigned char* cb = cst + ((size_t)(bh * 64 + c) * NSL + 2 * w) * CST_SLICE + (size_t)lane * 16;
          const LAS unsigned char* qa = lds + L3_Q + l31 * L3_QSTR + hi * 8;
          bf16x8 bfr[2][8];
#pragma unroll
          for (int q = 0; q < 4; ++q) { bfr[0][2 * q] = *(const bf16x8*)(cb + q * 1024); bfr[0][2 * q + 1] = *(const bf16x8*)(cb + CST_SLICE + q * 1024); }
#pragma unroll
          for (int gq = 0; gq < 4; ++gq) {
              if (gq < 3) {
#pragma unroll
                  for (int q = 0; q < 4; ++q) { bfr[(gq + 1) & 1][2 * q] = *(const bf16x8*)(cb + (4 * (gq + 1) + q) * 1024); bfr[(gq + 1) & 1][2 * q + 1] = *(const bf16x8*)(cb + CST_SLICE + (4 * (gq + 1) + q) * 1024); } }
#pragma unroll
              for (int q = 0; q < 4; ++q) { const int kk = 4 * gq + q; const bf16x8 b0 = bfr[gq & 1][2 * q], b1 = bfr[gq & 1][2 * q + 1];
                  bf16x8 a[2];
#pragma unroll
                  for (int rt = 0; rt < 2; ++rt) { const s16x4 lo = *(const LAS s16x4*)(qa + rt * 32 * L3_QSTR + kk * 32), hh = *(const LAS s16x4*)(qa + rt * 32 * L3_QSTR + kk * 32 + 16); a[rt] = cat8(lo, hh); }
                  acc[0][0] = __builtin_amdgcn_mfma_f32_32x32x16_bf16(a[0], b0, acc[0][0], 0, 0, 0);
                  acc[0][1] = __builtin_amdgcn_mfma_f32_32x32x16_bf16(a[0], b1, acc[0][1], 0, 0, 0);
                  acc[1][0] = __builtin_amdgcn_mfma_f32_32x32x16_bf16(a[1], b0, acc[1][0], 0, 0, 0);
                  acc[1][1] = __builtin_amdgcn_mfma_f32_32x32x16_bf16(a[1], b1, acc[1][1], 0, 0, 0); }
              __builtin_amdgcn_sched_barrier(0); } }
#pragma unroll
        for (int rt = 0; rt < 2; ++rt)
#pragma unroll
            for (int r = 0; r < 16; ++r) { const float f = inter[32 * rt + (r & 3) + 8 * (r >> 2) + 4 * hi]; acc[rt][0][r] *= f; acc[rt][1][r] *= f; }
        { const LAS unsigned char* wa = lds + L3_W + l31 * L3_WSTR + hi * 16;
          lds_cptr vp = (lds_cptr)(lds + L3_V + (8 * hi + q4) * L3_VSTR + (64 * w + 16 * g1 + 4 * p4) * 2);
#pragma unroll
          for (int ks = 0; ks < 4; ++ks) {
              const bf16x8 a0 = *(const LAS bf16x8*)(wa + ks * 32), a1 = *(const LAS bf16x8*)(wa + 32 * L3_WSTR + ks * 32);
              const bf16x8 b0 = cat8(vtr(vp + ks * 16 * L3_VSTR), vtr(vp + ks * 16 * L3_VSTR + 4 * L3_VSTR));
              const bf16x8 b1 = cat8(vtr(vp + ks * 16 * L3_VSTR + 64), vtr(vp + ks * 16 * L3_VSTR + 4 * L3_VSTR + 64));
              acc[0][0] = __builtin_amdgcn_mfma_f32_32x32x16_bf16(a0, b0, acc[0][0], 0, 0, 0);
              acc[0][1] = __builtin_amdgcn_mfma_f32_32x32x16_bf16(a0, b1, acc[0][1], 0, 0, 0);
              acc[1][0] = __builtin_amdgcn_mfma_f32_32x32x16_bf16(a1, b0, acc[1][0], 0, 0, 0);
              acc[1][1] = __builtin_amdgcn_mfma_f32_32x32x16_bf16(a1, b1, acc[1][1], 0, 0, 0); } }
        __syncthreads();
        { LAS unsigned short* hb = (LAS unsigned short*)(lds + L3_V);
#pragma unroll
          for (int rt = 0; rt < 2; ++rt)
#pragma unroll
              for (int r = 0; r < 16; ++r) { const int l_ = 32 * rt + (r & 3) + 8 * (r >> 2) + 4 * hi; const float dn = dinv[l_];
                  const float x0 = acc[rt][0][r] * dn, x1 = acc[rt][1][r] * dn;
                  const unsigned pw = pk2(x0, x1);
                  hb[l_ * (L3_VSTR / 2) + 64 * w + l31] = (unsigned short)(pw & 0xffffu); hb[l_ * (L3_VSTR / 2) + 64 * w + 32 + l31] = (unsigned short)(pw >> 16);
                  float q2 = x0 * x0 + x1 * x1; q2 += __shfl_xor(q2, 1); q2 += __shfl_xor(q2, 2); q2 += __shfl_xor(q2, 4); q2 += __shfl_xor(q2, 8); q2 += __shfl_xor(q2, 16);
                  if (l31 == 0) ssq[w * 64 + l_] = q2; } }
        __syncthreads();
        if (tid < 64) { float tot = 0.f;
#pragma unroll
            for (int ww = 0; ww < 8; ++ww) tot += ssq[ww * 64 + tid];
            rstdv[tid] = 1.f / sqrtf(tot * (1.f / LDV) + NORM_EPS); }
        __syncthreads();
        { const int ch = tid & 63; const f32x4 ga = *(const f32x4*)(hgain + h * LDV + ch * 8), gb = *(const f32x4*)(hgain + h * LDV + ch * 8 + 4);
#pragma unroll 2
          for (int i = 0; i < 8; ++i) { const int r = (tid >> 6) + 8 * i;
              const v4u ogv = *(const v4u*)(z + (row0 + r) * INW_MAIN + 2 * QKW + DM + h * LDV + ch * 8);
              const v4u hv = *(const LAS v4u*)(lds + L3_V + r * L3_VSTR + ch * 16);
              float hf[8], gf[8]; unpack8(hv, hf); unpack8(ogv, gf);
              const float rstd = rstdv[r];
#pragma unroll
              for (int e = 0; e < 8; ++e) gf[e] = rstd * __builtin_amdgcn_rcpf(1.f + __expf(-gf[e]));
              v4u o; o.x = pk2(hf[0] * ga[0] * gf[0], hf[1] * ga[1] * gf[1]); o.y = pk2(hf[2] * ga[2] * gf[2], hf[3] * ga[3] * gf[3]);
              o.z = pk2(hf[4] * gb[0] * gf[4], hf[5] * gb[1] * gf[5]); o.w = pk2(hf[6] * gb[2] * gf[6], hf[7] * gb[3] * gf[7]);
              *(v4u*)(O + (row0 + r) * DM + h * LDV + ch * 8) = o; } }
    }
    __syncthreads();
}


constexpr int AT_K = 0, AT_V = 65536;
__device__ __forceinline__ void p_attn(const Frame& F, const bf16* qkv, const float* qg, const float* kg, bf16* OG, float* LSE) {
    const int tid = F.tid, lane = F.lane, w = F.wave, i15 = lane & 15, quad = lane >> 4, q4 = i15 >> 2, p4 = lane & 3;
    LAS unsigned char* lds = F.lds;
    int lk[4];
#pragma unroll
    for (int ks = 0; ks < 4; ++ks) lk[ks] = i15 * 256 + (((4 * ks + quad) ^ i15) << 4);
    int lv[8];
    { const int rl = 4 * quad + q4, sw = (rl & 7) << 1, ps = ((p4 & 1) << 1) | (p4 >> 1);
#pragma unroll
      for (int dt = 0; dt < 8; ++dt) lv[dt] = rl * 256 + (((2 * dt + (ps >> 1)) ^ sw) << 4) + 8 * (ps & 1); }
#define AT_NIT(it_) ((F.vcu + F.G * ((it_) / 12)) < 256)
#define AT_DECODE(it_) const int grp_ = F.vcu + F.G * ((it_) / 12), k_ = (it_) % 12, b_ = grp_ >> 7, h_ = (grp_ >> 3) & 15, o_ = grp_ & 7; \
        const int g_ = k_ >> 2, dil_ = (g_ == 0) ? 1 : (g_ == 1) ? 4 : 16; \
        const int res_ = (g_ == 0) ? 0 : (g_ == 1) ? (o_ >> 1) : (2 * o_ + ((k_ - 8) >> 1)), n_ = (g_ == 0) ? (4 * o_ + k_) : (g_ == 1) ? (4 * (o_ & 1) + (k_ - 4)) : (k_ & 1); \
        const bool first_ = (g_ == 2) ? ((k_ & 1) == 0) : ((k_ & 3) == 0); const size_t brow_ = (size_t)b_ * SEQ;
    v4u pkc[4], pvc[4], pkp[4], pvp[4], pq_[4];
#define AT_PRELOAD(it_) do { AT_DECODE(it_) \
        _Pragma("unroll") for (int i = 0; i < 4; ++i) { const int id = tid + 512 * i, j = id >> 4, ch = id & 15; \
            const bf16* src = qkv + (brow_ + (size_t)(128 * n_ + j) * dil_ + res_) * NQKV + DM + h_ * AHD + ch * 8; pkc[i] = *(const v4u*)src; pvc[i] = *(const v4u*)(src + DM); } \
        if (first_ && n_ > 0) { _Pragma("unroll") for (int i = 0; i < 4; ++i) { const int id = tid + 512 * i, j = id >> 4, ch = id & 15; \
            const bf16* src = qkv + (brow_ + (size_t)(128 * (n_ - 1) + j) * dil_ + res_) * NQKV + DM + h_ * AHD + ch * 8; pkp[i] = *(const v4u*)src; pvp[i] = *(const v4u*)(src + DM); } } \
        { const size_t qrow_ = brow_ + (size_t)(128 * n_ + 16 * w + i15) * dil_ + res_; \
          _Pragma("unroll") for (int ks = 0; ks < 4; ++ks) pq_[ks] = *(const v4u*)(qkv + qrow_ * NQKV + h_ * AHD + 32 * ks + 8 * quad); } } while (0)
    if (AT_NIT(0)) AT_PRELOAD(0);
    for (int it = 0; AT_NIT(it); ++it) {
        AT_DECODE(it)
        const int g = g_, h = h_, n = n_, dil = dil_, res = res_; const size_t brow = brow_;
        const int hcur = (n & 1) * 32768, hprev = 32768 - hcur;
        asm volatile("s_waitcnt lgkmcnt(0)" ::: "memory"); __builtin_amdgcn_s_barrier(); asm volatile("" ::: "memory");
#pragma unroll
        for (int i = 0; i < 4; ++i) { const int id = tid + 512 * i, j = id >> 4, ch = id & 15;
            *(LAS v4u*)(lds + AT_K + hcur + j * 256 + ((ch ^ (j & 15)) << 4)) = pkc[i];
            *(LAS v4u*)(lds + AT_V + hcur + j * 256 + ((ch ^ ((j & 7) << 1)) << 4)) = pvc[i]; }
        if (first_) {
#pragma unroll
            for (int i = 0; i < 4; ++i) { const int id = tid + 512 * i, j = id >> 4, ch = id & 15;
                v4u kv = pkp[i], vvv = pvp[i]; if (n == 0) { kv = (v4u){0u, 0u, 0u, 0u}; vvv = kv; }
                *(LAS v4u*)(lds + AT_K + hprev + j * 256 + ((ch ^ (j & 15)) << 4)) = kv;
                *(LAS v4u*)(lds + AT_V + hprev + j * 256 + ((ch ^ ((j & 7) << 1)) << 4)) = vvv; } }
        const size_t qrow = brow + (size_t)(128 * n + 16 * w + i15) * dil + res;
        bf16x8 qf[4];
#pragma unroll
        for (int ks = 0; ks < 4; ++ks) qf[ks] = __builtin_bit_cast(bf16x8, pq_[ks]);
        asm volatile("s_waitcnt lgkmcnt(0)" ::: "memory"); __builtin_amdgcn_s_barrier(); asm volatile("" ::: "memory");
        if (AT_NIT(it + 1)) AT_PRELOAD(it + 1);
#define AT_TOFF(T) ((((T) < 8) ? hprev : hcur) + ((T) & 7) * 4096)
        pg8::f32x4 st[9];
        { bf16x8 ka[3][4];
#pragma unroll
          for (int ks = 0; ks < 4; ++ks) { ka[0][ks] = *(const LAS bf16x8*)(lds + AT_K + AT_TOFF(w) + lk[ks]); ka[1][ks] = *(const LAS bf16x8*)(lds + AT_K + AT_TOFF(w + 1) + lk[ks]); }
#pragma unroll
          for (int jt = 0; jt < 9; ++jt) { st[jt] = (pg8::f32x4){0.f, 0.f, 0.f, 0.f};
              if (jt < 7) {
#pragma unroll
                  for (int ks = 0; ks < 4; ++ks) ka[(jt + 2) % 3][ks] = *(const LAS bf16x8*)(lds + AT_K + AT_TOFF(w + jt + 2) + lk[ks]); }
              if (n > 0 || w + jt >= 8) {
#pragma unroll
              for (int ks = 0; ks < 4; ++ks) st[jt] = __builtin_amdgcn_mfma_f32_16x16x32_bf16(ka[jt % 3][ks], qf[ks], st[jt], 0, 0, 0); }
              __builtin_amdgcn_sched_barrier(0); } }
        float mx = -INFINITY;
#pragma unroll
        for (int jt = 0; jt < 9; ++jt) { const bool tile_ok = (n > 0) || (w + jt >= 8);
#pragma unroll
            for (int e = 0; e < 4; ++e) { const int dj = 16 * jt + 4 * quad + e - i15;
                const bool ok = tile_ok && (jt != 0 || dj >= 0) && (jt != 8 || dj <= 128);
                const float s = ok ? st[jt][e] : -INFINITY; st[jt][e] = s; mx = fmaxf(mx, s); } }
        mx = fmaxf(mx, __shfl_xor(mx, 16)); mx = fmaxf(mx, __shfl_xor(mx, 32));
        float l = 0.f;
#pragma unroll
        for (int jt = 0; jt < 9; ++jt)
#pragma unroll
            for (int e = 0; e < 4; ++e) { const float p = __builtin_amdgcn_exp2f(st[jt][e] - mx); st[jt][e] = p; l += p; }
        l += __shfl_xor(l, 16); l += __shfl_xor(l, 32);
        pg8::f32x4 ot[8];
#pragma unroll
        for (int dt = 0; dt < 8; ++dt) ot[dt] = (pg8::f32x4){0.f, 0.f, 0.f, 0.f};
        { bf16x8 pb[5];
#pragma unroll
          for (int kk = 0; kk < 5; ++kk) { v4u pw; pw.x = pk2(st[2 * kk][0], st[2 * kk][1]); pw.y = pk2(st[2 * kk][2], st[2 * kk][3]);
              if (kk < 4) { pw.z = pk2(st[2 * kk + 1][0], st[2 * kk + 1][1]); pw.w = pk2(st[2 * kk + 1][2], st[2 * kk + 1][3]); } else { pw.z = 0u; pw.w = 0u; }
              pb[kk] = __builtin_bit_cast(bf16x8, pw); }
          s16x4 vf[3][4][2];
          const int t1last = (w == 7) ? 8 : 9;
#define AT_VLOAD(bt, buf) do { const int kk_ = (bt) >> 1, hf_ = (bt) & 1; const int t0_ = w + 2 * kk_, t1_ = w + ((kk_ < 4) ? (2 * kk_ + 1) : t1last); const int o0_ = AT_TOFF(t0_), o1_ = AT_TOFF(t1_); \
          _Pragma("unroll") for (int d_ = 0; d_ < 4; ++d_) { vf[buf][d_][0] = vtr((lds_cptr)(lds + AT_V + o0_ + lv[4 * hf_ + d_])); vf[buf][d_][1] = vtr((lds_cptr)(lds + AT_V + o1_ + lv[4 * hf_ + d_])); } } while (0)
          AT_VLOAD(0, 0); AT_VLOAD(1, 1);
#pragma unroll
          for (int bt = 0; bt < 10; ++bt) {
              if (bt < 8) AT_VLOAD(bt + 2, (bt + 2) % 3);
              if (n > 0 || w + 2 * (bt >> 1) + 1 >= 8) {
#pragma unroll
              for (int d = 0; d < 4; ++d) ot[4 * (bt & 1) + d] = __builtin_amdgcn_mfma_f32_16x16x32_bf16(cat8(vf[bt % 3][d][0], vf[bt % 3][d][1]), pb[bt >> 1], ot[4 * (bt & 1) + d], 0, 0, 0); }
              __builtin_amdgcn_sched_barrier(0); }
#undef AT_VLOAD
        }
#undef AT_TOFF
        { const float il = 1.f / l; const int hi32 = quad >> 1, ql = quad & 1; bf16* op = OG + ((size_t)g * MROWS + qrow) * DM + h * AHD + 16 * hi32 + 8 * ql;
#pragma unroll
          for (int dp = 0; dp < 4; ++dp) { const unsigned x0 = pk2(ot[2 * dp][0] * il, ot[2 * dp][1] * il), x1 = pk2(ot[2 * dp][2] * il, ot[2 * dp][3] * il);
              const unsigned y0 = pk2(ot[2 * dp + 1][0] * il, ot[2 * dp + 1][1] * il), y1 = pk2(ot[2 * dp + 1][2] * il, ot[2 * dp + 1][3] * il);
              const auto r0 = __builtin_amdgcn_permlane32_swap(x0, y0, false, false), r1 = __builtin_amdgcn_permlane32_swap(x1, y1, false, false);
              v4u o; o.x = r0[0]; o.y = r1[0]; o.z = r0[1]; o.w = r1[1]; *(v4u*)(op + 32 * dp) = o; }
          if (quad == 0) LSE[(qrow * AH + h) * 4 + g] = (mx + __log2f(l)) * 0.6931471805599453f; }
    }
#undef AT_NIT
#undef AT_DECODE
#undef AT_PRELOAD
    __syncthreads();
}
__device__ __forceinline__ void p_attn_combine(const Frame& F, const bf16* OG, const float* LSE, bf16* O) {
    const size_t total = (size_t)MROWS * (DM / 8), stride = (size_t)F.G * NTHREADS;
    for (size_t idx = (size_t)F.vcu * NTHREADS + F.tid; idx < total; idx += stride) {
        const int c8 = (int)(idx & 255), row = (int)(idx >> 8), h = c8 >> 4;
        const f32x4 lv = *(const f32x4*)(LSE + ((size_t)row * AH + h) * 4); const float l0 = lv[0], l1 = lv[1], l2 = lv[2];
        const float m = fmaxf(l0, fmaxf(l1, l2)); float w0 = __expf(l0 - m), w1 = __expf(l1 - m), w2 = __expf(l2 - m); const float inv = 1.f / (w0 + w1 + w2); w0 *= inv; w1 *= inv; w2 *= inv;
        const v4u a = *(const v4u*)(OG + ((size_t)0 * MROWS + row) * DM + c8 * 8), bq = *(const v4u*)(OG + ((size_t)1 * MROWS + row) * DM + c8 * 8), cq = *(const v4u*)(OG + ((size_t)2 * MROWS + row) * DM + c8 * 8);
        v4u o;
        o.x = pk2(w0 * bflo(a.x) + w1 * bflo(bq.x) + w2 * bflo(cq.x), w0 * bfhi(a.x) + w1 * bfhi(bq.x) + w2 * bfhi(cq.x));
        o.y = pk2(w0 * bflo(a.y) + w1 * bflo(bq.y) + w2 * bflo(cq.y), w0 * bfhi(a.y) + w1 * bfhi(bq.y) + w2 * bfhi(cq.y));
        o.z = pk2(w0 * bflo(a.z) + w1 * bflo(bq.z) + w2 * bflo(cq.z), w0 * bfhi(a.z) + w1 * bfhi(bq.z) + w2 * bfhi(cq.z));
        o.w = pk2(w0 * bflo(a.w) + w1 * bflo(bq.w) + w2 * bflo(cq.w), w0 * bfhi(a.w) + w1 * bfhi(bq.w) + w2 * bfhi(cq.w));
        *(v4u*)(O + (size_t)row * DM + c8 * 8) = o;
    }
}

__device__ __forceinline__ void p_gemm_bf16(const Frame& F, const bf16* A, const bf16* Bt, int N, int K, bf16* O) {
    pg8::Gemm g{A, Bt, MROWS, N, K}; pg8::EpiBf16<0> E{O, N, nullptr, 0, 0, 1.f};
    pg8::StaticOrder S; S.init(MROWS, N, F.G, (int)blockIdx.x);
    pg8::gemm_phase<pg8::EpiBf16<0>, pg8::StaticOrder, true, true>(F.lds, g, S, E);
}
template <bool RB_IN, bool RB_OUT, bool WITH_SSQ> __device__ __forceinline__ void p_gemm_res(const Frame& F, const bf16* A, const bf16* Bt, int N, int K, const void* base, void* out, float* ssq = nullptr) {
    pg8::Gemm g{A, Bt, MROWS, N, K}; pg8::EpiRes<RB_IN, RB_OUT, WITH_SSQ> E{base, out, N, ssq};
    pg8::StaticOrder S; S.init(MROWS, N, F.G, (int)blockIdx.x);
    pg8::gemm_phase<pg8::EpiRes<RB_IN, RB_OUT, WITH_SSQ>, pg8::StaticOrder, true, true>(F.lds, g, S, E);
}
__device__ __forceinline__ void p_gemm_convgate(const Frame& F, const bf16* X, const bf16* Wt, const float* cw, const float* cb, bf16* Gout, const float* ssq) {
    pg8::Gemm g{Wt, X, FFN2, MROWS, DM}; pg8::EpiConvGateT E{Gout, cw, cb, (PG8_LAS float*)(F.lds + RING_BYTES)};
    pg8::StaticOrder S; S.init_tiles(FFN2 / 256, 2 * pg8::EpiConvGateT::TPS, F.G, (int)blockIdx.x);
    { LAS float* rsl = (LAS float*)(F.lds + RING_BYTES) + 5120; const int rl = F.tid >> 1, hf = F.tid & 1;
      __syncthreads();
#pragma unroll 2
      for (int i = 0; i < 7; ++i) { pg8::Unit u; if (!S.next(i, u)) break;
          int grow = pg8::EpiConvGateT::b_row0(u.pn) + rl; grow = grow < 0 ? 0 : (grow > MROWS - 1 ? MROWS - 1 : grow);
          const float* sp = ssq + (size_t)grow * 32 + 16 * hf; const f32x4 a0 = *(const f32x4*)sp, a1 = *(const f32x4*)(sp + 4), a2 = *(const f32x4*)(sp + 8), a3 = *(const f32x4*)(sp + 12);
          float t = ((a0[0] + a0[1]) + (a0[2] + a0[3])) + ((a1[0] + a1[1]) + (a1[2] + a1[3])) + ((a2[0] + a2[1]) + (a2[2] + a2[3])) + ((a3[0] + a3[1]) + (a3[2] + a3[3]));
          t += __shfl_xor(t, 1); if (hf == 0) rsl[256 * i + rl] = __builtin_amdgcn_rsqf(t * (1.f / DM) + NORM_EPS); }
      __syncthreads(); }
    pg8::gemm_phase<pg8::EpiConvGateT, pg8::StaticOrder, true, true>(F.lds, g, S, E);
}

__device__ __forceinline__ void p_gemm_qkv(const Frame& F, const bf16* A, const bf16* Bt, const float* qg, const float* kg, bf16* O) {
    pg8::Gemm g{A, Bt, MROWS, NQKV, DM}; pg8::EpiQKV E{O, NQKV, qg, kg, (PG8_LAS float*)(F.lds + RING_BYTES), 0.08838834764831845f * 1.4426950408889634f};
    pg8::StaticOrder S; S.init(MROWS, NQKV, F.G, (int)blockIdx.x);
    pg8::gemm_phase<pg8::EpiQKV, pg8::StaticOrder, true, true>(F.lds, g, S, E);
}

constexpr int N_PHASES = 15;
__global__ void __launch_bounds__(NTHREADS, 2) mega(Args args) {
    extern __shared__ __attribute__((aligned(16))) unsigned char lds_raw[];
    Frame F; F.lds = (LAS unsigned char*)lds_raw;
    F.tid = threadIdx.x; F.lane = F.tid & 63; F.wave = __builtin_amdgcn_readfirstlane(F.tid >> 6);
    F.G = gridDim.x; { const int bx = blockIdx.x; F.vcu = (F.G % 8 == 0) ? (bx % 8) * (F.G / 8) + bx / 8 : bx; }
    volatile LAS unsigned* MISC = (volatile LAS unsigned*)(F.lds + MISC_OFF);
    static_assert(L3_END <= MISC_OFF, "LDS map");
    for (int u = F.tid; u < (LDS_BYTES - MISC_OFF) / 4; u += NTHREADS) ((LAS unsigned*)(F.lds + MISC_OFF))[u] = 0u;
    __syncthreads();
    unsigned char* ws = args.ws;
    unsigned* ctl = (unsigned*)(ws + WS_CTL);
    XcdBarrier bar = xcd_barrier_post(ctl + CW_BAR, MISC);

    const float* x = args.in[0];
    const float *attn_norm = args.in[1], *w_qkv = args.in[2], *q_gain = args.in[3], *k_gain = args.in[4], *w_o = args.in[5];
    const float *lstm_norm = args.in[6], *w_in = args.in[7], *gate_bias = args.in[8], *lconv_w = args.in[9], *lconv_b = args.in[10], *head_gain = args.in[11], *w_out = args.in[12];
    const float *ffn_norm = args.in[13], *w_up = args.in[14], *fconv_w = args.in[15], *fconv_b = args.in[16], *w_down = args.in[17];
    float* out = args.out;
    bf16 *Wqkv = (bf16*)(ws + WS_WQKV), *Wo = (bf16*)(ws + WS_WO), *Win = (bf16*)(ws + WS_WIN), *Wout = (bf16*)(ws + WS_WOUT), *Wup = (bf16*)(ws + WS_WUP), *Wdn = (bf16*)(ws + WS_WDN);
    bf16 *HN = (bf16*)(ws + WS_HN), *G = (bf16*)(ws + WS_G), *QKV = (bf16*)(ws + WS_QKV), *O = (bf16*)(ws + WS_O), *QKC = (bf16*)(ws + WS_QKC), *U = (bf16*)(ws + WS_U);
    bf16* OG = (bf16*)(ws + WS_QKC); float* LSE = (float*)(ws + WS_G);
    float* SSQ = (float*)(ws + WS_SSQ); float* GWT = (float*)(ws + WS_GWT); bf16* XR = (bf16*)(ws + WS_XR);
    float *GATES = (float*)(ws + WS_GATES), *SU = (float*)(ws + WS_SU), *SM = (float*)(ws + WS_SM), *SE = (float*)(ws + WS_SE);

    const int lo = args.ph_lo, hi = args.ph_hi;
#define IN(k) (lo <= (k) && (k) < hi)

    int ph = 0;
#ifndef PROBE_MASK
#define PROBE_MASK 0u
#endif
#define PHASE(body) do { if (IN(ph)) { body; if ((PROBE_MASK >> ph) & 1u) { body; } } if (IN(ph) && IN(ph + 1)) xcd_barrier(bar); ++ph; } while (0)
    PHASE(
        p_convert(F, w_qkv, Wqkv, DM, NQKV, NQKV);
        p_convert(F, w_o, Wo, DM, DM, DM);
        p_convert(F, w_in, Win, DM, INW, INW_MAIN);
        p_convert(F, w_out, Wout, DM, DM, DM);
        p_convert(F, w_up, Wup, DM, FFN2, FFN2, true, 0, 0, ffn_norm);
        p_convert(F, w_down, Wdn, FFN, DM, DM);
        p_pack_gates(F, w_in, GWT);
        p_rmsnorm<false>(F, x, attn_norm, HN, nullptr, nullptr, nullptr));
    PHASE(p_gemm_qkv(F, HN, Wqkv, q_gain, k_gain, QKV));
    PHASE(p_attn(F, QKV, q_gain, k_gain, OG, LSE));
    PHASE(p_attn_combine(F, OG, LSE, O));
    PHASE((p_gemm_res<false, true, true>(F, O, Wo, DM, DM, x, XR, SSQ)));
    PHASE(p_gemm_convgate(F, XR, Wup, fconv_w, fconv_b, G, SSQ));
    PHASE((p_gemm_res<true, true, false>(F, G, Wdn, DM, FFN, XR, XR)));
    PHASE(p_lstm_norm(F, XR, lstm_norm, HN, GWT, gate_bias, GATES));
    PHASE(p_gemm_bf16(F, HN, Win, INW_MAIN, DM, QKV));
    PHASE(p_lstm_scan2(F, GATES, SU, SM, SE); p_lstm_conv(F, QKV, lconv_w, lconv_b, QKC));
    PHASE(p_lstm_state(F, QKC, QKV, SU, SM, ws + WS_CST, (float*)(ws + WS_NST));
          p_convert(F, w_up + (size_t)DM * FFN2, Wup + (size_t)FFN2 * DM, DM, FFN2, FFN2, true, 8 * NSL, F.G - 8 * NSL, ffn_norm + DM);
          p_convert(F, w_down + (size_t)FFN * DM, Wdn + (size_t)DM * FFN, FFN, DM, DM, false, 8 * NSL, F.G - 8 * NSL));
    PHASE(p_lstm_out(F, QKC, QKV, SU, SM, SE, ws + WS_CST, (const float*)(ws + WS_NST), head_gain, O));
    PHASE((p_gemm_res<true, true, true>(F, O, Wout, DM, DM, XR, XR, SSQ)));
    PHASE(p_gemm_convgate(F, XR, Wup + (size_t)FFN2 * DM, fconv_w + 3 * FFN2, fconv_b + FFN2, G, SSQ));
    PHASE((p_gemm_res<true, false, false>(F, G, Wdn + (size_t)DM * FFN, DM, FFN, XR, out)));
#undef PHASE
#undef IN
}

extern "C" void kernel_launch(void* const* d_in, const int* in_sizes, int n_in, void* d_out, int out_size, void* d_ws, size_t ws_size, hipStream_t stream) {
    static int grid = 0;
    if (grid == 0) {
        if (n_in != 18 || in_sizes[0] != MROWS * DM || out_size != MROWS * DM || ws_size < WS_END) { fprintf(stderr, "kernel_launch: unexpected problem (n_in %d, ws %zu < %zu)\n", n_in, ws_size, (size_t)WS_END); grid = -1; return; }
        int dev = 0, cus = 0, per_cu = 0;
        if (hipGetDevice(&dev) != hipSuccess || hipDeviceGetAttribute(&cus, hipDeviceAttributeMultiprocessorCount, dev) != hipSuccess) { grid = -1; return; }
        if (hipFuncSetAttribute((const void*)mega, hipFuncAttributeMaxDynamicSharedMemorySize, LDS_BYTES) != hipSuccess) { fprintf(stderr, "kernel_launch: hipFuncSetAttribute failed\n"); grid = -1; return; }
        if (hipOccupancyMaxActiveBlocksPerMultiprocessor(&per_cu, (const void*)mega, NTHREADS, LDS_BYTES) != hipSuccess || per_cu < 1) { fprintf(stderr, "kernel_launch: occupancy query says %d\n", per_cu); per_cu = 1; }
        (void)hipGetLastError();
        grid = cus;
    }
    if (grid < 0) return;
    if (hipMemsetAsync((char*)d_ws + WS_CTL, 0, CTL_ZERO_BYTES, stream) != hipSuccess) return;
    Args a; memset(&a, 0, sizeof(a));
    for (int i = 0; i < 18; ++i) a.in[i] = (const float*)d_in[i];
    a.out = (float*)d_out; a.ws = (unsigned char*)d_ws; a.ph_lo = 0; a.ph_hi = N_PHASES;
    void* kargs[] = {&a};
    hipError_t e = hipLaunchCooperativeKernel((const void*)mega, dim3(grid), dim3(NTHREADS), kargs, LDS_BYTES, stream);
    if (e != hipSuccess) { fprintf(stderr, "kernel_launch: cooperative launch failed: %s; plain launch instead\n", hipGetErrorString(e)); (void)hipGetLastError();
        hipLaunchKernelGGL(mega, dim3(grid), dim3(NTHREADS), LDS_BYTES, stream, a); }
}
```

```cpp
#include <hip/hip_runtime.h>
#include <cstdio>
#include <cstdint>
#include <cstring>

namespace pg8 {
#define PG8_LAS __attribute__((address_space(3)))
typedef unsigned short bf16_t;
typedef short bf16x8 __attribute__((ext_vector_type(8)));
typedef float f32x4 __attribute__((ext_vector_type(4)));
typedef unsigned u32x4 __attribute__((ext_vector_type(4)));
constexpr int BM = 256, BK = 64, HALF = 128, HTB = HALF * BK * 2  , STAGE_BYTES = 8 * HTB, NXCD = 8, WGM = 8;

__host__ __device__ __forceinline__ int lds_byte(int r, int c) { const int st = (r >> 4) * 2 + (c >> 5), rr = r & 15, cc = c & 31, ob = rr * 64 + cc * 2; return st * 1024 + (ob ^ (((ob >> 9) & 1) << 5)); }
__host__ __device__ __forceinline__ void stage_rc(int b, int& R, int& C) { const int st = b / 1024, sb = b % 1024, swz = sb ^ (((sb >> 9) & 1) << 5); R = (st >> 1) * 16 + swz / 64; C = (st & 1) * 32 + (swz % 64) / 2; }
__host__ __device__ __forceinline__ int perm32(int rho) { const int n = rho >> 4, i = rho & 15; return 8 * (i >> 2) + 4 * n + (i & 3); }

struct Unit { int pm, pn; };
struct Gemm { const bf16_t* A; const bf16_t* Bt; int M, N, K; };

struct StaticOrder {
    int nM, nN, nwg, G, c;
    __host__ __device__ void init(int M, int N, int G_, int c_) { nM = M / BM; nN = N / BM; nwg = nM * nN; G = G_; c = c_; }
    __host__ __device__ void init_tiles(int nM_, int nN_, int G_, int c_) { nM = nM_; nN = nN_; nwg = nM * nN; G = G_; c = c_; }
    __host__ __device__ bool next(int i, Unit& u) const {
        const long L = (long)i * G + c; if (L >= nwg) return false;
        int wgid = (int)L; { const int q = nwg / NXCD, r = nwg % NXCD, xcd = wgid % NXCD, off = wgid / NXCD; wgid = (xcd < r ? xcd * (q + 1) : r * (q + 1) + (xcd - r) * q) + off; }
        const int nig = WGM * nN, gid = wgid / nig, fm = gid * WGM, gsz = (nM - fm) < WGM ? (nM - fm) : WGM;
        u.pm = fm + ((wgid % nig) % gsz); u.pn = (wgid % nig) / gsz; return true;
    }
    __device__ __forceinline__ void a_ready(const Unit&) const {}
    __device__ __forceinline__ void done(const Unit&) const {}
};
__device__ __forceinline__ unsigned cvt_pk_bf16(float lo, float hi) { unsigned r; asm volatile("v_cvt_pk_bf16_f32 %0, %1, %2" : "=v"(r) : "v"(lo), "v"(hi)); return r; }
typedef float f32x2 __attribute__((ext_vector_type(2)));
__device__ __forceinline__ f32x2 gelu_pk(f32x2 v) {
    const f32x2 av = __builtin_elementwise_abs(v), d = av * 0.2316418882f + 1.0f;
    f32x2 t; t.x = __builtin_amdgcn_rcpf(d.x); t.y = __builtin_amdgcn_rcpf(d.y);
    f32x2 q = t * 0.5307027145f + (-0.7265760135f); q = q * t + 0.7107068705f; q = q * t + (-0.142248368f); q = q * t + 0.127414796f; q = q * t;
    const f32x2 s = (v * v) * (-0.72134752044f);
    f32x2 e; e.x = __builtin_amdgcn_exp2f(s.x); e.y = __builtin_amdgcn_exp2f(s.y);
    const f32x2 m = v * (q * e), r = v - m;
    f32x2 o; o.x = v.x < 0.f ? m.x : r.x; o.y = v.y < 0.f ? m.y : r.y; return o;
}

template <int ACT  > struct EpiBf16 {
    static constexpr bool PERM = true, AFTER_DRAIN = false, ACC_INIT = false; static_assert(ACT == 0 || ACT == 1, "EpiBf16: ACT is 0 (none) or 1 (gelu_pk)");
    static __host__ __device__ __forceinline__ int a_row0(int pm) { return pm * BM; }
    static __host__ __device__ __forceinline__ int b_row0(int pn) { return pn * BM; }
    bf16_t* O; int ldc; const float* bias; int split_cols; size_t split_stride; float scale0;
    __device__ __forceinline__ void operator()(const f32x4 (&acc)[2][2][4][2], const Unit& u, int wr, int wc, int fr, int fq, int ui) const {
        const int row0 = u.pm * BM + wr * 64 + fr; int colt = u.pn * BM; bf16_t* base = O;
        float sc = 1.f; if (split_cols) { const int t = colt / split_cols; base += (size_t)t * split_stride; colt -= t * split_cols; if (t == 0) sc = scale0; }
        const int col0 = colt + wc * 32 + 8 * fq, bcol0 = u.pn * BM + wc * 32 + 8 * fq;
        f32x4 bv[2][2];
#pragma unroll
        for (int bj = 0; bj < 2; ++bj)
#pragma unroll
            for (int n = 0; n < 2; ++n) bv[bj][n] = bias ? *(const f32x4*)(bias + bcol0 + bj * HALF + 4 * n) : (f32x4){0.f, 0.f, 0.f, 0.f};
#pragma unroll
        for (int ai = 0; ai < 2; ++ai)
#pragma unroll
            for (int m = 0; m < 4; ++m) { bf16_t* rowp = base + (size_t)(row0 + ai * HALF + m * 16) * ldc + col0;
#pragma unroll
                for (int bj = 0; bj < 2; ++bj) { f32x4 v0 = acc[ai][bj][m][0] + bv[bj][0], v1 = acc[ai][bj][m][1] + bv[bj][1];
                    if (ACT == 1) { f32x2 a = gelu_pk((f32x2){v0[0], v0[1]}), b = gelu_pk((f32x2){v0[2], v0[3]}), c = gelu_pk((f32x2){v1[0], v1[1]}), d = gelu_pk((f32x2){v1[2], v1[3]});
                        v0 = (f32x4){a.x, a.y, b.x, b.y}; v1 = (f32x4){c.x, c.y, d.x, d.y}; }
                    v0 = v0 * sc; v1 = v1 * sc; u32x4 w; w.x = cvt_pk_bf16(v0[0], v0[1]); w.y = cvt_pk_bf16(v0[2], v0[3]); w.z = cvt_pk_bf16(v1[0], v1[1]); w.w = cvt_pk_bf16(v1[2], v1[3]);
                    *(u32x4*)(rowp + bj * HALF) = w; } }
    }
};
struct EpiBf16RS {
    static constexpr bool PERM = true, AFTER_DRAIN = false, ACC_INIT = false;
    static __host__ __device__ __forceinline__ int a_row0(int pm) { return pm * BM; }
    static __host__ __device__ __forceinline__ int b_row0(int pn) { return pn * BM; }
    bf16_t* O; int ldc; const PG8_LAS float* rsl;
    __device__ __forceinline__ void operator()(const f32x4 (&acc)[2][2][4][2], const Unit& u, int wr, int wc, int fr, int fq, int ui) const {
        const int row0 = u.pm * BM + wr * 64 + fr, col0 = u.pn * BM + wc * 32 + 8 * fq;
#pragma unroll
        for (int ai = 0; ai < 2; ++ai)
#pragma unroll
            for (int m = 0; m < 4; ++m) { bf16_t* rowp = O + (size_t)(row0 + ai * HALF + m * 16) * ldc + col0; const float sc = rsl[256 * ui + ai * HALF + wr * 64 + m * 16 + fr];
#pragma unroll
                for (int bj = 0; bj < 2; ++bj) { const f32x4 v0 = acc[ai][bj][m][0] * sc, v1 = acc[ai][bj][m][1] * sc;
                    u32x4 w; w.x = cvt_pk_bf16(v0[0], v0[1]); w.y = cvt_pk_bf16(v0[2], v0[3]); w.z = cvt_pk_bf16(v1[0], v1[1]); w.w = cvt_pk_bf16(v1[2], v1[3]);
                    *(u32x4*)(rowp + bj * HALF) = w; } }
    }
};
template <bool RB_IN, bool RB_OUT, bool WITH_SSQ, bool WITH_GATES = false> struct EpiRes {
    static constexpr bool PERM = true, AFTER_DRAIN = false, ACC_INIT = true;
    static __host__ __device__ __forceinline__ int a_row0(int pm) { return pm * BM; }
    static __host__ __device__ __forceinline__ int b_row0(int pn) { return pn * BM; }
    const void* base; void* out; int ldc; float* ssq; const unsigned char* wgf; float* gp;
    static __device__ __forceinline__ f32x4 up2(unsigned lo, unsigned hi) { return (f32x4){__builtin_bit_cast(float, lo << 16), __builtin_bit_cast(float, lo & 0xffff0000u), __builtin_bit_cast(float, hi << 16), __builtin_bit_cast(float, hi & 0xffff0000u)}; }
    __device__ __forceinline__ void init(f32x4 (&acc)[2][2][4][2], const Unit& u, int wr, int wc, int fr, int fq) const {
        const int row0 = u.pm * BM + wr * 64 + fr, col0 = u.pn * BM + wc * 32 + 8 * fq;
#pragma unroll
        for (int ai = 0; ai < 2; ++ai)
#pragma unroll
            for (int m = 0; m < 4; ++m) { const size_t ro = (size_t)(row0 + ai * HALF + m * 16) * ldc + col0;
#pragma unroll
                for (int bj = 0; bj < 2; ++bj) { const size_t o = ro + bj * HALF;
                    if constexpr (RB_IN) { const u32x4 w = *(const u32x4*)((const bf16_t*)base + o); acc[ai][bj][m][0] = up2(w.x, w.y); acc[ai][bj][m][1] = up2(w.z, w.w); }
                    else { acc[ai][bj][m][0] = *(const f32x4*)((const float*)base + o); acc[ai][bj][m][1] = *(const f32x4*)((const float*)base + o + 4); } } }
    }
    __device__ __forceinline__ void operator()(const f32x4 (&acc)[2][2][4][2], const Unit& u, int wr, int wc, int fr, int fq, int ui) const {
        const int row0 = u.pm * BM + wr * 64 + fr, col0 = u.pn * BM + wc * 32 + 8 * fq;
        bf16x8 wf[2];
        if constexpr (WITH_GATES) {
#pragma unroll
            for (int bj = 0; bj < 2; ++bj) wf[bj] = *(const bf16x8*)(wgf + ((size_t)(8 * u.pn + 4 * bj + wc) * 64 + (fq * 16 + fr)) * 16); }
#pragma unroll
        for (int ai = 0; ai < 2; ++ai)
#pragma unroll
            for (int m = 0; m < 4; ++m) { const size_t ro = (size_t)(row0 + ai * HALF + m * 16) * ldc + col0; float q = 0.f; f32x4 gd = {0.f, 0.f, 0.f, 0.f};
#pragma unroll
                for (int bj = 0; bj < 2; ++bj) { const size_t o = ro + bj * HALF; const f32x4 v0 = acc[ai][bj][m][0], v1 = acc[ai][bj][m][1];
                    if constexpr (RB_OUT) { u32x4 w; w.x = cvt_pk_bf16(v0[0], v0[1]); w.y = cvt_pk_bf16(v0[2], v0[3]); w.z = cvt_pk_bf16(v1[0], v1[1]); w.w = cvt_pk_bf16(v1[2], v1[3]); *(u32x4*)((bf16_t*)out + o) = w;
                        if constexpr (WITH_GATES) gd = __builtin_amdgcn_mfma_f32_16x16x32_bf16(wf[bj], __builtin_bit_cast(bf16x8, w), gd, 0, 0, 0); }
                    else { *(f32x4*)((float*)out + o) = v0; *(f32x4*)((float*)out + o + 4) = v1; }
                    if constexpr (WITH_SSQ) q += ((v0[0] * v0[0] + v0[1] * v0[1]) + (v0[2] * v0[2] + v0[3] * v0[3])) + ((v1[0] * v1[0] + v1[1] * v1[1]) + (v1[2] * v1[2] + v1[3] * v1[3])); }
                if constexpr (WITH_SSQ) { q += __shfl_xor(q, 16); q += __shfl_xor(q, 32); if (fq == 0) ssq[(size_t)(row0 + ai * HALF + m * 16) * 32 + 4 * u.pn + wc] = q; }
                if constexpr (WITH_GATES) {
#pragma unroll
                    for (int e = 0; e < 4; ++e) gd[e] += __shfl_xor(gd[e], 32);
                    if (fq < 2) *(f32x4*)(gp + ((size_t)(row0 + ai * HALF + m * 16) * 32 + 4 * u.pn + wc) * 8 + 4 * fq) = gd; } }
    }
};
struct EpiQKV {
    static constexpr bool PERM = true, AFTER_DRAIN = false, ACC_INIT = false;
    static __host__ __device__ __forceinline__ int a_row0(int pm) { return pm * BM; }
    static __host__ __device__ __forceinline__ int b_row0(int pn) { return pn * BM; }
    bf16_t* O; int ldc; const float* qg; const float* kg; PG8_LAS float* part; float qscale;
    __device__ __forceinline__ void operator()(const f32x4 (&acc)[2][2][4][2], const Unit& u, int wr, int wc, int fr, int fq, int ui) const {
        const int kind = u.pn >> 3;
        const int row0 = u.pm * BM + wr * 64 + fr, col0 = u.pn * BM + wc * 32 + 8 * fq;
        if (kind < 2) {
#pragma unroll
            for (int ai = 0; ai < 2; ++ai)
#pragma unroll
                for (int m = 0; m < 4; ++m)
#pragma unroll
                    for (int bj = 0; bj < 2; ++bj) { const f32x4 a = acc[ai][bj][m][0], b = acc[ai][bj][m][1];
                        float q = ((a[0] * a[0] + a[1] * a[1]) + (a[2] * a[2] + a[3] * a[3])) + ((b[0] * b[0] + b[1] * b[1]) + (b[2] * b[2] + b[3] * b[3]));
                        q += __shfl_xor(q, 16); q += __shfl_xor(q, 32);
                        if (fq == 0) part[((ai * HALF + wr * 64 + m * 16 + fr) * 2 + bj) * 4 + wc] = q; }
        }
        asm volatile("s_waitcnt lgkmcnt(0)" ::: "memory"); __builtin_amdgcn_s_barrier(); asm volatile("" ::: "memory");
        f32x4 g0 = (f32x4){1.f, 1.f, 1.f, 1.f}, g1 = g0;
        if (kind < 2) { const float* gp = (kind == 0 ? qg : kg) + wc * 32 + 8 * fq; g0 = *(const f32x4*)gp; g1 = *(const f32x4*)(gp + 4); }
        const float sc = (kind == 0) ? qscale : 1.f;
#pragma unroll
        for (int ai = 0; ai < 2; ++ai)
#pragma unroll
            for (int m = 0; m < 4; ++m) { bf16_t* rowp = O + (size_t)(row0 + ai * HALF + m * 16) * ldc + col0;
#pragma unroll
                for (int bj = 0; bj < 2; ++bj) { float rs = 1.f;
                    if (kind < 2) { const f32x4 pp = *(const PG8_LAS f32x4*)(part + ((ai * HALF + wr * 64 + m * 16 + fr) * 2 + bj) * 4); rs = sc * __builtin_amdgcn_rsqf(((pp[0] + pp[1]) + (pp[2] + pp[3])) * (1.f / 128.f) + 1e-6f); }
                    const f32x4 v0 = acc[ai][bj][m][0] * g0 * rs, v1 = acc[ai][bj][m][1] * g1 * rs;
                    u32x4 w; w.x = cvt_pk_bf16(v0[0], v0[1]); w.y = cvt_pk_bf16(v0[2], v0[3]); w.z = cvt_pk_bf16(v1[0], v1[1]); w.w = cvt_pk_bf16(v1[2], v1[3]);
                    *(u32x4*)(rowp + bj * HALF) = w; } }
    }
};
__device__ __forceinline__ float dpp_ror1(float v) { return __builtin_bit_cast(float, __builtin_amdgcn_mov_dpp(__builtin_bit_cast(int, v), 0x121, 0xf, 0xf, true)); }
__device__ __forceinline__ float dpp_ror2(float v) { return __builtin_bit_cast(float, __builtin_amdgcn_mov_dpp(__builtin_bit_cast(int, v), 0x122, 0xf, 0xf, true)); }
struct EpiConvGate {
    static constexpr bool PERM = true, AFTER_DRAIN = false, ACC_INIT = false;
    static constexpr int TPS = 17, TSTRIDE = 241, SEQL = 4096, FF = 5632;
    static __host__ __device__ __forceinline__ int a_row0(int pm) { return (pm / TPS) * SEQL + (pm % TPS) * TSTRIDE - 2; }
    static __host__ __device__ __forceinline__ int b_row0(int pn) { return pn * BM; }
    bf16_t* G; const float* cw; const float* cb; PG8_LAS float* tails; const float* ssq;
    __device__ __forceinline__ void operator()(const f32x4 (&acc)[2][2][4][2], const Unit& u, int wr, int wc, int fr, int fq, int ui) const {
        const int wid = wr * 4 + wc, seq = u.pm / TPS, tbase = (u.pm % TPS) * TSTRIDE - 2;
        const int ch0 = 128 * u.pn + 32 * wc + 8 * fq;
        if (fr >= 14) {
#pragma unroll
            for (int ai = 0; ai < 2; ++ai)
#pragma unroll
                for (int bj = 0; bj < 2; ++bj)
#pragma unroll
                    for (int n = 0; n < 2; ++n) *(PG8_LAS f32x4*)(tails + (((wid * 2 + ai) * 2 + (fr - 14)) * 2 + bj) * 32 + fq * 8 + n * 4) = acc[ai][bj][3][n];
        }
        const PG8_LAS float* rsl = tails + 2048 + 256 * ui;
        PG8_LAS float* coef = tails + 2048 + 12 * 256;
        { const int tid_ = threadIdx.x; if (tid_ < 256) { const int a_ = tid_ >> 5, c_ = tid_ & 31;
            const float* src = (a_ < 6 ? cw + (a_ >> 1) * 2 * FF : cb) + (a_ & 1) * FF + 128 * u.pn + 4 * c_;
            *(PG8_LAS f32x4*)(coef + a_ * 128 + 4 * c_) = *(const f32x4*)src; } }
        asm volatile("s_waitcnt lgkmcnt(0)" ::: "memory"); __builtin_amdgcn_s_barrier(); asm volatile("" ::: "memory");
        const bool is15 = (fr == 15), ge14 = (fr >= 14);
#pragma unroll
        for (int ai = 0; ai < 2; ++ai) {
            const bool has_src = !(ai == 0 && wr == 0);
            const int swid = (wr ^ 1) * 4 + wc, sai = (wr == 1) ? ai : ai - 1;
#pragma unroll
            for (int n = 0; n < 2; ++n) {
                f32x4 gv[4];
#pragma unroll
                for (int bj = 0; bj < 2; ++bj) {
                    const PG8_LAS float* cfp = coef + bj * 128 + 32 * wc + 8 * fq + 4 * n;
                    const f32x4 w0 = *(const PG8_LAS f32x4*)cfp, w1 = *(const PG8_LAS f32x4*)(cfp + 256), w2 = *(const PG8_LAS f32x4*)(cfp + 512), bb = *(const PG8_LAS f32x4*)(cfp + 768);
                    f32x4 prev = (f32x4){0.f, 0.f, 0.f, 0.f};
                    if (ge14 && has_src) { prev = *(const PG8_LAS f32x4*)(tails + (((swid * 2 + sai) * 2 + (fr - 14)) * 2 + bj) * 32 + fq * 8 + n * 4);
                        if (ssq) prev = prev * rsl[128 * ai + 64 * wr - 16 + fr]; }
#pragma unroll
                    for (int m = 0; m < 4; ++m) {
                        f32x4 cur = acc[ai][bj][m][n]; if (ssq) cur = cur * rsl[128 * ai + 64 * wr + 16 * m + fr];
                        const int t = tbase + 128 * ai + 64 * wr + 16 * m + fr;
                        f32x4 cv;
#pragma unroll
                        for (int e = 0; e < 4; ++e) {
                            float p1 = dpp_ror1(is15 ? prev[e] : cur[e]), p2 = dpp_ror2(ge14 ? prev[e] : cur[e]);
                            if (ai == 0 && m == 0) { p1 = (t >= 1) ? p1 : 0.f; p2 = (t >= 2) ? p2 : 0.f; }
                            cv[e] = bb[e] + w0[e] * p2 + w1[e] * p1 + w2[e] * cur[e]; }
                        if (bj == 0) {
#pragma unroll
                            for (int e = 0; e < 4; ++e) gv[m][e] = cv[e] * __builtin_amdgcn_rcpf(1.f + __expf(-cv[e]));
                        } else { const f32x4 o = gv[m] * cv; const int rl = 128 * ai + 64 * wr + 16 * m + fr;
                            if (rl >= 2 && rl < 2 + TSTRIDE && t < SEQL) { typedef unsigned u32x2 __attribute__((ext_vector_type(2))); u32x2 w; w.x = cvt_pk_bf16(o[0], o[1]); w.y = cvt_pk_bf16(o[2], o[3]);
                                *(u32x2*)(G + (size_t)(seq * SEQL + t) * FF + ch0 + 4 * n) = w; } }
                        prev = cur;
                    }
                }
            }
        }
    }
};
struct EpiConvGateT {
    static constexpr bool PERM = true, AFTER_DRAIN = false, ACC_INIT = false;
    static constexpr int TPS = 17, TSTRIDE = 241, SEQL = 4096, FF = 5632;
    static __host__ __device__ __forceinline__ int a_row0(int pm) { return pm * BM; }
    static __host__ __device__ __forceinline__ int b_row0(int pn) { return (pn / TPS) * SEQL + (pn % TPS) * TSTRIDE - 2; }
    bf16_t* G; const float* cw; const float* cb; PG8_LAS float* xl;
    __device__ __forceinline__ void operator()(f32x4 (&acc)[2][2][4][2], const Unit& u, int wr, int wc, int fr, int fq, int ui) const {
        const int wid = wr * 4 + wc, lane = fq * 16 + fr, seq = u.pn / TPS, tbase = (u.pn % TPS) * TSTRIDE - 2;
        PG8_LAS unsigned* tails = (PG8_LAS unsigned*)xl; PG8_LAS unsigned short* ob = (PG8_LAS unsigned short*)(xl + 2048) + wid * 512; PG8_LAS float* coef = xl + 4096; const PG8_LAS float* rsl = xl + 5120 + 256 * ui;
        f32x4 cfv = {0.f, 0.f, 0.f, 0.f}; const int tid_ = threadIdx.x, a_ = (tid_ >> 5) & 7, c_ = tid_ & 31;
        if (tid_ < 256) { const int up_ = a_ >> 2, j_ = a_ & 3; cfv = *(const f32x4*)((j_ < 3 ? cw + j_ * 2 * FF : cb) + up_ * FF + 128 * u.pm + 4 * c_); }
#pragma unroll
        for (int bj = 0; bj < 2; ++bj) { const f32x4 r0 = *(const PG8_LAS f32x4*)(rsl + 128 * bj + 32 * wc + 8 * fq), r1 = *(const PG8_LAS f32x4*)(rsl + 128 * bj + 32 * wc + 8 * fq + 4);
#pragma unroll
            for (int ai = 0; ai < 2; ++ai)
#pragma unroll
                for (int m = 0; m < 4; ++m) { acc[ai][bj][m][0] = acc[ai][bj][m][0] * r0; acc[ai][bj][m][1] = acc[ai][bj][m][1] * r1; } }
        if (fq == 3) {
#pragma unroll
            for (int bj = 0; bj < 2; ++bj)
#pragma unroll
                for (int ai = 0; ai < 2; ++ai)
#pragma unroll
                    for (int m = 0; m < 4; ++m) tails[((wid * 2 + bj) * 8 + ai * 4 + m) * 16 + fr] = cvt_pk_bf16(acc[ai][bj][m][1][2], acc[ai][bj][m][1][3]);
        }
        if (tid_ < 256) *(PG8_LAS f32x4*)(coef + a_ * 128 + 4 * c_) = cfv;
        asm volatile("s_waitcnt lgkmcnt(0)" ::: "memory"); __builtin_amdgcn_s_barrier(); asm volatile("" ::: "memory");
#pragma unroll
        for (int bj = 0; bj < 2; ++bj) {
            const bool has_src = (wc > 0) || (bj == 1);
            const int swid = (wc > 0) ? wid - 1 : wr * 4 + 3, sbj = (wc > 0) ? bj : 0;
            const bool firstgrp = (tbase < 0) && (bj == 0) && (wc == 0) && (fq == 0);
#pragma unroll
            for (int mp = 0; mp < 2; ++mp) {
                unsigned pk[2][2][2];
#pragma unroll
                for (int mq = 0; mq < 2; ++mq) { const int m = 2 * mp + mq;
                    float cv[2][8];
#pragma unroll
                    for (int ai = 0; ai < 2; ++ai) {
                        float sq[8];
#pragma unroll
                        for (int j = 0; j < 8; ++j) sq[j] = acc[ai][bj][m][j >> 2][j & 3];
                        float p6 = __shfl_up(sq[6], 16), p7 = __shfl_up(sq[7], 16);
                        if (fq == 0) { unsigned tv = 0u; if (has_src) tv = tails[((swid * 2 + sbj) * 8 + ai * 4 + m) * 16 + fr];
                            p6 = __builtin_bit_cast(float, tv << 16); p7 = __builtin_bit_cast(float, tv & 0xffff0000u); }
                        if (firstgrp) { sq[0] = 0.f; sq[1] = 0.f; }
                        const PG8_LAS float* cf = coef + ai * 512 + 64 * wr + 16 * m + fr; const float w0 = cf[0], w1 = cf[128], w2 = cf[256], bb = cf[384];
                        cv[ai][0] = bb + w0 * p6 + w1 * p7 + w2 * sq[0];
                        cv[ai][1] = bb + w0 * p7 + w1 * sq[0] + w2 * sq[1];
#pragma unroll
                        for (int j = 2; j < 8; ++j) cv[ai][j] = bb + w0 * sq[j - 2] + w1 * sq[j - 1] + w2 * sq[j];
                    }
                    float o[8];
#pragma unroll
                    for (int j = 0; j < 8; ++j) o[j] = cv[0][j] * __builtin_amdgcn_rcpf(1.f + __expf(-cv[0][j])) * cv[1][j];
#pragma unroll
                    for (int n = 0; n < 2; ++n) { pk[mq][n][0] = cvt_pk_bf16(o[4 * n], o[4 * n + 1]); pk[mq][n][1] = cvt_pk_bf16(o[4 * n + 2], o[4 * n + 3]); }
                }
#pragma unroll
                for (int n = 0; n < 2; ++n) {
#pragma unroll
                    for (int mq = 0; mq < 2; ++mq) {
                        ob[(4 * fq + 0) * 32 + 16 * mq + fr] = (unsigned short)(pk[mq][n][0] & 0xffffu); ob[(4 * fq + 1) * 32 + 16 * mq + fr] = (unsigned short)(pk[mq][n][0] >> 16);
                        ob[(4 * fq + 2) * 32 + 16 * mq + fr] = (unsigned short)(pk[mq][n][1] & 0xffffu); ob[(4 * fq + 3) * 32 + 16 * mq + fr] = (unsigned short)(pk[mq][n][1] >> 16); }
                    asm volatile("s_waitcnt lgkmcnt(0)" ::: "memory");
                    { const int trow = lane >> 2, chunk = lane & 3; const u32x4 v = *(const PG8_LAS u32x4*)(ob + trow * 32 + chunk * 8);
                      const int tl = 128 * bj + 32 * wc + 8 * (trow >> 2) + 4 * n + (trow & 3), t = tbase + tl;
                      asm volatile("s_waitcnt lgkmcnt(0)" ::: "memory");
                      if (tl >= 2 && tl < 2 + TSTRIDE && t < SEQL) *(u32x4*)(G + (size_t)(seq * SEQL + t) * FF + 128 * u.pm + 64 * wr + 32 * mp + 8 * chunk) = v; }
                }
            }
        }
    }
};
template <class Epi, class Sched, bool ALIGN_EPI = false, bool SP2 = false>
__device__ __forceinline__ void gemm_phase(PG8_LAS unsigned char* lds, const Gemm g, const Sched& S, const Epi& E) {
    const int tid = threadIdx.x, wid = __builtin_amdgcn_readfirstlane(tid >> 6), lane = tid & 63, wr = wid >> 2, wc = wid & 3, fr = lane & 15, fq = lane >> 4;
    const int K = g.K, nt = K / BK;
    unsigned voffA[2], voffB[2];
#pragma unroll
    for (int i = 0; i < 2; ++i) { int R, C; stage_rc(tid * 16 + i * 8192, R, C); const int Rb = Epi::PERM ? ((R & ~31) + perm32(R & 31)) : R;
        voffA[i] = (unsigned)(R * K + C) * 2u; voffB[i] = (unsigned)(Rb * K + C) * 2u; }
    const size_t kstep = (size_t)(BK * 2);
    const size_t hstep = (size_t)HALF * K * 2;
    const size_t tstep = 2 * hstep;
    const unsigned ldsw = (unsigned)wid * 1024u;
    const int aoff = lds_byte(wr * 64 + fr, fq * 8), boff = lds_byte(wc * 32 + fr, fq * 8);
#define PG8_SA(b, h) (((b) * 2 + (h)) * HTB)
#define PG8_SB(b, h) ((4 + (b) * 2 + (h)) * HTB)
#define PG8_STAGE(bufoff, gbase, voff) do { _Pragma("unroll") for (int _i = 0; _i < 2; ++_i) \
        __builtin_amdgcn_global_load_lds((const unsigned*)((const char*)(gbase) + (voff)[_i]), (PG8_LAS unsigned*)(lds + (bufoff) + ldsw + _i * 8192), 16, 0, 0); } while (0)
#define PG8_LDA(dst, b, h) do { _Pragma("unroll") for (int m = 0; m < 4; ++m) _Pragma("unroll") for (int k = 0; k < 2; ++k) dst[m][k] = *(const PG8_LAS bf16x8*)(lds + PG8_SA(b, h) + aoff + m * 2048 + k * 1024); } while (0)
#define PG8_LDB(dst, b, h) do { _Pragma("unroll") for (int n = 0; n < 2; ++n) _Pragma("unroll") for (int k = 0; k < 2; ++k) dst[n][k] = *(const PG8_LAS bf16x8*)(lds + PG8_SB(b, h) + boff + n * 2048 + k * 1024); } while (0)
#define PG8_MMA(ai, bj, At, Bt) do { __builtin_amdgcn_s_setprio(1); _Pragma("unroll") for (int m = 0; m < 4; ++m) _Pragma("unroll") for (int n = 0; n < 2; ++n) _Pragma("unroll") for (int k = 0; k < 2; ++k) \
        acc[ai][bj][m][n] = __builtin_amdgcn_mfma_f32_16x16x32_bf16(Bt[n][k], At[m][k], acc[ai][bj][m][n], 0, 0, 0); __builtin_amdgcn_s_setprio(0); } while (0)
#define PG8_WAIT_V(n) asm volatile("s_waitcnt vmcnt(" #n ")" ::: "memory")
#define PG8_WAIT_L(n) asm volatile("s_waitcnt lgkmcnt(" #n ")" ::: "memory")
#define PG8_BAR __builtin_amdgcn_s_barrier()
#define PG8_SCHED __builtin_amdgcn_sched_barrier(0)
    Unit cur, nxt; int ui = 0;
    if (!S.next(0, cur)) return;
    f32x4 acc[2][2][4][2];
    if constexpr (Epi::ACC_INIT) E.init(acc, cur, wr, wc, fr, fq); else {
#pragma unroll
    for (int a = 0; a < 2; ++a)
#pragma unroll
        for (int b = 0; b < 2; ++b)
#pragma unroll
            for (int m = 0; m < 4; ++m)
#pragma unroll
                for (int n = 0; n < 2; ++n) acc[a][b][m][n] = (f32x4){0.f, 0.f, 0.f, 0.f}; }
    bf16x8 At[4][2], B0[2][2], B1[2][2];
    const char* cA = (const char*)g.A + (long)Epi::a_row0(cur.pm) * (long)(K * 2); const char* cB = (const char*)g.Bt + (long)Epi::b_row0(cur.pn) * (long)(K * 2);
    S.a_ready(cur);
    if constexpr (SP2) {
        PG8_STAGE(PG8_SB(0, 0), cB, voffB); PG8_STAGE(PG8_SB(0, 1), cB + hstep, voffB); PG8_STAGE(PG8_SA(0, 0), cA, voffA); PG8_STAGE(PG8_SA(0, 1), cA + hstep, voffA);
        if (wr == 1) PG8_BAR;
        PG8_WAIT_V(2); PG8_BAR;
        PG8_STAGE(PG8_SB(1, 0), cB + kstep, voffB); PG8_STAGE(PG8_SA(1, 0), cA + kstep, voffA); PG8_STAGE(PG8_SB(1, 1), cB + hstep + kstep, voffB);
        PG8_WAIT_V(6); PG8_BAR;
    } else {
        PG8_STAGE(PG8_SB(0, 0), cB, voffB); PG8_STAGE(PG8_SA(0, 0), cA, voffA); PG8_STAGE(PG8_SB(0, 1), cB + hstep, voffB); PG8_STAGE(PG8_SA(0, 1), cA + hstep, voffA);
        if (wr == 1) PG8_BAR;
        PG8_WAIT_V(4); PG8_BAR;
        PG8_STAGE(PG8_SB(1, 0), cB + kstep, voffB); PG8_STAGE(PG8_SA(1, 0), cA + kstep, voffA); PG8_STAGE(PG8_SB(1, 1), cB + hstep + kstep, voffB);
        PG8_WAIT_V(6); PG8_BAR;
    }
    for (;;) {
        const bool has_next = S.next(ui + 1, nxt);
        const char* nA = has_next ? (const char*)g.A + (long)Epi::a_row0(nxt.pm) * (long)(K * 2) : cA; const char* nB = has_next ? (const char*)g.Bt + (long)Epi::b_row0(nxt.pn) * (long)(K * 2) : cB;
        for (int t = 0; t < nt; t += 2) {
            const bool last = (t == nt - 2);
            const char* a1 = cA + (size_t)(t + 1) * kstep;
            const char* a2 = last ? nA : cA + (size_t)(t + 2) * kstep; const char* b2 = last ? nB : cB + (size_t)(t + 2) * kstep;
            const char* a3 = a2 + kstep; const char* b3 = b2 + kstep;
            if (last && has_next) S.a_ready(nxt);
            if constexpr (SP2) {
            PG8_LDB(B0, 0, 0); PG8_LDB(B1, 0, 1); PG8_SCHED; PG8_LDA(At, 0, 0); PG8_STAGE(PG8_SA(1, 1), a1 + hstep, voffA);
            PG8_WAIT_V(8); PG8_WAIT_L(0); PG8_BAR; PG8_MMA(0, 0, At, B0); PG8_MMA(0, 1, At, B1); PG8_BAR; PG8_SCHED;
            PG8_LDA(At, 0, 1); PG8_STAGE(PG8_SB(0, 0), b2, voffB); PG8_STAGE(PG8_SB(0, 1), b2 + hstep, voffB); PG8_STAGE(PG8_SA(0, 0), a2, voffA);
            PG8_WAIT_V(8); PG8_WAIT_L(0); PG8_BAR; PG8_MMA(1, 0, At, B0); PG8_MMA(1, 1, At, B1); PG8_BAR; PG8_SCHED;
            PG8_LDB(B0, 1, 0); PG8_LDB(B1, 1, 1); PG8_SCHED; PG8_LDA(At, 1, 0); PG8_STAGE(PG8_SA(0, 1), a2 + hstep, voffA);
            PG8_WAIT_V(8); PG8_WAIT_L(0); PG8_BAR; PG8_MMA(0, 0, At, B0); PG8_MMA(0, 1, At, B1); PG8_BAR; PG8_SCHED;
            PG8_LDA(At, 1, 1); PG8_STAGE(PG8_SB(1, 0), b3, voffB); PG8_STAGE(PG8_SB(1, 1), b3 + hstep, voffB); PG8_STAGE(PG8_SA(1, 0), a3, voffA);
            PG8_WAIT_V(8); PG8_WAIT_L(0); PG8_BAR; PG8_MMA(1, 0, At, B0); PG8_MMA(1, 1, At, B1); PG8_BAR; PG8_SCHED;
            } else {
            PG8_LDB(B0, 0, 0); PG8_SCHED; PG8_LDA(At, 0, 0); PG8_STAGE(PG8_SA(1, 1), a1 + hstep, voffA);
            PG8_WAIT_L(8); PG8_BAR; PG8_WAIT_L(0); PG8_MMA(0, 0, At, B0); PG8_BAR; PG8_SCHED;
            PG8_LDB(B1, 0, 1); PG8_STAGE(PG8_SB(0, 0), b2, voffB);
            PG8_BAR; PG8_WAIT_L(0); PG8_MMA(0, 1, At, B1); PG8_BAR;
            PG8_LDA(At, 0, 1); PG8_STAGE(PG8_SA(0, 0), a2, voffA);
            PG8_BAR; PG8_WAIT_L(0); PG8_MMA(1, 0, At, B0); PG8_BAR; PG8_SCHED;
            PG8_STAGE(PG8_SB(0, 1), b2 + hstep, voffB);
            PG8_WAIT_V(6); PG8_BAR; PG8_MMA(1, 1, At, B1); PG8_BAR;
            PG8_LDB(B0, 1, 0); PG8_SCHED; PG8_LDA(At, 1, 0); PG8_STAGE(PG8_SA(0, 1), a2 + hstep, voffA);
            PG8_WAIT_L(8); PG8_BAR; PG8_WAIT_L(0); PG8_MMA(0, 0, At, B0); PG8_BAR; PG8_SCHED;
            PG8_LDB(B1, 1, 1); PG8_STAGE(PG8_SB(1, 0), b3, voffB);
            PG8_BAR; PG8_WAIT_L(0); PG8_MMA(0, 1, At, B1); PG8_BAR;
            PG8_LDA(At, 1, 1); PG8_STAGE(PG8_SA(1, 0), a3, voffA);
            PG8_BAR; PG8_WAIT_L(0); PG8_MMA(1, 0, At, B0); PG8_BAR; PG8_SCHED;
            PG8_STAGE(PG8_SB(1, 1), b3 + hstep, voffB);
            PG8_WAIT_V(6); PG8_BAR; PG8_MMA(1, 1, At, B1); PG8_BAR;
            }
        }
        if constexpr (ALIGN_EPI) { if (wr == 0) PG8_BAR; }
        if constexpr (!Epi::AFTER_DRAIN) { E(acc, cur, wr, wc, fr, fq, ui); S.done(cur); }
        if (!has_next) break;
        if constexpr (Epi::ACC_INIT) E.init(acc, nxt, wr, wc, fr, fq); else {
#pragma unroll
        for (int a = 0; a < 2; ++a)
#pragma unroll
            for (int b = 0; b < 2; ++b)
#pragma unroll
                for (int m = 0; m < 4; ++m)
#pragma unroll
                    for (int n = 0; n < 2; ++n) acc[a][b][m][n] = (f32x4){0.f, 0.f, 0.f, 0.f}; }
        cur = nxt; cA = nA; cB = nB; ++ui;
        if constexpr (ALIGN_EPI) { if (wr == 1) PG8_BAR; }
    }
    PG8_WAIT_V(0);
    if constexpr (!ALIGN_EPI) { if (wr == 0) PG8_BAR; }
    PG8_BAR;
    if constexpr (Epi::AFTER_DRAIN) { E.fused(acc, cur, wr, wc, fr, fq, lds, wid, lane); S.done(cur); }
#undef PG8_SA
#undef PG8_SB
#undef PG8_STAGE
#undef PG8_LDA
#undef PG8_LDB
#undef PG8_MMA
#undef PG8_WAIT_V
#undef PG8_WAIT_L
#undef PG8_BAR
#undef PG8_SCHED
}
}

constexpr int BATCH = 2, SEQ = 4096, DM = 2048, MROWS = BATCH * SEQ;
constexpr int AH = 16, AHD = 128, NQKV = 3 * DM;
constexpr int LH = 4, LDV = 512, LDK = 256, QKW = 1024, INW = 6152, INW_MAIN = 6144;
constexpr int FFN = 5632, FFN2 = 2 * FFN;
constexpr float NORM_EPS = 1e-6f;

typedef unsigned short bf16;
typedef unsigned v4u __attribute__((ext_vector_type(4)));
typedef unsigned v2u __attribute__((ext_vector_type(2)));
typedef float f32x4 __attribute__((ext_vector_type(4)));
typedef float f32x2 __attribute__((ext_vector_type(2)));
#define LAS __attribute__((address_space(3)))

__device__ __forceinline__ unsigned f2bf(float f) { unsigned u = __builtin_bit_cast(unsigned, f); return (u + 0x7fffu + ((u >> 16) & 1u)) >> 16; }
__device__ __forceinline__ unsigned pk2(float lo, float hi) { unsigned r; asm("v_cvt_pk_bf16_f32 %0, %1, %2" : "=v"(r) : "v"(lo), "v"(hi)); return r; }
template <int N> __device__ __forceinline__ float dpp_ror(float v) { return __builtin_bit_cast(float, __builtin_amdgcn_mov_dpp(__builtin_bit_cast(int, v), 0x120 + N, 0xf, 0xf, true)); }
__device__ __forceinline__ float row16_sum(float v) { v += dpp_ror<1>(v); v += dpp_ror<2>(v); v += dpp_ror<4>(v); v += dpp_ror<8>(v); return v; }
__device__ __forceinline__ float bf2f(unsigned short b) { return __builtin_bit_cast(float, (unsigned)b << 16); }
__device__ __forceinline__ float bflo(unsigned w) { return __builtin_bit_cast(float, w << 16); }
__device__ __forceinline__ float bfhi(unsigned w) { return __builtin_bit_cast(float, w & 0xffff0000u); }
__device__ __forceinline__ float wave_sum(float v) {
#pragma unroll
    for (int o = 1; o < 64; o <<= 1) v += __shfl_xor(v, o);
    return v;
}
__device__ __forceinline__ float sigmoidf_(float x) { return __builtin_amdgcn_rcpf(1.f + __expf(-x)); }
__device__ __forceinline__ float siluf_(float x) { return x * __builtin_amdgcn_rcpf(1.f + __expf(-x)); }

constexpr size_t MiB = 1u << 20;
constexpr size_t WS_CTL = 0;
constexpr size_t WS_WQKV = 1 * MiB;
constexpr size_t WS_WO   = WS_WQKV + (size_t)NQKV * DM * 2;
constexpr size_t WS_WIN  = WS_WO + (size_t)DM * DM * 2;
constexpr size_t WS_WOUT = WS_WIN + (size_t)INW_MAIN * DM * 2;
constexpr size_t WS_WUP  = WS_WOUT + (size_t)DM * DM * 2;
constexpr size_t WS_WDN  = WS_WUP + 2 * (size_t)FFN2 * DM * 2;
constexpr size_t WS_HN   = WS_WDN + 2 * (size_t)DM * FFN * 2;
constexpr size_t WS_G    = WS_HN + (size_t)MROWS * DM * 2;
constexpr size_t WS_R    = WS_G + (size_t)MROWS * FFN * 2;
constexpr size_t WS_QKV  = WS_R;
constexpr size_t WS_O    = WS_QKV + (size_t)MROWS * NQKV * 2;
constexpr size_t WS_QKC  = WS_O + (size_t)MROWS * DM * 2;
constexpr size_t WS_HS   = WS_QKC + (size_t)MROWS * DM * 2;
constexpr size_t WS_U    = WS_R;
constexpr size_t WS_REND = WS_HS + (size_t)MROWS * DM * 4;
static_assert(WS_U + (size_t)MROWS * FFN2 * 2 <= WS_REND, "U overlay");
constexpr size_t WS_GATES = WS_REND;
constexpr size_t WS_SU   = WS_GATES + (size_t)MROWS * 8 * 4;
constexpr size_t WS_SM   = WS_SU + 8 * SEQ * 4;
constexpr size_t WS_SE   = WS_SM + 8 * SEQ * 4;
constexpr size_t WS_NST  = WS_SE + 8 * SEQ * 4;
constexpr size_t WS_CST  = WS_NST + 8 * 64 * 256 * 4;
constexpr size_t WS_SSQ  = WS_CST + (size_t)8 * 64 * 17 * 16384;
constexpr size_t WS_GWT  = WS_SSQ + (size_t)MROWS * 32 * 4;
constexpr size_t WS_XR   = WS_HS;
constexpr size_t WS_END  = WS_GWT + (size_t)DM * 8 * 4;
static_assert(WS_END <= 738000000, "workspace");

__device__ __forceinline__ void transpose_load(const float* W, int ldn, int nblk, int item, int lane, f32x4 (&v)[8]) {
    const int kb = item / nblk, nb = item % nblk, k0 = 64 * kb, n0 = 32 * nb;
#pragma unroll
    for (int i = 0; i < 8; ++i) v[i] = *(const f32x4*)(W + (size_t)(k0 + 8 * i + (lane >> 3)) * ldn + n0 + 4 * (lane & 7));
}
__device__ __forceinline__ void transpose_store(const f32x4 (&v)[8], int K, int nblk, bf16* WT, LAS float* scr, int item, int lane, bool gate_perm, const LAS float* kgain) {
    const int kb = item / nblk, nb = item % nblk, k0 = 64 * kb, n0 = 32 * nb;
    const int r0 = !gate_perm ? n0 : (n0 < FFN ? (n0 / 128) * 256 + (n0 % 128) : ((n0 - FFN) / 128) * 256 + 128 + ((n0 - FFN) % 128));
#pragma unroll
    for (int i = 0; i < 8; ++i) { LAS float* d = scr + (8 * i + (lane >> 3)) * 33 + 4 * (lane & 7); d[0] = v[i][0]; d[1] = v[i][1]; d[2] = v[i][2]; d[3] = v[i][3]; }
    asm volatile("s_waitcnt lgkmcnt(0)" ::: "memory");
    const int c = lane & 7;
    f32x4 ga = (f32x4){1.f, 1.f, 1.f, 1.f}, gb = ga;
    if (kgain) { ga = *(const LAS f32x4*)(kgain + k0 + 8 * c); gb = *(const LAS f32x4*)(kgain + k0 + 8 * c + 4); }
#pragma unroll
    for (int j = 0; j < 4; ++j) { const int n = (lane >> 3) + 8 * j; const LAS float* s = scr + (8 * c) * 33 + n;
        v4u o; o.x = pk2(s[0 * 33] * ga[0], s[1 * 33] * ga[1]); o.y = pk2(s[2 * 33] * ga[2], s[3 * 33] * ga[3]); o.z = pk2(s[4 * 33] * gb[0], s[5 * 33] * gb[1]); o.w = pk2(s[6 * 33] * gb[2], s[7 * 33] * gb[3]);
        *(v4u*)(WT + (size_t)(r0 + n) * K + k0 + 8 * c) = o; }
    asm volatile("s_waitcnt lgkmcnt(0)" ::: "memory");
}

#define XB_TMO      128
#define XB_XCNT(j)  (256  + 64 * (j))
#define XB_XSUB(j)  (1280 + 64 * (j))
#define XB_XGEN(j)  (2304 + 64 * (j))
#define XB_TOP      3328
#define XB_TOPGEN   3392
#define XCD_BAR_WORDS 3456
#define XB_SPIN_CAP (1u << 18)

__device__ __forceinline__ unsigned xb_ld(unsigned* p)              { return __hip_atomic_load(p, __ATOMIC_RELAXED, __HIP_MEMORY_SCOPE_AGENT); }
__device__ __forceinline__ unsigned xb_add(unsigned* p, unsigned v) { return __hip_atomic_fetch_add(p, v, __ATOMIC_RELAXED, __HIP_MEMORY_SCOPE_AGENT); }
__device__ __forceinline__ unsigned xb_xcc_id() { return (unsigned)__builtin_amdgcn_s_getreg((3 << 11) | 20) & 0xFu; }
#define XB_SPIN(cond, bar) do { unsigned _sp = 0; while (cond) { __builtin_amdgcn_s_sleep(1); \
    if ((++_sp & 255u) == 0u) { if (xb_ld(&(bar)[XB_TMO])) break; if (_sp > XB_SPIN_CAP) { atomicAdd(&(bar)[XB_TMO], 1u); break; } } } } while (0)

struct XcdBarrier {
    unsigned* bar; unsigned x;
    volatile LAS unsigned* st;
};

__device__ __forceinline__ XcdBarrier xcd_barrier_post(unsigned* bar, volatile LAS unsigned* st) {
    XcdBarrier b; b.bar = bar; b.x = xb_xcc_id(); b.st = st;
    if (threadIdx.x == 0) (void)xb_add(&bar[XB_XCNT(b.x)], 1u);
    return b;
}
__device__ __forceinline__ void xcd_barrier_complete(unsigned* bar, unsigned x, unsigned& nloc, unsigned& nx) {
    const unsigned G = gridDim.x * gridDim.y * gridDim.z;
    unsigned sum, cnt, mine, sp = 0u;
    for (;;) {
        sum = 0u; cnt = 0u; mine = 0u;
#pragma unroll
        for (unsigned j = 0; j < 16; ++j) { const unsigned c = xb_ld(&bar[XB_XCNT(j)]); sum += c; cnt += (c > 0u) ? 1u : 0u; mine = (j == x) ? c : mine; }
        if (sum == G) break;
        __builtin_amdgcn_s_sleep(1);
        if ((++sp & 255u) == 0u) { if (xb_ld(&bar[XB_TMO])) break; if (sp > XB_SPIN_CAP) { atomicAdd(&bar[XB_TMO], 1u); break; } }
    }
    nloc = mine > 0u ? mine : 1u; nx = cnt > 0u ? cnt : 1u;
}

__device__ __forceinline__ void xcd_barrier(const XcdBarrier& b) {
    asm volatile("s_waitcnt vmcnt(0)" ::: "memory");
    __syncthreads();
    if (threadIdx.x == 0) {
        unsigned* bar = b.bar;
        __builtin_amdgcn_s_waitcnt(0);
        unsigned nloc = b.st[0], nx = b.st[1];
        if (nloc == 0u) { xcd_barrier_complete(bar, b.x, nloc, nx); b.st[0] = nloc; b.st[1] = nx; }
        const unsigned old = xb_add(&bar[XB_XSUB(b.x)], 1u);
        const unsigned gen = old / nloc;
        if (old + 1u == (gen + 1u) * nloc) {
            __builtin_amdgcn_fence(__ATOMIC_RELEASE, "agent");
            asm volatile("s_waitcnt vmcnt(0)" ::: "memory");
            const unsigned og = xb_add(&bar[XB_TOP], 1u);
            const unsigned tg = og / nx;
            if (og + 1u == (tg + 1u) * nx) xb_add(&bar[XB_TOPGEN], 1u);
            else XB_SPIN(xb_ld(&bar[XB_TOPGEN]) == tg, bar);
            __builtin_amdgcn_fence(__ATOMIC_ACQUIRE, "agent");
            xb_add(&bar[XB_XGEN(b.x)], 1u);
            asm volatile("s_waitcnt vmcnt(0)" ::: "memory");
        } else {
            XB_SPIN(xb_ld(&bar[XB_XGEN(b.x)]) == gen, bar);
            __builtin_amdgcn_fence(__ATOMIC_ACQUIRE, "agent");
            asm volatile("s_waitcnt vmcnt(0)" ::: "memory");
        }
    }
    __syncthreads();
}


#define XB_XSUB2(j) (3456 + 64 * (j))
#define XB_TOP2     4480
#define XB_SET3     1152
__device__ __forceinline__ void xcd_arrive2(const XcdBarrier& b, const unsigned wofs = 0u) {
    asm volatile("s_waitcnt vmcnt(0)" ::: "memory");
    __syncthreads();
    if (threadIdx.x == 0) {
        unsigned* bar = b.bar;
        __builtin_amdgcn_s_waitcnt(0);
        unsigned nloc = b.st[0], nx = b.st[1];
        if (nloc == 0u) { xcd_barrier_complete(bar, b.x, nloc, nx); b.st[0] = nloc; b.st[1] = nx; }
        const unsigned old = xb_add(&bar[wofs + XB_XSUB2(b.x)], 1u);
        if (old + 1u == nloc) {
            __builtin_amdgcn_fence(__ATOMIC_RELEASE, "agent");
            asm volatile("s_waitcnt vmcnt(0)" ::: "memory");
            (void)xb_add(&bar[wofs + XB_TOP2], 1u); }
    }
}
__device__ __forceinline__ void xcd_wait2(const XcdBarrier& b, const unsigned wofs = 0u) {
    asm volatile("s_waitcnt vmcnt(0)" ::: "memory");
    __syncthreads();
    if (threadIdx.x == 0) {
        unsigned* bar = b.bar; const unsigned nx = b.st[1];
        XB_SPIN(xb_ld(&bar[wofs + XB_TOP2]) < nx, bar);
        __builtin_amdgcn_fence(__ATOMIC_ACQUIRE, "agent");
        asm volatile("s_waitcnt vmcnt(0)" ::: "memory");
    }
    __syncthreads();
}

constexpr int NWAVES = 8, NTHREADS = 512;
constexpr int RING_BYTES = 131072;
constexpr int MISC_OFF = 163840 - 256;
constexpr int LDS_BYTES = 163840;
constexpr int CW_BAR = 4096;
constexpr size_t CTL_ZERO_BYTES = 64 * 1024;

struct Args { const float* in[18]; float* out; unsigned char* ws; int ph_lo, ph_hi; };

struct Frame {
    LAS unsigned char* lds; int tid, lane, wave, vcu, G;
};

template <int DEPTH = 1> __device__ __forceinline__ void p_convert(const Frame& F, const float* W, bf16* WT, int K, int ldn, int N, bool gate_perm = false, int rank0 = 0, int nranks = 0, const float* kgain = nullptr) {
    LAS float* scr = (LAS float*)(F.lds + F.wave * 16384);
    if (nranks == 0) nranks = F.G;
    if (F.vcu < rank0 || F.vcu >= rank0 + nranks) return;
    const int gw = (F.vcu - rank0) * NWAVES + F.wave, NGW = nranks * NWAVES;
    const int nblk = N / 32, items = (K / 64) * nblk;
    const LAS float* kgl = nullptr;
    if (kgain) { LAS float* gl = (LAS float*)(F.lds + NWAVES * 16384); __syncthreads();
        for (int i = F.tid; i < K / 4; i += NTHREADS) *(LAS f32x4*)(gl + 4 * i) = *(const f32x4*)(kgain + 4 * i);
        __syncthreads(); kgl = gl; }
    if constexpr (DEPTH == 1) {
    f32x4 cur[8], nxt[8];
    if (gw < items) transpose_load(W, ldn, nblk, gw, F.lane, nxt);
    for (int it = gw; it < items; it += NGW) {
#pragma unroll
        for (int i = 0; i < 8; ++i) cur[i] = nxt[i];
        if (it + NGW < items) transpose_load(W, ldn, nblk, it + NGW, F.lane, nxt);
        transpose_store(cur, K, nblk, WT, scr, it, F.lane, gate_perm, kgl);
    }
    } else {
    f32x4 cur[8], n1[8], n2[8];
    if (gw < items) transpose_load(W, ldn, nblk, gw, F.lane, n1);
    if (gw + NGW < items) transpose_load(W, ldn, nblk, gw + NGW, F.lane, n2);
    for (int it = gw; it < items; it += NGW) {
#pragma unroll
        for (int i = 0; i < 8; ++i) { cur[i] = n1[i]; n1[i] = n2[i]; }
        if (it + 2 * NGW < items) transpose_load(W, ldn, nblk, it + 2 * NGW, F.lane, n2);
        transpose_store(cur, K, nblk, WT, scr, it, F.lane, gate_perm, kgl);
    }
    }
}

__device__ __forceinline__ void p_pack_gates(const Frame& F, const float* w_in, const float* gain, unsigned char* wgf) {
    for (int id = F.vcu * NTHREADS + F.tid; id < 64 * 64; id += F.G * NTHREADS) { const int cb = id >> 6, ln = id & 63, fq = ln >> 4, fr = ln & 15, gate = fr & 7; unsigned short h[8];
#pragma unroll
        for (int i = 0; i < 8; ++i) { const int c = 32 * cb + 8 * fq + i; const float v = gain[c] * w_in[(size_t)c * INW + INW_MAIN + gate]; const unsigned hi = f2bf(v);
            h[i] = (unsigned short)((fr < 8) ? hi : f2bf(v - __builtin_bit_cast(float, hi << 16))); }
        v4u o; o.x = h[0] | ((unsigned)h[1] << 16); o.y = h[2] | ((unsigned)h[3] << 16); o.z = h[4] | ((unsigned)h[5] << 16); o.w = h[6] | ((unsigned)h[7] << 16);
        *(v4u*)(wgf + (size_t)id * 16) = o; }
}
template <bool XBF> __device__ __forceinline__ int nrm_idx(int q, int lane) { return XBF ? 2 * (64 * (q >> 1) + lane) + (q & 1) : 64 * q + lane; }
template <bool XBF> __device__ __forceinline__ f32x4 nrm_ld(const void* x, size_t row, int q, int lane) {
    if constexpr (XBF) { const v2u w = ((const v2u*)((const bf16*)x + row * DM))[nrm_idx<XBF>(q, lane)]; return (f32x4){bflo(w.x), bfhi(w.x), bflo(w.y), bfhi(w.y)}; }
    else return ((const f32x4*)((const float*)x + row * DM))[nrm_idx<XBF>(q, lane)];
}
template <bool XBF> __device__ __forceinline__ void p_rmsnorm(const Frame& F, const void* x, const float* g, bf16* hn, const float* w_in, const float* gate_bias, float* gates) {
    const int gw = F.vcu * NWAVES + F.wave, NGW = F.G * NWAVES, lane = F.lane;
    LAS float* gwl = (LAS float*)F.lds;
    if (w_in) { __syncthreads();
#pragma unroll
        for (int i = 0; i < 8; ++i) { const int id = F.tid + NTHREADS * i, k = id >> 1; *(LAS f32x4*)(gwl + (k >> 3) * 68 + (k & 7) * 8 + (id & 1) * 4) = *(const f32x4*)(w_in + id * 4); }
        __syncthreads(); }
    f32x4 gg[8], nx[8];
#pragma unroll
    for (int j = 0; j < 8; ++j) gg[j] = ((const f32x4*)g)[nrm_idx<XBF>(j, lane)];
    if (gw < MROWS) {
#pragma unroll
        for (int j = 0; j < 8; ++j) nx[j] = nrm_ld<XBF>(x, (size_t)gw, j, lane); }
    for (int row = gw; row < MROWS; row += NGW) {
        f32x4 v[8]; float s = 0.f;
#pragma unroll
        for (int j = 0; j < 8; ++j) { v[j] = nx[j]; s += (v[j].x * v[j].x + v[j].y * v[j].y) + (v[j].z * v[j].z + v[j].w * v[j].w); }
        if (row + NGW < MROWS) {
#pragma unroll
            for (int j = 0; j < 8; ++j) nx[j] = nrm_ld<XBF>(x, (size_t)(row + NGW), j, lane); }
        const float rstd = 1.f / sqrtf(wave_sum(s) * (1.f / DM) + NORM_EPS);
#pragma unroll
        for (int j = 0; j < 8; ++j) v[j] = v[j] * rstd * gg[j];
        if constexpr (XBF) { v4u* o16 = (v4u*)(hn + (size_t)row * DM) + lane;
#pragma unroll
            for (int jj = 0; jj < 4; ++jj) { v4u w; w.x = pk2(v[2 * jj].x, v[2 * jj].y); w.y = pk2(v[2 * jj].z, v[2 * jj].w); w.z = pk2(v[2 * jj + 1].x, v[2 * jj + 1].y); w.w = pk2(v[2 * jj + 1].z, v[2 * jj + 1].w); o16[64 * jj] = w; } }
        else {
            const bool odd = lane & 1; bf16* ob_ = hn + (size_t)row * DM;
#pragma unroll
            for (int jj = 0; jj < 4; ++jj) { const unsigned a0 = pk2(v[2 * jj].x, v[2 * jj].y), a1 = pk2(v[2 * jj].z, v[2 * jj].w), b0 = pk2(v[2 * jj + 1].x, v[2 * jj + 1].y), b1 = pk2(v[2 * jj + 1].z, v[2 * jj + 1].w);
                const unsigned s0 = odd ? a0 : b0, s1 = odd ? a1 : b1;
                const unsigned r0 = (unsigned)__builtin_amdgcn_mov_dpp((int)s0, 0xB1, 0xf, 0xf, true), r1 = (unsigned)__builtin_amdgcn_mov_dpp((int)s1, 0xB1, 0xf, 0xf, true);
                v4u w; if (odd) { w.x = r0; w.y = r1; w.z = b0; w.w = b1; } else { w.x = a0; w.y = a1; w.z = r0; w.w = r1; }
                *(v4u*)(ob_ + 4 * (64 * (2 * jj + (odd ? 1 : 0)) + (lane & ~1))) = w; } }
        if (w_in) {
            float acc[8];
#pragma unroll
            for (int q = 0; q < 8; ++q) acc[q] = 0.f;
#pragma unroll
            for (int j = 0; j < 8; ++j) { asm volatile("" ::: "memory");
#pragma unroll
                for (int e = 0; e < 4; ++e) { const int k = 4 * nrm_idx<XBF>(j, lane) + e; const LAS float* wp = gwl + (k >> 3) * 68 + (k & 7) * 8; const f32x4 a = *(const LAS f32x4*)wp, b = *(const LAS f32x4*)(wp + 4); const float hv = v[j][e];
                    acc[0] += hv * a.x; acc[1] += hv * a.y; acc[2] += hv * a.z; acc[3] += hv * a.w; acc[4] += hv * b.x; acc[5] += hv * b.y; acc[6] += hv * b.z; acc[7] += hv * b.w; } }
#pragma unroll
            for (int q = 0; q < 8; ++q) acc[q] = wave_sum(acc[q]);
            if (lane < 8) { float r = acc[0];
#pragma unroll
                for (int q = 1; q < 8; ++q) r = (lane == q) ? acc[q] : r;
                gates[(size_t)row * 8 + lane] = r + gate_bias[lane]; }
        }
    }
}

__device__ __forceinline__ void unpack8(const v4u v, float (&f)[8]) { f[0] = bflo(v.x); f[1] = bfhi(v.x); f[2] = bflo(v.y); f[3] = bfhi(v.y); f[4] = bflo(v.z); f[5] = bfhi(v.z); f[6] = bflo(v.w); f[7] = bfhi(v.w); }
__device__ __forceinline__ void p_lstm_conv(const Frame& F, const bf16* z, const float* cw, const float* cb, bf16* qk) {
    constexpr int NCH = DM / 8, SEGR = 16, NSEG = MROWS / SEGR;
    const int total = NCH * NSEG, stride = F.G * NTHREADS;
    for (int item = F.vcu * NTHREADS + F.tid; item < total; item += stride) {
        const int cc = item % NCH, seg = item / NCH, c = 8 * cc, r0 = seg * SEGR, t0 = r0 & (SEQ - 1);
        float w[4][8], bb[8];
        { const f32x4 b0 = *(const f32x4*)(cb + c), b1 = *(const f32x4*)(cb + c + 4);
#pragma unroll
          for (int e = 0; e < 4; ++e) { bb[e] = b0[e]; bb[4 + e] = b1[e]; }
#pragma unroll
          for (int j = 0; j < 4; ++j) { const f32x4 w0 = *(const f32x4*)(cw + j * DM + c), w1 = *(const f32x4*)(cw + j * DM + c + 4);
#pragma unroll
              for (int e = 0; e < 4; ++e) { w[j][e] = w0[e]; w[j][4 + e] = w1[e]; } } }
        const float sc = (c >= QKW) ? 0.0625f : 1.f;
        float x3[8], x2[8], x1[8];
#pragma unroll
        for (int e = 0; e < 8; ++e) { x3[e] = 0.f; x2[e] = 0.f; x1[e] = 0.f; }
        if (t0 > 0) { unpack8(*(const v4u*)(z + (size_t)(r0 - 3) * INW_MAIN + c), x3); unpack8(*(const v4u*)(z + (size_t)(r0 - 2) * INW_MAIN + c), x2); unpack8(*(const v4u*)(z + (size_t)(r0 - 1) * INW_MAIN + c), x1); }
#pragma unroll 4
        for (int r = 0; r < SEGR; ++r) {
            float x0[8]; unpack8(*(const v4u*)(z + (size_t)(r0 + r) * INW_MAIN + c), x0);
            float o[8];
#pragma unroll
            for (int e = 0; e < 8; ++e) { const float a = bb[e] + w[0][e] * x3[e] + w[1][e] * x2[e] + w[2][e] * x1[e] + w[3][e] * x0[e]; o[e] = siluf_(a) * sc; x3[e] = x2[e]; x2[e] = x1[e]; x1[e] = x0[e]; }
            v4u ow; ow.x = pk2(o[0], o[1]); ow.y = pk2(o[2], o[3]); ow.z = pk2(o[4], o[5]); ow.w = pk2(o[6], o[7]);
            *(v4u*)(qk + (size_t)(r0 + r) * DM + c) = ow;
        }
    }
}

typedef short bf16x8 __attribute__((ext_vector_type(8)));
typedef short s16x4 __attribute__((ext_vector_type(4)));
typedef float f32x16 __attribute__((ext_vector_type(16)));
typedef __attribute__((address_space(3))) const unsigned char* lds_cptr;
__device__ __forceinline__ s16x4 vtr(lds_cptr p) { return __builtin_bit_cast(s16x4, __builtin_amdgcn_ds_read_tr16_b64_v4i16((__attribute__((address_space(3))) s16x4*)p)); }
__device__ __forceinline__ bf16x8 cat8(s16x4 lo, s16x4 hi) { return (bf16x8){lo[0], lo[1], lo[2], lo[3], hi[0], hi[1], hi[2], hi[3]}; }

constexpr int NSL = 17;
constexpr size_t CST_SLICE = 16384;
constexpr int L2_KSTR = 576, L2_KBUF = 64 * L2_KSTR;
constexpr int L2_VBUF = 64 * 64;

__device__ __forceinline__ float log_sigmoidf_(float x) { return (x >= 0.f) ? -log1pf(__expf(-x)) : x - log1pf(__expf(x)); }
__device__ __forceinline__ void p_lstm_scan2(const Frame& F, const float* gates, float* U, float* Mx, float* E) {
    if (F.vcu >= 8) return;
    const int bh = F.vcu, b = bh >> 2, h = bh & 3, tid = F.tid, lane = F.lane, w = F.wave, t0 = tid * 8;
    LAS float* wsum = (LAS float*)F.lds; LAS float* wmax = wsum + 8;
    const float* gb = gates + (size_t)(b * SEQ + t0) * 8;
    float lf[8], li[8];
#pragma unroll
    for (int i = 0; i < 8; ++i) { lf[i] = gb[i * 8 + 4 + h]; li[i] = gb[i * 8 + h]; }
    float s = 0.f;
#pragma unroll
    for (int i = 0; i < 8; ++i) { lf[i] = log_sigmoidf_(lf[i]); s += lf[i]; }
    float inc = s;
#pragma unroll
    for (int o = 1; o < 64; o <<= 1) { const float y = __shfl_up(inc, o); if (lane >= o) inc += y; }
    __syncthreads();
    if (lane == 63) wsum[w] = inc;
    __syncthreads();
    float base = 0.f;
#pragma unroll
    for (int q = 0; q < 8; ++q) base += (q < w) ? wsum[q] : 0.f;
    float Fc = base + inc - s, lm = -INFINITY; float u[8], Fv[8];
#pragma unroll
    for (int i = 0; i < 8; ++i) { Fc += lf[i]; Fv[i] = Fc; u[i] = li[i] - Fc; lm = fmaxf(lm, u[i]); }
    float pm = lm;
#pragma unroll
    for (int o = 1; o < 64; o <<= 1) { const float y = __shfl_up(pm, o); if (lane >= o) pm = fmaxf(pm, y); }
    if (lane == 63) wmax[w] = pm;
    __syncthreads();
    float mm = __shfl_up(pm, 1); if (lane == 0) mm = 0.f;
#pragma unroll
    for (int q = 0; q < 8; ++q) mm = fmaxf(mm, (q < w) ? wmax[q] : 0.f);
    mm = fmaxf(mm, 0.f);
#pragma unroll
    for (int i = 0; i < 8; ++i) { mm = fmaxf(mm, u[i]); U[bh * SEQ + t0 + i] = u[i]; Mx[bh * SEQ + t0 + i] = mm; E[bh * SEQ + t0 + i] = __expf(-(Fv[i] + mm)); }
    __syncthreads();
}

constexpr int S2_KSTR = 320, S2_KBUF = 64 * S2_KSTR;
constexpr int S2_VSTR = 192, S2_VBUF = 64 * S2_VSTR;
constexpr int S2_NWG = 128;
__device__ __forceinline__ void p_lstm_state(const Frame& F, const bf16* qk, const bf16* z, const float* U, const float* Mx, unsigned char* cst, float* nst) {
    const int item = F.vcu; if (item >= S2_NWG) return;
    const int bh = item >> 4, dkh = (item >> 3) & 1, dvp = item & 7, b = bh >> 2, h = bh & 3;
    const int tid = F.tid, lane = F.lane, w = F.wave, hi = lane >> 5, g1 = (lane >> 4) & 1, q4 = (lane & 15) >> 2, p4 = lane & 3, kbk = w & 3, vbk = w >> 2;
    LAS unsigned char* kb0 = F.lds; LAS unsigned char* vb0 = F.lds + 2 * S2_KBUF;
    const size_t rbase = (size_t)b * SEQ;
    const bf16* kg = qk + rbase * DM + QKW + h * LDK + 128 * dkh;
    const bf16* vg = z + rbase * INW_MAIN + 2 * QKW + h * LDV + 64 * dvp;
    const float* Ub = U + bh * SEQ; const float* Mb = Mx + bh * SEQ;
    const bool donorm = (dvp == 0);
    f32x16 acc;
#pragma unroll
    for (int r = 0; r < 16; ++r) acc[r] = 0.f;
    v4u kreg[4][2]; v4u vreg[4];
    LAS float* wtl = (LAS float*)(F.lds + 2 * S2_KBUF + 2 * S2_VBUF); LAS float* decl = wtl + SEQ; LAS float* nl = decl + 64;
    const int krow = tid >> 4, kch = tid & 15, vrow = tid >> 3, vch = tid & 7, nd = tid & 127, ntq = tid >> 7;
    __syncthreads();
    float nacc = 0.f;
#define L2_LOAD(c, sl) do { const int t0_ = (c) * 64; \
        _Pragma("unroll") for (int i_ = 0; i_ < 2; ++i_) kreg[sl][i_] = *(const v4u*)(kg + (size_t)(t0_ + krow + 32 * i_) * DM + kch * 8); \
        vreg[sl] = *(const v4u*)(vg + (size_t)(t0_ + vrow) * INW_MAIN + vch * 8); } while (0)
#define L2_STORE(sl, buf, c_) do { \
        _Pragma("unroll") for (int i_ = 0; i_ < 2; ++i_) *(LAS v4u*)(kb0 + (buf) * S2_KBUF + (krow + 32 * i_) * S2_KSTR + kch * 16) = kreg[sl][i_]; \
        { const float wt_ = wtl[(c_) * 64 + vrow]; v4u o_; const v4u vr_ = vreg[sl]; \
            o_.x = pk2(bflo(vr_.x) * wt_, bfhi(vr_.x) * wt_); o_.y = pk2(bflo(vr_.y) * wt_, bfhi(vr_.y) * wt_); o_.z = pk2(bflo(vr_.z) * wt_, bfhi(vr_.z) * wt_); o_.w = pk2(bflo(vr_.w) * wt_, bfhi(vr_.w) * wt_); \
            *(LAS v4u*)(vb0 + (buf) * S2_VBUF + vrow * S2_VSTR + vch * 16) = o_; } } while (0)
    const int koff = (8 * hi + q4) * S2_KSTR + (32 * kbk + 16 * g1 + 4 * p4) * 2;
    const int voff = (8 * hi + q4) * S2_VSTR + (32 * vbk + 16 * g1 + 4 * p4) * 2;
    unsigned char* cdst = cst + ((size_t)(bh * 64) * NSL + (2 * dvp + vbk)) * CST_SLICE + ((size_t)((4 * dkh + kbk) * 2) * 64 + lane) * 16;
    float* ndst = nst + (size_t)(bh * 64) * LDK + 128 * dkh + nd;
    L2_LOAD(0, 0); L2_LOAD(1, 1); L2_LOAD(2, 2); L2_LOAD(3, 3);
#pragma unroll
    for (int i = 0; i < 8; ++i) { const int t = tid + 512 * i; wtl[t] = __expf(Ub[t] - Mb[(t & ~63) + 63]); }
    if (tid < 64) decl[tid] = __expf((tid > 0 ? Mb[tid * 64 - 1] : 0.f) - Mb[tid * 64 + 63]);
    __syncthreads();
    L2_STORE(0, 0, 0);
    __syncthreads();
#define L2_CSTORE(c_) do { unsigned char* d = cdst + (size_t)(c_) * NSL * CST_SLICE; \
          _Pragma("unroll") for (int s_ = 0; s_ < 2; ++s_) { v4u o; o.x = pk2(acc[8 * s_ + 0], acc[8 * s_ + 1]); o.y = pk2(acc[8 * s_ + 2], acc[8 * s_ + 3]); o.z = pk2(acc[8 * s_ + 4], acc[8 * s_ + 5]); o.w = pk2(acc[8 * s_ + 6], acc[8 * s_ + 7]); \
              *(v4u*)(d + s_ * 1024) = o; } } while (0)
#define L2_ITER(c, sl, sln) do { \
        const float decay = decl[c]; \
        if (donorm) { nl[(((c) & 1) * 4 + ntq) * 128 + nd] = nacc; \
            if ((c) > 0 && tid < 128) { const LAS float* np_ = nl + ((((c) - 1) & 1) * 4) * 128 + tid; ndst[(size_t)((c) - 1) * LDK] = (np_[0] + np_[128]) + (np_[256] + np_[384]); } \
            float np = 0.f; const LAS unsigned char* kr_ = kb0 + ((c) & 1) * S2_KBUF + (16 * ntq) * S2_KSTR + nd * 2; const LAS float* wr_ = wtl + (c) * 64 + 16 * ntq; \
            _Pragma("unroll") for (int t_ = 0; t_ < 16; ++t_) np += wr_[t_] * bf2f(*(const LAS unsigned short*)(kr_ + t_ * S2_KSTR)); \
            nacc = nacc * decay + np; } \
        _Pragma("unroll") for (int r = 0; r < 16; ++r) acc[r] *= decay; \
        { lds_cptr kp = (lds_cptr)(kb0 + ((c) & 1) * S2_KBUF + koff); lds_cptr vp = (lds_cptr)(vb0 + ((c) & 1) * S2_VBUF + voff); \
          _Pragma("unroll") for (int ks = 0; ks < 4; ++ks) { \
              const bf16x8 a = cat8(vtr(kp + ks * 16 * S2_KSTR), vtr(kp + ks * 16 * S2_KSTR + 4 * S2_KSTR)); \
              const bf16x8 bb = cat8(vtr(vp + ks * 16 * S2_VSTR), vtr(vp + ks * 16 * S2_VSTR + 4 * S2_VSTR)); \
              acc = __builtin_amdgcn_mfma_f32_32x32x16_bf16(a, bb, acc, 0, 0, 0); } } \
        if ((c) + 1 < 64) { L2_STORE(sln, ((c) + 1) & 1, (c) + 1); } \
        if ((c) + 4 < 64) L2_LOAD((c) + 4, sl); \
        if ((c) + 1 < 64) L2_CSTORE((c) + 1);            \
        asm volatile("s_waitcnt lgkmcnt(0)" ::: "memory"); __builtin_amdgcn_s_barrier(); asm volatile("" ::: "memory"); } while (0)
    L2_CSTORE(0);
    for (int c4 = 0; c4 < 64; c4 += 4) { L2_ITER(c4, 0, 1); L2_ITER(c4 + 1, 1, 2); L2_ITER(c4 + 2, 2, 3); L2_ITER(c4 + 3, 3, 0); }
    if (donorm && tid < 128) { const LAS float* np_ = nl + 4 * 128 + tid; ndst[(size_t)63 * LDK] = (np_[0] + np_[128]) + (np_[256] + np_[384]); }
#undef L2_ITER
#undef L2_CSTORE
#undef L2_LOAD
#undef L2_STORE
}

constexpr int L3_QSTR = 528, L3_VSTR = 1088, L3_WSTR = 144;
constexpr int L3_Q = 0, L3_K = L3_Q + 64 * L3_QSTR, L3_V = L3_K + 64 * L3_QSTR, L3_W = L3_V + 64 * L3_VSTR, L3_SC = L3_W + 64 * L3_WSTR, L3_END = L3_SC + 8192;
__device__ __forceinline__ void p_lstm_out(const Frame& F, const XcdBarrier& bar, const bf16* qk, const bf16* z, const float* U, const float* Mx, const float* E, const unsigned char* cst, const float* nst, const float* hgain, bf16* O) {
    const int tid = F.tid, lane = F.lane, w = F.wave, hi = lane >> 5, g1 = (lane >> 4) & 1, q4 = (lane & 15) >> 2, p4 = lane & 3, l31 = lane & 31;
    LAS unsigned char* lds = F.lds;
    LAS float* sc = (LAS float*)(lds + L3_SC);
    LAS float* uS = sc, *Mrow = sc + 64, *inter = sc + 128, *Erow = sc + 192, *dinv = sc + 256, *nvec = sc + 320, *ssq = sc + 576, *rstdv = sc + 1088;
    for (int item = F.vcu; item < 8 * 64; item += F.G) {
        const int bh = item >> 6, c = item & 63, b = bh >> 2, h = bh & 3, t0 = c * 64;
        const size_t row0 = (size_t)b * SEQ + t0;
        __syncthreads();
        const unsigned char* cb = cst + ((size_t)(bh * 64 + c) * NSL + 2 * w) * CST_SLICE + (size_t)lane * 16;
        const bool first_item = (item == F.vcu);
        bf16x8 bfr[2][8];
        if (!first_item) {
#pragma unroll
            for (int q = 0; q < 4; ++q) { bfr[0][2 * q] = *(const bf16x8*)(cb + q * 1024); bfr[0][2 * q + 1] = *(const bf16x8*)(cb + CST_SLICE + q * 1024); } }
        { v4u rq[4], rk[4], rv[8];
#pragma unroll
          for (int i = 0; i < 4; ++i) { const int id = tid + 512 * i, r = id >> 5, ch = id & 31;
              rq[i] = *(const v4u*)(qk + (row0 + r) * DM + h * LDK + ch * 8); rk[i] = *(const v4u*)(qk + (row0 + r) * DM + QKW + h * LDK + ch * 8); }
#pragma unroll
          for (int i = 0; i < 8; ++i) { const int id = tid + 512 * i, r = id >> 6, ch = id & 63; rv[i] = *(const v4u*)(z + (row0 + r) * INW_MAIN + 2 * QKW + h * LDV + ch * 8); }
#pragma unroll
          for (int i = 0; i < 4; ++i) { const int id = tid + 512 * i, r = id >> 5, ch = id & 31;
              *(LAS v4u*)(lds + L3_Q + r * L3_QSTR + ch * 16) = rq[i]; *(LAS v4u*)(lds + L3_K + r * L3_QSTR + ch * 16) = rk[i]; }
#pragma unroll
          for (int i = 0; i < 8; ++i) { const int id = tid + 512 * i, r = id >> 6, ch = id & 63; *(LAS v4u*)(lds + L3_V + r * L3_VSTR + ch * 16) = rv[i]; } }
        if (tid < 64) { const float mr = Mx[bh * SEQ + t0 + tid]; const float mp = (c > 0) ? Mx[bh * SEQ + t0 - 1] : 0.f;
            uS[tid] = U[bh * SEQ + t0 + tid]; Mrow[tid] = mr; inter[tid] = __expf(mp - mr); Erow[tid] = E[bh * SEQ + t0 + tid]; }
        else if (tid < 128 && !first_item) { const int i4 = tid - 64; *(LAS f32x4*)(nvec + 4 * i4) = *(const f32x4*)(nst + (size_t)(bh * 64 + c) * LDK + 4 * i4); }
        __syncthreads();
        { const int rt = w >> 1, i15 = lane & 15, quad = lane >> 4;
#pragma unroll
          for (int cc = 0; cc < 2; ++cc) { const int ct = 2 * (w & 1) + cc;
              pg8::f32x4 sacc = (pg8::f32x4){0.f, 0.f, 0.f, 0.f};
              if (ct <= rt) {
                  const LAS unsigned char* qa = lds + L3_Q + (16 * rt + i15) * L3_QSTR + quad * 16; const LAS unsigned char* ka = lds + L3_K + (16 * ct + i15) * L3_QSTR + quad * 16;
#pragma unroll
                  for (int ks = 0; ks < 8; ++ks) { const bf16x8 a = *(const LAS bf16x8*)(qa + ks * 64), bb = *(const LAS bf16x8*)(ka + ks * 64);
                      sacc = __builtin_amdgcn_mfma_f32_16x16x32_bf16(a, bb, sacc, 0, 0, 0); } }
              const int s_ = 16 * ct + i15; const float us = uS[s_];
#pragma unroll
              for (int e = 0; e < 4; ++e) { const int l_ = 16 * rt + 4 * quad + e; const float wv = (s_ <= l_) ? sacc[e] * __expf(us - Mrow[l_]) : 0.f;
                  *(LAS unsigned short*)(lds + L3_W + l_ * L3_WSTR + s_ * 2) = (unsigned short)f2bf(wv); } } }
        if (first_item) {
            xcd_wait2(bar, 2 * XB_SET3);
            if (tid >= 64 && tid < 128) { const int i4 = tid - 64; *(LAS f32x4*)(nvec + 4 * i4) = *(const f32x4*)(nst + (size_t)(bh * 64 + c) * LDK + 4 * i4); }
#pragma unroll
            for (int q = 0; q < 4; ++q) { bfr[0][2 * q] = *(const bf16x8*)(cb + q * 1024); bfr[0][2 * q + 1] = *(const bf16x8*)(cb + CST_SLICE + q * 1024); } }
        __syncthreads();
        { const int r = tid >> 3, part = tid & 7; const v4u wv = *(const LAS v4u*)(lds + L3_W + r * L3_WSTR + part * 16);
          float rs = (bflo(wv.x) + bfhi(wv.x)) + (bflo(wv.y) + bfhi(wv.y)) + (bflo(wv.z) + bfhi(wv.z)) + (bflo(wv.w) + bfhi(wv.w)); float qn = 0.f;
#pragma unroll
          for (int i = 0; i < 4; ++i) { const v4u qv = *(const LAS v4u*)(lds + L3_Q + r * L3_QSTR + part * 64 + i * 16); const LAS float* np = nvec + part * 32 + i * 8;
              qn += bflo(qv.x) * np[0] + bfhi(qv.x) * np[1] + bflo(qv.y) * np[2] + bfhi(qv.y) * np[3] + bflo(qv.z) * np[4] + bfhi(qv.z) * np[5] + bflo(qv.w) * np[6] + bfhi(qv.w) * np[7]; }
          float den = inter[r] * qn + rs; den += __shfl_xor(den, 1); den += __shfl_xor(den, 2); den += __shfl_xor(den, 4);
          if (part == 0) dinv[r] = 1.f / fmaxf(fabsf(den), Erow[r]); }
        f32x16 acc[2][2];
#pragma unroll
        for (int a = 0; a < 2; ++a)
#pragma unroll
            for (int bq = 0; bq < 2; ++bq)
#pragma unroll
                for (int r = 0; r < 16; ++r) acc[a][bq][r] = 0.f;
        { const LAS unsigned char* qa = lds + L3_Q + l31 * L3_QSTR + hi * 8;
#pragma unroll
          for (int gq = 0; gq < 4; ++gq) {
              if (gq < 3) {
#pragma unroll
                  for (int q = 0; q < 4; ++q) { bfr[(gq + 1) & 1][2 * q] = *(const bf16x8*)(cb + (4 * (gq + 1) + q) * 1024); bfr[(gq + 1) & 1][2 * q + 1] = *(const bf16x8*)(cb + CST_SLICE + (4 * (gq + 1) + q) * 1024); } }
#pragma unroll
              for (int q = 0; q < 4; ++q) { const int kk = 4 * gq + q; const bf16x8 b0 = bfr[gq & 1][2 * q], b1 = bfr[gq & 1][2 * q + 1];
                  bf16x8 a[2];
#pragma unroll
                  for (int rt = 0; rt < 2; ++rt) { const s16x4 lo = *(const LAS s16x4*)(qa + rt * 32 * L3_QSTR + kk * 32), hh = *(const LAS s16x4*)(qa + rt * 32 * L3_QSTR + kk * 32 + 16); a[rt] = cat8(lo, hh); }
                  acc[0][0] = __builtin_amdgcn_mfma_f32_32x32x16_bf16(a[0], b0, acc[0][0], 0, 0, 0);
                  acc[0][1] = __builtin_amdgcn_mfma_f32_32x32x16_bf16(a[0], b1, acc[0][1], 0, 0, 0);
                  acc[1][0] = __builtin_amdgcn_mfma_f32_32x32x16_bf16(a[1], b0, acc[1][0], 0, 0, 0);
                  acc[1][1] = __builtin_amdgcn_mfma_f32_32x32x16_bf16(a[1], b1, acc[1][1], 0, 0, 0); }
              __builtin_amdgcn_sched_barrier(0); } }
#pragma unroll
        for (int rt = 0; rt < 2; ++rt)
#pragma unroll
            for (int r = 0; r < 16; ++r) { const float f = inter[32 * rt + (r & 3) + 8 * (r >> 2) + 4 * hi]; acc[rt][0][r] *= f; acc[rt][1][r] *= f; }
        { const LAS unsigned char* wa = lds + L3_W + l31 * L3_WSTR + hi * 16;
          lds_cptr vp = (lds_cptr)(lds + L3_V + (8 * hi + q4) * L3_VSTR + (64 * w + 16 * g1 + 4 * p4) * 2);
#pragma unroll
          for (int ks = 0; ks < 4; ++ks) {
              const bf16x8 a0 = *(const LAS bf16x8*)(wa + ks * 32), a1 = *(const LAS bf16x8*)(wa + 32 * L3_WSTR + ks * 32);
              const bf16x8 b0 = cat8(vtr(vp + ks * 16 * L3_VSTR), vtr(vp + ks * 16 * L3_VSTR + 4 * L3_VSTR));
              const bf16x8 b1 = cat8(vtr(vp + ks * 16 * L3_VSTR + 64), vtr(vp + ks * 16 * L3_VSTR + 4 * L3_VSTR + 64));
              acc[0][0] = __builtin_amdgcn_mfma_f32_32x32x16_bf16(a0, b0, acc[0][0], 0, 0, 0);
              acc[0][1] = __builtin_amdgcn_mfma_f32_32x32x16_bf16(a0, b1, acc[0][1], 0, 0, 0);
              acc[1][0] = __builtin_amdgcn_mfma_f32_32x32x16_bf16(a1, b0, acc[1][0], 0, 0, 0);
              acc[1][1] = __builtin_amdgcn_mfma_f32_32x32x16_bf16(a1, b1, acc[1][1], 0, 0, 0); } }
        __syncthreads();
        { LAS unsigned short* hb = (LAS unsigned short*)(lds + L3_V);
#pragma unroll
          for (int rt = 0; rt < 2; ++rt)
#pragma unroll
              for (int r = 0; r < 16; ++r) { const int l_ = 32 * rt + (r & 3) + 8 * (r >> 2) + 4 * hi; const float dn = dinv[l_];
                  const float x0 = acc[rt][0][r] * dn, x1 = acc[rt][1][r] * dn;
                  const unsigned pw = pk2(x0, x1);
                  hb[l_ * (L3_VSTR / 2) + 64 * w + l31] = (unsigned short)(pw & 0xffffu); hb[l_ * (L3_VSTR / 2) + 64 * w + 32 + l31] = (unsigned short)(pw >> 16);
                  float q2 = x0 * x0 + x1 * x1; q2 += __shfl_xor(q2, 1); q2 += __shfl_xor(q2, 2); q2 += __shfl_xor(q2, 4); q2 += __shfl_xor(q2, 8); q2 += __shfl_xor(q2, 16);
                  if (l31 == 0) ssq[w * 64 + l_] = q2; } }
        __syncthreads();
        if (tid < 64) { float tot = 0.f;
#pragma unroll
            for (int ww = 0; ww < 8; ++ww) tot += ssq[ww * 64 + tid];
            rstdv[tid] = 1.f / sqrtf(tot * (1.f / LDV) + NORM_EPS); }
        __syncthreads();
        { const int ch = tid & 63; const f32x4 ga = *(const f32x4*)(hgain + h * LDV + ch * 8), gb = *(const f32x4*)(hgain + h * LDV + ch * 8 + 4);
#pragma unroll 2
          for (int i = 0; i < 8; ++i) { const int r = (tid >> 6) + 8 * i;
              const v4u ogv = *(const v4u*)(z + (row0 + r) * INW_MAIN + 2 * QKW + DM + h * LDV + ch * 8);
              const v4u hv = *(const LAS v4u*)(lds + L3_V + r * L3_VSTR + ch * 16);
              float hf[8], gf[8]; unpack8(hv, hf); unpack8(ogv, gf);
              const float rstd = rstdv[r];
#pragma unroll
              for (int e = 0; e < 8; ++e) gf[e] = rstd * __builtin_amdgcn_rcpf(1.f + __expf(-gf[e]));
              v4u o; o.x = pk2(hf[0] * ga[0] * gf[0], hf[1] * ga[1] * gf[1]); o.y = pk2(hf[2] * ga[2] * gf[2], hf[3] * ga[3] * gf[3]);
              o.z = pk2(hf[4] * gb[0] * gf[4], hf[5] * gb[1] * gf[5]); o.w = pk2(hf[6] * gb[2] * gf[6], hf[7] * gb[3] * gf[7]);
              *(v4u*)(O + (row0 + r) * DM + h * LDV + ch * 8) = o; } }
    }
    __syncthreads();
}


constexpr int AT_K = 0, AT_V = 65536;
template <int KB, int KC, bool FUSE> __device__ __forceinline__ void p_attn(const Frame& F, const XcdBarrier& bar, const bf16* qkv, const float* qg, const float* kg, bf16* OG, float* LSE, bf16* O) {
    const int tid = F.tid, lane = F.lane, w = F.wave, i15 = lane & 15, quad = lane >> 4, q4 = i15 >> 2, p4 = lane & 3;
    LAS unsigned char* lds = F.lds;
    int lk[4];
#pragma unroll
    for (int ks = 0; ks < 4; ++ks) lk[ks] = i15 * 256 + (((4 * ks + quad) ^ i15) << 4);
    int lv[8];
    { const int rl = 4 * quad + q4, sw = (rl & 7) << 1, ps = ((p4 & 1) << 1) | (p4 >> 1);
#pragma unroll
      for (int dt = 0; dt < 8; ++dt) lv[dt] = rl * 256 + (((2 * dt + (ps >> 1)) ^ sw) << 4) + 8 * (ps & 1); }
#define AT_NIT(it_) ((F.vcu + F.G * ((it_) / KC)) < 256)
#define AT_DECODE(it_) const int grp_ = F.vcu + F.G * ((it_) / KC), k_ = KB + (it_) % KC, b_ = grp_ >> 7, h_ = (grp_ >> 3) & 15, o_ = grp_ & 7; \
        const int g_ = k_ >> 2, dil_ = (g_ == 0) ? 1 : (g_ == 1) ? 4 : 16; \
        const int res_ = (g_ == 0) ? 0 : (g_ == 1) ? (o_ >> 1) : (2 * o_ + ((k_ - 8) >> 1)), n_ = (g_ == 0) ? (4 * o_ + k_) : (g_ == 1) ? (4 * (o_ & 1) + (k_ - 4)) : (k_ & 1); \
        const bool first_ = (g_ == 2) ? ((k_ & 1) == 0) : ((k_ & 3) == 0); const size_t brow_ = (size_t)b_ * SEQ;
    v4u pkc[4], pvc[4], pkp[4], pvp[4], pq_[4];
#define AT_PRELOAD(it_) do { AT_DECODE(it_) \
        _Pragma("unroll") for (int i = 0; i < 4; ++i) { const int id = tid + 512 * i, j = id >> 4, ch = id & 15; \
            const bf16* src = qkv + (brow_ + (size_t)(128 * n_ + j) * dil_ + res_) * NQKV + DM + h_ * AHD + ch * 8; pkc[i] = *(const v4u*)src; pvc[i] = *(const v4u*)(src + DM); } \
        if (first_ && n_ > 0) { _Pragma("unroll") for (int i = 0; i < 4; ++i) { const int id = tid + 512 * i, j = id >> 4, ch = id & 15; \
            const bf16* src = qkv + (brow_ + (size_t)(128 * (n_ - 1) + j) * dil_ + res_) * NQKV + DM + h_ * AHD + ch * 8; pkp[i] = *(const v4u*)src; pvp[i] = *(const v4u*)(src + DM); } } \
        { const size_t qrow_ = brow_ + (size_t)(128 * n_ + 16 * w + i15) * dil_ + res_; \
          _Pragma("unroll") for (int ks = 0; ks < 4; ++ks) pq_[ks] = *(const v4u*)(qkv + qrow_ * NQKV + h_ * AHD + 32 * ks + 8 * quad); } } while (0)
    if (AT_NIT(0)) AT_PRELOAD(0);
    for (int it = 0; AT_NIT(it); ++it) {
        AT_DECODE(it)
        const int g = g_, h = h_, n = n_, dil = dil_, res = res_; const size_t brow = brow_;
        const int hcur = (n & 1) * 32768, hprev = 32768 - hcur;
        asm volatile("s_waitcnt lgkmcnt(0)" ::: "memory"); __builtin_amdgcn_s_barrier(); asm volatile("" ::: "memory");
#pragma unroll
        for (int i = 0; i < 4; ++i) { const int id = tid + 512 * i, j = id >> 4, ch = id & 15;
            *(LAS v4u*)(lds + AT_K + hcur + j * 256 + ((ch ^ (j & 15)) << 4)) = pkc[i];
            *(LAS v4u*)(lds + AT_V + hcur + j * 256 + ((ch ^ ((j & 7) << 1)) << 4)) = pvc[i]; }
        if (first_) {
#pragma unroll
            for (int i = 0; i < 4; ++i) { const int id = tid + 512 * i, j = id >> 4, ch = id & 15;
                v4u kv = pkp[i], vvv = pvp[i]; if (n == 0) { kv = (v4u){0u, 0u, 0u, 0u}; vvv = kv; }
                *(LAS v4u*)(lds + AT_K + hprev + j * 256 + ((ch ^ (j & 15)) << 4)) = kv;
                *(LAS v4u*)(lds + AT_V + hprev + j * 256 + ((ch ^ ((j & 7) << 1)) << 4)) = vvv; } }
        const size_t qrow = brow + (size_t)(128 * n + 16 * w + i15) * dil + res;
        bf16x8 qf[4];
#pragma unroll
        for (int ks = 0; ks < 4; ++ks) qf[ks] = __builtin_bit_cast(bf16x8, pq_[ks]);
        asm volatile("s_waitcnt lgkmcnt(0)" ::: "memory"); __builtin_amdgcn_s_barrier(); asm volatile("" ::: "memory");
        if (AT_NIT(it + 1)) AT_PRELOAD(it + 1);
#define AT_TOFF(T) ((((T) < 8) ? hprev : hcur) + ((T) & 7) * 4096)
        pg8::f32x4 st[9];
        { bf16x8 ka[3][4];
#pragma unroll
          for (int ks = 0; ks < 4; ++ks) { ka[0][ks] = *(const LAS bf16x8*)(lds + AT_K + AT_TOFF(w) + lk[ks]); ka[1][ks] = *(const LAS bf16x8*)(lds + AT_K + AT_TOFF(w + 1) + lk[ks]); }
#pragma unroll
          for (int jt = 0; jt < 9; ++jt) { st[jt] = (pg8::f32x4){0.f, 0.f, 0.f, 0.f};
              if (jt < 7) {
#pragma unroll
                  for (int ks = 0; ks < 4; ++ks) ka[(jt + 2) % 3][ks] = *(const LAS bf16x8*)(lds + AT_K + AT_TOFF(w + jt + 2) + lk[ks]); }
              if (n > 0 || w + jt >= 8) {
#pragma unroll
              for (int ks = 0; ks < 4; ++ks) st[jt] = __builtin_amdgcn_mfma_f32_16x16x32_bf16(ka[jt % 3][ks], qf[ks], st[jt], 0, 0, 0); }
              __builtin_amdgcn_sched_barrier(0); } }
        float mx = -INFINITY;
#pragma unroll
        for (int jt = 0; jt < 9; ++jt) { const bool tile_ok = (n > 0) || (w + jt >= 8);
#pragma unroll
            for (int e = 0; e < 4; ++e) { const int dj = 16 * jt + 4 * quad + e - i15;
                const bool ok = tile_ok && (jt != 0 || dj >= 0) && (jt != 8 || dj <= 128);
                const float s = ok ? st[jt][e] : -INFINITY; st[jt][e] = s; mx = fmaxf(mx, s); } }
        mx = fmaxf(mx, __shfl_xor(mx, 16)); mx = fmaxf(mx, __shfl_xor(mx, 32));
        float l = 0.f;
#pragma unroll
        for (int jt = 0; jt < 9; ++jt)
#pragma unroll
            for (int e = 0; e < 4; ++e) { const float p = __builtin_amdgcn_exp2f(st[jt][e] - mx); st[jt][e] = p; l += p; }
        l += __shfl_xor(l, 16); l += __shfl_xor(l, 32);
        pg8::f32x4 ot[8];
#pragma unroll
        for (int dt = 0; dt < 8; ++dt) ot[dt] = (pg8::f32x4){0.f, 0.f, 0.f, 0.f};
        { bf16x8 pb[5];
#pragma unroll
          for (int kk = 0; kk < 5; ++kk) { v4u pw; pw.x = pk2(st[2 * kk][0], st[2 * kk][1]); pw.y = pk2(st[2 * kk][2], st[2 * kk][3]);
              if (kk < 4) { pw.z = pk2(st[2 * kk + 1][0], st[2 * kk + 1][1]); pw.w = pk2(st[2 * kk + 1][2], st[2 * kk + 1][3]); } else { pw.z = 0u; pw.w = 0u; }
              pb[kk] = __builtin_bit_cast(bf16x8, pw); }
          s16x4 vf[3][4][2];
          const int t1last = (w == 7) ? 8 : 9;
#define AT_VLOAD(bt, buf) do { const int kk_ = (bt) >> 1, hf_ = (bt) & 1; const int t0_ = w + 2 * kk_, t1_ = w + ((kk_ < 4) ? (2 * kk_ + 1) : t1last); const int o0_ = AT_TOFF(t0_), o1_ = AT_TOFF(t1_); \
          _Pragma("unroll") for (int d_ = 0; d_ < 4; ++d_) { vf[buf][d_][0] = vtr((lds_cptr)(lds + AT_V + o0_ + lv[4 * hf_ + d_])); vf[buf][d_][1] = vtr((lds_cptr)(lds + AT_V + o1_ + lv[4 * hf_ + d_])); } } while (0)
          AT_VLOAD(0, 0); AT_VLOAD(1, 1);
#pragma unroll
          for (int bt = 0; bt < 10; ++bt) {
              if (bt < 8) AT_VLOAD(bt + 2, (bt + 2) % 3);
              if (n > 0 || w + 2 * (bt >> 1) + 1 >= 8) {
#pragma unroll
              for (int d = 0; d < 4; ++d) ot[4 * (bt & 1) + d] = __builtin_amdgcn_mfma_f32_16x16x32_bf16(cat8(vf[bt % 3][d][0], vf[bt % 3][d][1]), pb[bt >> 1], ot[4 * (bt & 1) + d], 0, 0, 0); }
              __builtin_amdgcn_sched_barrier(0); }
#undef AT_VLOAD
        }
#undef AT_TOFF
        v4u oc1[4], oc2[4]; f32x4 lsev = {0.f, 0.f, 0.f, 0.f};
        if constexpr (FUSE) { if (it == 0) xcd_wait2(bar, XB_SET3); }
        if constexpr (FUSE) { const int hi32_ = quad >> 1, ql_ = quad & 1; const bf16* p1 = OG + ((size_t)1 * MROWS + qrow) * DM + h * AHD + 16 * hi32_ + 8 * ql_; const bf16* p2 = p1 + (size_t)MROWS * DM;
#pragma unroll
            for (int dp = 0; dp < 4; ++dp) { oc1[dp] = *(const v4u*)(p1 + 32 * dp); oc2[dp] = *(const v4u*)(p2 + 32 * dp); }
            lsev = *(const f32x4*)(LSE + (qrow * AH + h) * 4); }
        { const float il = 1.f / l; const int hi32 = quad >> 1, ql = quad & 1; bf16* op = OG + ((size_t)g * MROWS + qrow) * DM + h * AHD + 16 * hi32 + 8 * ql;
#pragma unroll
          for (int dp = 0; dp < 4; ++dp) { const unsigned x0 = pk2(ot[2 * dp][0] * il, ot[2 * dp][1] * il), x1 = pk2(ot[2 * dp][2] * il, ot[2 * dp][3] * il);
              const unsigned y0 = pk2(ot[2 * dp + 1][0] * il, ot[2 * dp + 1][1] * il), y1 = pk2(ot[2 * dp + 1][2] * il, ot[2 * dp + 1][3] * il);
              const auto r0 = __builtin_amdgcn_permlane32_swap(x0, y0, false, false), r1 = __builtin_amdgcn_permlane32_swap(x1, y1, false, false);
              v4u o; o.x = r0[0]; o.y = r1[0]; o.z = r0[1]; o.w = r1[1];
              if constexpr (!FUSE) *(v4u*)(op + 32 * dp) = o;
              else {
                  const float l0 = (mx + __log2f(l)) * 0.6931471805599453f, l1 = lsev[1], l2 = lsev[2];
                  const float mm = fmaxf(l0, fmaxf(l1, l2)); float w0 = __expf(l0 - mm), w1 = __expf(l1 - mm), w2 = __expf(l2 - mm); const float inv = 1.f / (w0 + w1 + w2); w0 *= inv; w1 *= inv; w2 *= inv;
                  const v4u A = o, B = oc1[dp], C = oc2[dp]; v4u oo;
                  oo.x = pk2(w0 * bflo(A.x) + w1 * bflo(B.x) + w2 * bflo(C.x), w0 * bfhi(A.x) + w1 * bfhi(B.x) + w2 * bfhi(C.x));
                  oo.y = pk2(w0 * bflo(A.y) + w1 * bflo(B.y) + w2 * bflo(C.y), w0 * bfhi(A.y) + w1 * bfhi(B.y) + w2 * bfhi(C.y));
                  oo.z = pk2(w0 * bflo(A.z) + w1 * bflo(B.z) + w2 * bflo(C.z), w0 * bfhi(A.z) + w1 * bfhi(B.z) + w2 * bfhi(C.z));
                  oo.w = pk2(w0 * bflo(A.w) + w1 * bflo(B.w) + w2 * bflo(C.w), w0 * bfhi(A.w) + w1 * bfhi(B.w) + w2 * bfhi(C.w));
                  *(v4u*)(O + (size_t)qrow * DM + h * AHD + 16 * hi32 + 8 * ql + 32 * dp) = oo; } }
          if constexpr (!FUSE) { if (quad == 0) LSE[(qrow * AH + h) * 4 + g] = (mx + __log2f(l)) * 0.6931471805599453f; } }
    }
#undef AT_NIT
#undef AT_DECODE
#undef AT_PRELOAD
    __syncthreads();
    if constexpr (!FUSE) xcd_arrive2(bar, XB_SET3);
}
__device__ __forceinline__ void p_attn_combine(const Frame& F, const bf16* OG, const float* LSE, bf16* O) {
    const size_t total = (size_t)MROWS * (DM / 8), stride = (size_t)F.G * NTHREADS;
    for (size_t idx = (size_t)F.vcu * NTHREADS + F.tid; idx < total; idx += stride) {
        const int c8 = (int)(idx & 255), row = (int)(idx >> 8), h = c8 >> 4;
        const f32x4 lv = *(const f32x4*)(LSE + ((size_t)row * AH + h) * 4); const float l0 = lv[0], l1 = lv[1], l2 = lv[2];
        const float m = fmaxf(l0, fmaxf(l1, l2)); float w0 = __expf(l0 - m), w1 = __expf(l1 - m), w2 = __expf(l2 - m); const float inv = 1.f / (w0 + w1 + w2); w0 *= inv; w1 *= inv; w2 *= inv;
        const v4u a = *(const v4u*)(OG + ((size_t)0 * MROWS + row) * DM + c8 * 8), bq = *(const v4u*)(OG + ((size_t)1 * MROWS + row) * DM + c8 * 8), cq = *(const v4u*)(OG + ((size_t)2 * MROWS + row) * DM + c8 * 8);
        v4u o;
        o.x = pk2(w0 * bflo(a.x) + w1 * bflo(bq.x) + w2 * bflo(cq.x), w0 * bfhi(a.x) + w1 * bfhi(bq.x) + w2 * bfhi(cq.x));
        o.y = pk2(w0 * bflo(a.y) + w1 * bflo(bq.y) + w2 * bflo(cq.y), w0 * bfhi(a.y) + w1 * bfhi(bq.y) + w2 * bfhi(cq.y));
        o.z = pk2(w0 * bflo(a.z) + w1 * bflo(bq.z) + w2 * bflo(cq.z), w0 * bfhi(a.z) + w1 * bfhi(bq.z) + w2 * bfhi(cq.z));
        o.w = pk2(w0 * bflo(a.w) + w1 * bflo(bq.w) + w2 * bflo(cq.w), w0 * bfhi(a.w) + w1 * bfhi(bq.w) + w2 * bfhi(cq.w));
        *(v4u*)(O + (size_t)row * DM + c8 * 8) = o;
    }
}

__device__ __forceinline__ void p_gemm_bf16(const Frame& F, const bf16* A, const bf16* Bt, int N, int K, bf16* O) {
    pg8::Gemm g{A, Bt, MROWS, N, K}; pg8::EpiBf16<0> E{O, N, nullptr, 0, 0, 1.f};
    pg8::StaticOrder S; S.init(MROWS, N, F.G, (int)blockIdx.x);
    pg8::gemm_phase<pg8::EpiBf16<0>, pg8::StaticOrder, true, true>(F.lds, g, S, E);
}
struct StaticOrderWait : pg8::StaticOrder { const XcdBarrier* xb; unsigned wofs; mutable bool waited;
    __device__ __forceinline__ void a_ready(const pg8::Unit&) const { if (!waited) { xcd_wait2(*xb, wofs); waited = true; } } };
template <bool RB_IN, bool RB_OUT, bool WITH_SSQ, bool WITH_GATES = false> __device__ __forceinline__ void p_gemm_res(const Frame& F, const XcdBarrier& bar, unsigned wofs, const bf16* A, const bf16* Bt, int N, int K, const void* base, void* out, float* ssq = nullptr, const unsigned char* wgf = nullptr, float* gp = nullptr) {
    pg8::Gemm g{A, Bt, MROWS, N, K}; pg8::EpiRes<RB_IN, RB_OUT, WITH_SSQ, WITH_GATES> E{base, out, N, ssq, wgf, gp};
    StaticOrderWait S; S.init(MROWS, N, F.G, (int)blockIdx.x); S.xb = &bar; S.wofs = wofs; S.waited = false;
    pg8::gemm_phase<pg8::EpiRes<RB_IN, RB_OUT, WITH_SSQ, WITH_GATES>, StaticOrderWait, true, true>(F.lds, g, S, E);
    if (!S.waited) xcd_wait2(bar, wofs);
}
__device__ __forceinline__ void p_gemm_win(const Frame& F, const bf16* X, const bf16* Wt, bf16* Z, const float* ssq, const float* gp, const float* gate_bias, float* gates) {
    pg8::Gemm g{X, Wt, MROWS, INW_MAIN, DM}; LAS float* rsl = (LAS float*)(F.lds + RING_BYTES);
    pg8::EpiBf16RS E{Z, INW_MAIN, (const PG8_LAS float*)rsl};
    pg8::StaticOrder S; S.init(MROWS, INW_MAIN, F.G, (int)blockIdx.x);
    __syncthreads();
    { const int rl = F.tid >> 1, hf = F.tid & 1;
      f32x4 sa[7][4]; bool uv[7];
#pragma unroll
      for (int i = 0; i < 7; ++i) { pg8::Unit u; uv[i] = S.next(i, u); if (!uv[i]) u.pm = 0;
          const float* sp = ssq + (size_t)(u.pm * 256 + rl) * 32 + 16 * hf;
#pragma unroll
          for (int j = 0; j < 4; ++j) sa[i][j] = *(const f32x4*)(sp + 4 * j); }
#pragma unroll
      for (int i = 0; i < 7; ++i) { const f32x4 a0 = sa[i][0], a1 = sa[i][1], a2 = sa[i][2], a3 = sa[i][3];
          float t = ((a0[0] + a0[1]) + (a0[2] + a0[3])) + ((a1[0] + a1[1]) + (a1[2] + a1[3])) + ((a2[0] + a2[1]) + (a2[2] + a2[3])) + ((a3[0] + a3[1]) + (a3[2] + a3[3]));
          t += __shfl_xor(t, 1); if (hf == 0 && uv[i]) rsl[256 * i + rl] = __builtin_amdgcn_rsqf(t * (1.f / DM) + NORM_EPS); } }
    for (int row = F.vcu * 32 + (F.tid >> 4); row < MROWS; row += F.G * 32) {
        const int pt = F.tid & 15; const float* pp = gp + ((size_t)row * 32 + 2 * pt) * 8; const f32x4 p0 = *(const f32x4*)pp, p1 = *(const f32x4*)(pp + 4), p2 = *(const f32x4*)(pp + 8), p3 = *(const f32x4*)(pp + 12);
        const f32x2 sq = *(const f32x2*)(ssq + (size_t)row * 32 + 2 * pt);
        float gsum[8], st = row16_sum(sq.x + sq.y);
#pragma unroll
        for (int e = 0; e < 4; ++e) { gsum[e] = row16_sum(p0[e] + p2[e]); gsum[4 + e] = row16_sum(p1[e] + p3[e]); }
        const float rstd = __builtin_amdgcn_rsqf(st * (1.f / DM) + NORM_EPS);
        if (pt < 8) { float r = gsum[0];
#pragma unroll
            for (int q = 1; q < 8; ++q) r = (pt == q) ? gsum[q] : r;
            gates[(size_t)row * 8 + pt] = r * rstd + gate_bias[pt]; } }
    __syncthreads();
    pg8::gemm_phase<pg8::EpiBf16RS, pg8::StaticOrder, true, true>(F.lds, g, S, E);
}
__device__ __forceinline__ void p_gemm_convgate(const Frame& F, const bf16* X, const bf16* Wt, const float* cw, const float* cb, bf16* Gout, const float* ssq) {
    pg8::Gemm g{Wt, X, FFN2, MROWS, DM}; pg8::EpiConvGateT E{Gout, cw, cb, (PG8_LAS float*)(F.lds + RING_BYTES)};
    pg8::StaticOrder S; S.init_tiles(FFN2 / 256, 2 * pg8::EpiConvGateT::TPS, F.G, (int)blockIdx.x);
    { LAS float* rsl = (LAS float*)(F.lds + RING_BYTES) + 5120; const int rl = F.tid >> 1, hf = F.tid & 1;
      __syncthreads();
      f32x4 sa[7][4]; bool uv[7];
#pragma unroll
      for (int i = 0; i < 7; ++i) { pg8::Unit u; uv[i] = S.next(i, u); if (!uv[i]) u.pn = 0;
          int grow = pg8::EpiConvGateT::b_row0(u.pn) + rl; grow = grow < 0 ? 0 : (grow > MROWS - 1 ? MROWS - 1 : grow);
          const float* sp = ssq + (size_t)grow * 32 + 16 * hf;
#pragma unroll
          for (int j = 0; j < 4; ++j) sa[i][j] = *(const f32x4*)(sp + 4 * j); }
#pragma unroll
      for (int i = 0; i < 7; ++i) { const f32x4 a0 = sa[i][0], a1 = sa[i][1], a2 = sa[i][2], a3 = sa[i][3];
          float t = ((a0[0] + a0[1]) + (a0[2] + a0[3])) + ((a1[0] + a1[1]) + (a1[2] + a1[3])) + ((a2[0] + a2[1]) + (a2[2] + a2[3])) + ((a3[0] + a3[1]) + (a3[2] + a3[3]));
          t += __shfl_xor(t, 1); if (hf == 0 && uv[i]) rsl[256 * i + rl] = __builtin_amdgcn_rsqf(t * (1.f / DM) + NORM_EPS); }
      __syncthreads(); }
    pg8::gemm_phase<pg8::EpiConvGateT, pg8::StaticOrder, true, true>(F.lds, g, S, E);
}

__device__ __forceinline__ void p_gemm_qkv(const Frame& F, const bf16* A, const bf16* Bt, const float* qg, const float* kg, bf16* O) {
    pg8::Gemm g{A, Bt, MROWS, NQKV, DM}; pg8::EpiQKV E{O, NQKV, qg, kg, (PG8_LAS float*)(F.lds + RING_BYTES), 0.08838834764831845f * 1.4426950408889634f};
    pg8::StaticOrder S; S.init(MROWS, NQKV, F.G, (int)blockIdx.x);
    pg8::gemm_phase<pg8::EpiQKV, pg8::StaticOrder, true, true>(F.lds, g, S, E);
}

constexpr int N_PHASES = 14;
__global__ void __launch_bounds__(NTHREADS, 2) mega(Args args) {
    extern __shared__ __attribute__((aligned(16))) unsigned char lds_raw[];
    Frame F; F.lds = (LAS unsigned char*)lds_raw;
    F.tid = threadIdx.x; F.lane = F.tid & 63; F.wave = __builtin_amdgcn_readfirstlane(F.tid >> 6);
    F.G = gridDim.x; { const int bx = blockIdx.x; F.vcu = (F.G % 8 == 0) ? (bx % 8) * (F.G / 8) + bx / 8 : bx; }
    volatile LAS unsigned* MISC = (volatile LAS unsigned*)(F.lds + MISC_OFF);
    static_assert(L3_END <= MISC_OFF, "LDS map");
    for (int u = F.tid; u < (LDS_BYTES - MISC_OFF) / 4; u += NTHREADS) ((LAS unsigned*)(F.lds + MISC_OFF))[u] = 0u;
    __syncthreads();
    unsigned char* ws = args.ws;
    unsigned* ctl = (unsigned*)(ws + WS_CTL);
    XcdBarrier bar = xcd_barrier_post(ctl + CW_BAR, MISC);

    const float* x = args.in[0];
    const float *attn_norm = args.in[1], *w_qkv = args.in[2], *q_gain = args.in[3], *k_gain = args.in[4], *w_o = args.in[5];
    const float *lstm_norm = args.in[6], *w_in = args.in[7], *gate_bias = args.in[8], *lconv_w = args.in[9], *lconv_b = args.in[10], *head_gain = args.in[11], *w_out = args.in[12];
    const float *ffn_norm = args.in[13], *w_up = args.in[14], *fconv_w = args.in[15], *fconv_b = args.in[16], *w_down = args.in[17];
    float* out = args.out;
    bf16 *Wqkv = (bf16*)(ws + WS_WQKV), *Wo = (bf16*)(ws + WS_WO), *Win = (bf16*)(ws + WS_WIN), *Wout = (bf16*)(ws + WS_WOUT), *Wup = (bf16*)(ws + WS_WUP), *Wdn = (bf16*)(ws + WS_WDN);
    bf16 *HN = (bf16*)(ws + WS_HN), *G = (bf16*)(ws + WS_G), *QKV = (bf16*)(ws + WS_QKV), *O = (bf16*)(ws + WS_O), *QKC = (bf16*)(ws + WS_QKC), *U = (bf16*)(ws + WS_U);
    bf16* OG = (bf16*)(ws + WS_QKC); float* LSE = (float*)(ws + WS_G);
    float* SSQ = (float*)(ws + WS_SSQ); float* GWT = (float*)(ws + WS_GWT); bf16* XR = (bf16*)(ws + WS_XR);
    float *GATES = (float*)(ws + WS_GATES), *SU = (float*)(ws + WS_SU), *SM = (float*)(ws + WS_SM), *SE = (float*)(ws + WS_SE);

    const int lo = args.ph_lo, hi = args.ph_hi;
#define IN(k) (lo <= (k) && (k) < hi)

    int ph = 0;
#ifndef PROBE_MASK
#define PROBE_MASK 0u
#endif
#define PHASE(body) do { if (IN(ph)) { body; if ((PROBE_MASK >> ph) & 1u) { body; } } if (IN(ph) && IN(ph + 1)) xcd_barrier(bar); ++ph; } while (0)
    if (IN(ph)) {
        p_convert(F, w_qkv, Wqkv, DM, NQKV, NQKV);
        p_rmsnorm<false>(F, x, attn_norm, HN, nullptr, nullptr, nullptr);
        xcd_arrive2(bar);
        p_convert(F, w_o, Wo, DM, DM, DM);
        p_convert(F, w_in, Win, DM, INW, INW_MAIN, false, 0, 0, lstm_norm);
        p_convert(F, w_up, Wup, DM, FFN2, FFN2, true, 0, 0, ffn_norm);
        p_convert(F, w_down, Wdn, FFN, DM, DM);
        p_pack_gates(F, w_in, lstm_norm, ws + WS_GWT);
        xcd_wait2(bar);
    }
    ++ph;
    PHASE(p_gemm_qkv(F, HN, Wqkv, q_gain, k_gain, QKV));
    if (IN(ph)) p_attn<4, 8, false>(F, bar, QKV, q_gain, k_gain, OG, LSE, O);
    ++ph;
    if (IN(ph)) { p_attn<0, 4, true>(F, bar, QKV, q_gain, k_gain, OG, LSE, O); xcd_arrive2(bar, 3 * XB_SET3); }
    ++ph;
    PHASE((p_gemm_res<false, true, true>(F, bar, 3 * XB_SET3, O, Wo, DM, DM, x, XR, SSQ)));
    if (IN(ph)) { p_gemm_convgate(F, XR, Wup, fconv_w, fconv_b, G, SSQ); xcd_arrive2(bar, 4 * XB_SET3); }
    ++ph;
    PHASE((p_gemm_res<true, true, true, true>(F, bar, 4 * XB_SET3, G, Wdn, DM, FFN, XR, XR, SSQ, ws + WS_GWT, (float*)(ws + WS_HN))));
    PHASE(p_gemm_win(F, XR, Win, QKV, SSQ, (const float*)(ws + WS_HN), gate_bias, GATES));
    PHASE(p_lstm_scan2(F, GATES, SU, SM, SE); p_lstm_conv(F, QKV, lconv_w, lconv_b, QKC));
    if (IN(ph)) { p_lstm_state(F, QKC, QKV, SU, SM, ws + WS_CST, (float*)(ws + WS_NST));
          p_convert<2>(F, w_up + (size_t)DM * FFN2, Wup + (size_t)FFN2 * DM, DM, FFN2, FFN2, true, S2_NWG, F.G - S2_NWG, ffn_norm + DM);
          p_convert<2>(F, w_down + (size_t)FFN * DM, Wdn + (size_t)DM * FFN, FFN, DM, DM, false, S2_NWG, F.G - S2_NWG);
          p_convert<2>(F, w_out, Wout, DM, DM, DM, false, S2_NWG, F.G - S2_NWG);
          xcd_arrive2(bar, 2 * XB_SET3); }
    ++ph;
    if (IN(ph)) { p_lstm_out(F, bar, QKC, QKV, SU, SM, SE, ws + WS_CST, (const float*)(ws + WS_NST), head_gain, O); xcd_arrive2(bar, 5 * XB_SET3); }
    ++ph;
    PHASE((p_gemm_res<true, true, true>(F, bar, 5 * XB_SET3, O, Wout, DM, DM, XR, XR, SSQ)));
    if (IN(ph)) { p_gemm_convgate(F, XR, Wup + (size_t)FFN2 * DM, fconv_w + 3 * FFN2, fconv_b + FFN2, G, SSQ); xcd_arrive2(bar, 6 * XB_SET3); }
    ++ph;
    PHASE((p_gemm_res<true, false, false>(F, bar, 6 * XB_SET3, G, Wdn + (size_t)DM * FFN, DM, FFN, XR, out)));
#undef PHASE
#undef IN
}

extern "C" void kernel_launch(void* const* d_in, const int* in_sizes, int n_in, void* d_out, int out_size, void* d_ws, size_t ws_size, hipStream_t stream) {
    static int grid = 0;
    if (grid == 0) {
        if (n_in != 18 || in_sizes[0] != MROWS * DM || out_size != MROWS * DM || ws_size < WS_END) { fprintf(stderr, "kernel_launch: unexpected problem (n_in %d, ws %zu < %zu)\n", n_in, ws_size, (size_t)WS_END); grid = -1; return; }
        int dev = 0, cus = 0, per_cu = 0;
        if (hipGetDevice(&dev) != hipSuccess || hipDeviceGetAttribute(&cus, hipDeviceAttributeMultiprocessorCount, dev) != hipSuccess) { grid = -1; return; }
        if (hipFuncSetAttribute((const void*)mega, hipFuncAttributeMaxDynamicSharedMemorySize, LDS_BYTES) != hipSuccess) { fprintf(stderr, "kernel_launch: hipFuncSetAttribute failed\n"); grid = -1; return; }
        if (hipOccupancyMaxActiveBlocksPerMultiprocessor(&per_cu, (const void*)mega, NTHREADS, LDS_BYTES) != hipSuccess || per_cu < 1) { fprintf(stderr, "kernel_launch: occupancy query says %d\n", per_cu); per_cu = 1; }
        (void)hipGetLastError();
        grid = cus;
    }
    if (grid < 0) return;
    if (hipMemsetAsync((char*)d_ws + WS_CTL, 0, CTL_ZERO_BYTES, stream) != hipSuccess) return;
    Args a; memset(&a, 0, sizeof(a));
    for (int i = 0; i < 18; ++i) a.in[i] = (const float*)d_in[i];
    a.out = (float*)d_out; a.ws = (unsigned char*)d_ws; a.ph_lo = 0; a.ph_hi = N_PHASES;
    void* kargs[] = {&a};
    hipError_t e = hipLaunchCooperativeKernel((const void*)mega, dim3(grid), dim3(NTHREADS), kargs, LDS_BYTES, stream);
    if (e != hipSuccess) { fprintf(stderr, "kernel_launch: cooperative launch failed: %s; plain launch instead\n", hipGetErrorString(e)); (void)hipGetLastError();
        hipLaunchKernelGGL(mega, dim3(grid), dim3(NTHREADS), LDS_BYTES, stream, a); }
}
```
